# Optimizing an MI355X kernel written in HIP

```python
import math
import jax, jax.numpy as jnp
from jax import lax
import numpy as np

D_MODEL = 1024
BATCH = 4
SEQ = 4096
DEPTH = 1

GRID_W = 64
CTX_LEN = 256
D_MIX = D_MODEL
HG_WIDTH = D_MIX // 2
HG_HEAD_DIM = 128
HG_HEADS = HG_WIDTH // HG_HEAD_DIM
HG_EXPAND = 128
HG_KDIM = HG_HEADS * HG_EXPAND
POOL_WIDTH = D_MIX - HG_WIDTH
POOL_WINDOWS = (2, 4, 8, 16)
POOL_GROUP = POOL_WIDTH // len(POOL_WINDOWS)
IN_COLS = 2 * HG_KDIM + HG_KDIM + 2 * HG_WIDTH + POOL_WIDTH
CHUNK = 64
N_EXPERTS = 32
TOP_K = 4
D_FF = D_MODEL
SWIGLU_LIMIT = 7.0
SWIGLU_ALPHA = 1.702
MOE_BLOCK = 128
EPS = 1e-6

kernel_name = "hybrid_hgrn2_pool_moe_dit_block"


def rms_norm(x, gain):
    xf = x.astype(jnp.float32)
    y = xf * lax.rsqrt(jnp.mean(xf * xf, axis=-1, keepdims=True) + EPS)
    return (y * gain.astype(jnp.float32)).astype(x.dtype)


def gla_chunked(q, k, v, logf, s0):
    B, H, T, DK = q.shape
    DV = v.shape[-1]
    n = T // CHUNK

    def to_chunks(a):
        return a.reshape(B, H, n, CHUNK, a.shape[-1]).transpose(2, 0, 1, 3, 4)

    causal = jnp.tril(jnp.ones((CHUNK, CHUNK), dtype=bool))[:, :, None]

    def step(S, inp):
        qc, kc, vc, lc = inp
        b = jnp.cumsum(lc, axis=-2)
        o_inter = jnp.einsum('bhtk,bhkv->bhtv', qc * jnp.exp(b), S)
        diff = b[:, :, :, None, :] - b[:, :, None, :, :]
        decay = jnp.exp(jnp.where(causal, diff, -jnp.inf))
        att = jnp.einsum('bhtk,bhsk,bhtsk->bhts', qc, kc, decay)
        o = o_inter + jnp.einsum('bhts,bhsv->bhtv', att, vc)
        b_last = b[:, :, -1:, :]
        S = jnp.exp(b_last[:, :, 0, :, None]) * S + jnp.einsum(
            'bhsk,bhsv->bhkv', kc * jnp.exp(b_last - b), vc)
        return S, o

    S, o = lax.scan(step, s0, (to_chunks(q), to_chunks(k), to_chunks(v), to_chunks(logf)))
    o = o.transpose(1, 2, 0, 3, 4).reshape(B, H, T, DV)
    return o, S


def hgrn2_mixer(p, lb, norm_gain, s0_f, s0_b):
    B, T, _ = p.shape
    q, ff, fb, i, g = jnp.split(p, [HG_KDIM, 2 * HG_KDIM, 3 * HG_KDIM, 3 * HG_KDIM + HG_WIDTH], axis=-1)

    def heads(a):
        return a.reshape(B, T, HG_HEADS, -1).transpose(0, 2, 1, 3).astype(jnp.float32)

    qh = heads(jax.nn.silu(q))
    vh = heads(i)

    def direction(fpre, lbd, s0, reverse):
        fz = heads(fpre)
        lbh = lbd.astype(jnp.float32).reshape(HG_HEADS, 1, HG_EXPAND)
        logf = jnp.log(lbh + (1.0 - lbh) * jax.nn.sigmoid(fz))
        kk = (1.0 - lbh) * jax.nn.sigmoid(-fz)
        qq, vv = qh, vh
        if reverse:
            qq, kk, vv, logf = (jnp.flip(a, axis=2) for a in (qq, kk, vv, logf))
        o, s = gla_chunked(qq, kk, vv, logf, s0)
        if reverse:
            o = jnp.flip(o, axis=2)
        return o, s

    o_f, s_f = direction(ff, lb[0], s0_f, False)
    o_b, s_b = direction(fb, lb[1], s0_b, True)
    o = o_f + o_b
    o = o * lax.rsqrt(jnp.mean(o * o, axis=-1, keepdims=True) + EPS)
    o = o.transpose(0, 2, 1, 3).reshape(B, T, HG_WIDTH)
    o = o * norm_gain.astype(jnp.float32) * jax.nn.sigmoid(g.astype(jnp.float32))
    return o.astype(p.dtype), s_f, s_b


def window_mean(x, axis, w):
    n = x.shape[axis]
    cs = jnp.cumsum(x.astype(jnp.float32), axis=axis)
    zero = jnp.zeros_like(lax.slice_in_dim(cs, 0, 1, axis=axis))
    cs = jnp.concatenate([zero, cs], axis=axis)
    t = jnp.arange(n)
    lo = jnp.clip(t - w // 2, 0, n)
    hi = jnp.clip(t - w // 2 + w, 0, n)
    s = jnp.take(cs, hi, axis=axis) - jnp.take(cs, lo, axis=axis)
    shape = [1] * x.ndim
    shape[axis] = n
    cnt = (hi - lo).astype(jnp.float32).reshape(shape)
    return s / cnt


def pool_mixer(u, pool_w, pool_scale, rows):
    B, T, _ = u.shape
    outs = []
    for gi, w in enumerate(POOL_WINDOWS):
        ug = u[..., gi * POOL_GROUP:(gi + 1) * POOL_GROUP].astype(jnp.float32)
        if rows is None:
            m = window_mean(ug, 1, w)
        else:
            grid = ug.reshape(B, rows, GRID_W, POOL_GROUP)
            m = window_mean(window_mean(grid, 1, w), 2, w).reshape(B, T, POOL_GROUP)
        outs.append(jnp.einsum('btc,cd->btd', m - ug, pool_w[gi].astype(jnp.float32)))
    y = jnp.concatenate(outs, axis=-1) * pool_scale.astype(jnp.float32)
    return y.astype(u.dtype)


def moe(xt, w_router, b_router, w_gate, b_gate, w_up, b_up, w_down, b_down):
    T, D = xt.shape
    logits = (xt @ w_router + b_router).astype(jnp.float32)
    top_val, top_idx = lax.top_k(logits, TOP_K)
    top_w = jax.nn.softmax(top_val, axis=-1)
    A = T * TOP_K
    flat_e = top_idx.reshape(-1).astype(jnp.int32)
    flat_tok = jnp.arange(A, dtype=jnp.int32) // TOP_K
    flat_w = top_w.reshape(-1)
    order = jnp.argsort(flat_e, stable=True)
    sorted_e = flat_e[order]
    counts = jnp.bincount(flat_e, length=N_EXPERTS)
    padded = ((counts + MOE_BLOCK - 1) // MOE_BLOCK) * MOE_BLOCK
    start = jnp.cumsum(counts) - counts
    pend = jnp.cumsum(padded)
    pstart = pend - padded
    rank = jnp.arange(A, dtype=jnp.int32) - start[sorted_e]
    dest = pstart[sorted_e] + rank
    n_blocks = -(-A // MOE_BLOCK) + N_EXPERTS
    P = n_blocks * MOE_BLOCK
    row_tok = jnp.full((P,), T, dtype=jnp.int32).at[dest].set(flat_tok[order])
    row_w = jnp.zeros((P,), jnp.float32).at[dest].set(flat_w[order])
    block_e = jnp.clip(jnp.searchsorted(pend, jnp.arange(n_blocks) * MOE_BLOCK, side='right'), 0, N_EXPERTS - 1)
    xpad = jnp.concatenate([xt, jnp.zeros((1, D), xt.dtype)], axis=0)
    xb = xpad[row_tok].reshape(n_blocks, MOE_BLOCK, D)

    def expert_block(args):
        xblk, e = args
        gate = xblk @ w_gate[e] + b_gate[e]
        up = xblk @ w_up[e] + b_up[e]
        gate = jnp.minimum(gate, SWIGLU_LIMIT)
        up = jnp.clip(up, -SWIGLU_LIMIT, SWIGLU_LIMIT)
        h = (up + 1.0) * gate * jax.nn.sigmoid(SWIGLU_ALPHA * gate)
        return h @ w_down[e] + b_down[e]

    yb = lax.map(expert_block, (xb, block_e)).reshape(P, D)
    y = jax.ops.segment_sum(yb.astype(jnp.float32) * row_w[:, None], row_tok, num_segments=T + 1)[:T]
    return y.astype(xt.dtype)


def setup_inputs(seed: int = 0) -> dict:
    key = jax.random.key(seed)
    ks = jax.random.split(key, 26)
    L, D, E, F = DEPTH, D_MODEL, N_EXPERTS, D_FF
    nrm = lambda k, s, sc: jax.random.normal(k, s, jnp.float32) * sc
    return {
        "x": nrm(ks[0], (BATCH, SEQ, D), 1.0),
        "c": nrm(ks[1], (BATCH, D), 1.0),
        "ctx": nrm(ks[2], (BATCH, CTX_LEN, D), 1.0),
        "c_ctx": nrm(ks[3], (D,), 1.0),
        "w_ada": nrm(ks[4], (L, D, 6 * D), 0.5 / math.sqrt(D)),
        "b_ada": nrm(ks[5], (L, 6 * D), 0.02),
        "g_pre_mix": 1.0 + nrm(ks[6], (L, D), 0.02),
        "g_post_mix": 1.0 + nrm(ks[7], (L, D), 0.02),
        "g_pre_ffn": 1.0 + nrm(ks[8], (L, D), 0.02),
        "g_post_ffn": 1.0 + nrm(ks[9], (L, D), 0.02),
        "w_in": nrm(ks[10], (L, D, IN_COLS), 1.0 / math.sqrt(D)),
        "w_out": nrm(ks[11], (L, D_MIX, D), 1.0 / math.sqrt(D_MIX)),
        "hgrn_lb_logits": nrm(ks[12], (L + 1, 2, HG_KDIM), 0.1),
        "hgrn_norm": 1.0 + nrm(ks[13], (L, HG_WIDTH), 0.02),
        "pool_w": nrm(ks[14], (L, len(POOL_WINDOWS), POOL_GROUP, POOL_GROUP), 1.0 / math.sqrt(POOL_GROUP)),
        "pool_scale": 1.0 + nrm(ks[15], (L, POOL_WIDTH), 0.1),
        "w_router": nrm(ks[16], (L, D, E), 1.0 / math.sqrt(D)),
        "b_router": nrm(ks[17], (L, E), 0.01),
        "w_gate": nrm(ks[18], (L, E, D, F), 1.0 / math.sqrt(D)),
        "b_gate": nrm(ks[19], (L, E, F), 0.01),
        "w_up": nrm(ks[20], (L, E, D, F), 1.0 / math.sqrt(D)),
        "b_up": nrm(ks[21], (L, E, F), 0.01),
        "w_down": nrm(ks[22], (L, E, F, D), 1.0 / math.sqrt(F)),
        "b_down": nrm(ks[23], (L, E, D), 0.01),
    }


def reference(x, c, ctx, c_ctx, w_ada, b_ada, g_pre_mix, g_post_mix, g_pre_ffn, g_post_ffn,
              w_in, w_out, hgrn_lb_logits, hgrn_norm, pool_w, pool_scale,
              w_router, b_router, w_gate, b_gate, w_up, b_up, w_down, b_down):
    B, S, D = x.shape
    rows = S // GRID_W
    Bc, Tc, _ = ctx.shape
    lb_table = jnp.cumsum(jax.nn.softmax(hgrn_lb_logits.astype(jnp.float32), axis=0), axis=0)

    for l in range(DEPTH):
        last = l == DEPTH - 1
        mod_lat = (jax.nn.silu(c) @ w_ada[l] + b_ada[l])[:, None, :]
        mod_ctx = (jax.nn.silu(c_ctx) @ w_ada[l] + b_ada[l])[None, None, :]
        sh1, sc1, gt1, sh2, sc2, gt2 = jnp.split(mod_lat, 6, axis=-1)
        csh1, csc1, cgt1, csh2, csc2, cgt2 = jnp.split(mod_ctx, 6, axis=-1)
        lb = lb_table[l]

        hc = rms_norm(ctx, g_pre_mix[l]) * (1.0 + csc1) + csh1
        pc = hc @ w_in[l]
        zeros_state = jnp.zeros((Bc, HG_HEADS, HG_EXPAND, HG_HEAD_DIM), jnp.float32)
        o_hg_c, s_f, s_b = hgrn2_mixer(pc[..., :IN_COLS - POOL_WIDTH], lb, hgrn_norm[l], zeros_state, zeros_state)

        hx = rms_norm(x, g_pre_mix[l]) * (1.0 + sc1) + sh1
        px = hx @ w_in[l]
        o_hg_x, _, _ = hgrn2_mixer(px[..., :IN_COLS - POOL_WIDTH], lb, hgrn_norm[l], s_f, s_b)
        o_pool_x = pool_mixer(px[..., IN_COLS - POOL_WIDTH:], pool_w[l], pool_scale[l], rows)
        yx = jnp.concatenate([o_hg_x, o_pool_x], axis=-1) @ w_out[l]
        x = x + gt1 * rms_norm(yx, g_post_mix[l])

        if not last:
            o_pool_c = pool_mixer(pc[..., IN_COLS - POOL_WIDTH:], pool_w[l], pool_scale[l], None)
            yc = jnp.concatenate([o_hg_c, o_pool_c], axis=-1) @ w_out[l]
            ctx = ctx + cgt1 * rms_norm(yc, g_post_mix[l])

        hx2 = (rms_norm(x, g_pre_ffn[l]) * (1.0 + sc2) + sh2).reshape(B * S, D)
        if last:
            tokens = hx2
        else:
            hc2 = (rms_norm(ctx, g_pre_ffn[l]) * (1.0 + csc2) + csh2).reshape(Bc * Tc, D)
            tokens = jnp.concatenate([hx2, hc2], axis=0)
        y = moe(tokens, w_router[l], b_router[l], w_gate[l], b_gate[l], w_up[l], b_up[l], w_down[l], b_down[l])
        x = x + gt2 * rms_norm(y[:B * S].reshape(B, S, D), g_post_ffn[l])
        if not last:
            ctx = ctx + cgt2 * rms_norm(y[B * S:].reshape(Bc, Tc, D), g_post_ffn[l])

    return x
```

```cpp
#include <hip/hip_runtime.h>
#include <cstdio>
#include <cstdint>

#define LAS __attribute__((address_space(3)))
typedef unsigned short bf16_t;
typedef short bf16x8 __attribute__((ext_vector_type(8)));
typedef float f32x4 __attribute__((ext_vector_type(4)));
typedef float f32x16 __attribute__((ext_vector_type(16)));
typedef unsigned u32x4 __attribute__((ext_vector_type(4)));
typedef unsigned u32x2 __attribute__((ext_vector_type(2)));

#ifndef MK_N_LAUNCHES
#define MK_N_LAUNCHES 1
#endif
#ifndef REPMASK
#define REPMASK 0x000
#endif

constexpr int D = 1024, NB = 4, SEQ = 4096, M = NB * SEQ, CTXL = 256, MC = NB * CTXL, MTOT = M + MC;
constexpr int NIN = 3072, NE = 32, TOPK = 4, FF = 1024;
constexpr int NHEAD = 4, HD = 128;
constexpr int NBLK = 17;
constexpr int ECAP = 16384;
constexpr int HROWS = 65536 + NE * 256;
constexpr float EPS = 1e-6f;

constexpr size_t MiB = 1u << 20;
constexpr size_t WS_CTL = 0, CTL_ZERO_BYTES = 1 * MiB;
constexpr size_t WS_MOD = 1 * MiB;
constexpr size_t WS_WRH = 1 * MiB + 128 * 1024;
constexpr size_t WS_WRL = 1 * MiB + 192 * 1024;
constexpr size_t WS_PE = 1 * MiB + 256 * 1024;
constexpr size_t WS_PSLOT = WS_PE + 256 * 1024;
constexpr size_t WS_PW = WS_PSLOT + 256 * 1024;
constexpr size_t WS_WIN = 2 * MiB;
constexpr size_t WS_WOUT = 8 * MiB;
constexpr size_t WS_WGU = 10 * MiB;
constexpr size_t WS_WDN = 74 * MiB;
constexpr size_t WS_HX2 = 106 * MiB;
constexpr size_t WS_HX2F = 138 * MiB;
constexpr size_t WS_U = 138 * MiB;
constexpr size_t WS_YB = 154 * MiB;
constexpr size_t WS_P = 234 * MiB;
constexpr size_t WS_X1B = 234 * MiB;
constexpr size_t WS_H = 298 * MiB;
constexpr size_t WS_HX = 336 * MiB;
constexpr size_t WS_ST = 370 * MiB;
constexpr size_t WS_DD = 405 * MiB;
constexpr size_t WS_A2 = 406 * MiB;
constexpr size_t WS_YX = 438 * MiB;
constexpr size_t WS_YXB = 470 * MiB;
constexpr size_t WS_RTOK = 502 * MiB;
constexpr size_t WS_END = 504 * MiB;
static_assert(WS_YB + (size_t)HROWS * 1024 * 2 <= WS_H && WS_H + (size_t)HROWS * 1024 <= WS_ST, "MoE buffers");
static_assert(WS_P + (size_t)MTOT * NIN * 2 <= WS_HX && WS_HX + (size_t)MTOT * D * 2 <= WS_ST && WS_ST + (size_t)32 * NBLK * 16384 * 4 <= WS_DD, "ws map");
constexpr float WSCALE = 256.0f, WSCALE_INV = 1.0f / 256.0f;

constexpr int CW_BAR = 4096;
constexpr int CW_CNT = 8192;
constexpr int CW_MT = 32768;
constexpr int CW_MOD = 12800;
constexpr int CW_CTX = 12288;

constexpr int RING_BYTES = 131072;
constexpr int LDS_TAB = RING_BYTES;
constexpr int LDS_MISC = RING_BYTES + 4096;
constexpr int LDS_BIAS = RING_BYTES + 1024;
constexpr int LDS_GOFF = RING_BYTES + 6144;
constexpr int LDS_BYTES = 155648;
static_assert(LDS_GOFF + 2 * 512 * 16 <= LDS_BYTES, "LDS map");
static_assert(8 * 16384 <= RING_BYTES, "per-wave scratch stays below the LDS tables / control words");

typedef float f32x2_ __attribute__((ext_vector_type(2)));
typedef __bf16 bf16x2_ __attribute__((ext_vector_type(2)));
__device__ __forceinline__ unsigned cvt_pk_bf16(float lo, float hi) { const bf16x2_ r = __builtin_convertvector((f32x2_){lo, hi}, bf16x2_); return __builtin_bit_cast(unsigned, r); }
__device__ __forceinline__ float bf2f(unsigned short b) { return __uint_as_float(((unsigned)b) << 16); }
__device__ __forceinline__ float bflo(unsigned w) { return __uint_as_float(w << 16); }
__device__ __forceinline__ float bfhi(unsigned w) { return __uint_as_float(w & 0xffff0000u); }
__device__ __forceinline__ unsigned short f2bf(float f) { return (unsigned short)(cvt_pk_bf16(f, 0.f) & 0xffffu); }
__device__ __forceinline__ unsigned pk4_fp8(float a, float b, float c, float d) { int w = __builtin_amdgcn_cvt_pk_fp8_f32(a, b, 0, false); w = __builtin_amdgcn_cvt_pk_fp8_f32(c, d, w, true); return (unsigned)w; }
__device__ __forceinline__ float sigmoidf_(float x) { return __builtin_amdgcn_rcpf(1.0f + __builtin_amdgcn_exp2f(-1.44269504089f * x)); }
__device__ __forceinline__ float wave_sum(float v) {
#pragma unroll
    for (int o = 1; o < 64; o <<= 1) v += __shfl_xor(v, o);
    return v;
}
#define TOUCH4(v) asm volatile("" : "+v"((v).x), "+v"((v).y), "+v"((v).z), "+v"((v).w))
#define TOUCH2(v) asm volatile("" : "+v"((v).x), "+v"((v).y))
#define LDS_WAIT() asm volatile("s_waitcnt lgkmcnt(0)" ::: "memory")
#define VM_WAIT() asm volatile("s_waitcnt vmcnt(0)" ::: "memory")
#define LSYNC() do { asm volatile("s_waitcnt lgkmcnt(0)" ::: "memory"); __builtin_amdgcn_s_barrier(); asm volatile("" ::: "memory"); } while (0)

#define XB_TMO      128
#define XB_XCNT(j)  (256  + 64 * (j))
#define XB_XSUB(j)  (1280 + 64 * (j))
#define XB_XGEN(j)  (2304 + 64 * (j))
#define XB_TOP      3328
#define XB_TOPGEN   3392
#define XCD_BAR_WORDS 3456
#define XB_SPIN_CAP (1u << 18)
__device__ __forceinline__ unsigned xb_ld(unsigned* p)              { return __hip_atomic_load(p, __ATOMIC_RELAXED, __HIP_MEMORY_SCOPE_AGENT); }
__device__ __forceinline__ unsigned xb_add(unsigned* p, unsigned v) { return __hip_atomic_fetch_add(p, v, __ATOMIC_RELAXED, __HIP_MEMORY_SCOPE_AGENT); }
__device__ __forceinline__ unsigned xb_xcc_id() { return (unsigned)__builtin_amdgcn_s_getreg((3 << 11) | 20) & 0xFu; }
#define XB_SPIN(cond, bar) do { unsigned _sp = 0; while (cond) { __builtin_amdgcn_s_sleep(1); \
    if ((++_sp & 255u) == 0u) { if (xb_ld(&(bar)[XB_TMO])) break; if (_sp > XB_SPIN_CAP) { atomicAdd(&(bar)[XB_TMO], 1u); break; } } } } while (0)
struct XcdBarrier { unsigned* bar; unsigned x; volatile LAS unsigned* st; };
__device__ __forceinline__ XcdBarrier xcd_barrier_post(unsigned* bar, volatile LAS unsigned* st) {
    XcdBarrier b; b.bar = bar; b.x = xb_xcc_id(); b.st = st;
    if (threadIdx.x == 0) (void)xb_add(&bar[XB_XCNT(b.x)], 1u);
    return b;
}
__device__ __forceinline__ void xcd_barrier_complete(unsigned* bar, unsigned x, unsigned& nloc, unsigned& nx) {
    const unsigned G = gridDim.x * gridDim.y * gridDim.z;
    unsigned sum, cnt, mine, sp = 0u;
    for (;;) {
        sum = 0u; cnt = 0u; mine = 0u;
#pragma unroll
        for (unsigned j = 0; j < 16; ++j) { const unsigned c = xb_ld(&bar[XB_XCNT(j)]); sum += c; cnt += (c > 0u) ? 1u : 0u; mine = (j == x) ? c : mine; }
        if (sum == G) break;
        __builtin_amdgcn_s_sleep(1);
        if ((++sp & 255u) == 0u) { if (xb_ld(&bar[XB_TMO])) break; if (sp > XB_SPIN_CAP) { atomicAdd(&bar[XB_TMO], 1u); break; } }
    }
    nloc = mine > 0u ? mine : 1u; nx = cnt > 0u ? cnt : 1u;
}
__device__ __forceinline__ void xcd_arrive(const XcdBarrier& b) {
    asm volatile("s_waitcnt vmcnt(0)" ::: "memory");
    __syncthreads();
    if (threadIdx.x == 0) {
        unsigned* bar = b.bar;
        __builtin_amdgcn_s_waitcnt(0);
        unsigned nloc = b.st[0], nx = b.st[1];
        if (nloc == 0u) { xcd_barrier_complete(bar, b.x, nloc, nx); b.st[0] = nloc; b.st[1] = nx; }
        const unsigned old = xb_add(&bar[XB_XSUB(b.x)], 1u);
        const unsigned gen = old / nloc;
        if (old + 1u == (gen + 1u) * nloc) {
            __builtin_amdgcn_fence(__ATOMIC_RELEASE, "agent");
            asm volatile("s_waitcnt vmcnt(0)" ::: "memory");
#pragma unroll
            for (unsigned j = 0; j < 16; ++j) (void)xb_add(&bar[XB_XGEN(j)], 1u);
        }
        b.st[2] = nx * (gen + 1u);
    }
}
__device__ __forceinline__ void xcd_wait(const XcdBarrier& b) {
    if (threadIdx.x == 0) {
        unsigned* bar = b.bar;
        const unsigned need = b.st[2];
        XB_SPIN((int)(xb_ld(&bar[XB_XGEN(b.x)]) - need) < 0, bar);
        __builtin_amdgcn_fence(__ATOMIC_ACQUIRE, "agent");
        asm volatile("s_waitcnt vmcnt(0)" ::: "memory");
    }
    __syncthreads();
}
__device__ __forceinline__ void xcd_barrier(const XcdBarrier& b) { xcd_arrive(b); xcd_wait(b); }

namespace pg8 {
constexpr int BM = 256, BK = 64, HALF = 128, HTB = HALF * BK * 2, STAGE_BYTES = 8 * HTB, NXCD = 8, WGM = 8;
__host__ __device__ __forceinline__ int lds_byte(int r, int c) { const int st = (r >> 4) * 2 + (c >> 5), rr = r & 15, cc = c & 31, ob = rr * 64 + cc * 2; return st * 1024 + (ob ^ (((ob >> 9) & 1) << 5)); }
__host__ __device__ __forceinline__ void stage_rc(int b, int& R, int& C) { const int st = b / 1024, sb = b % 1024, swz = sb ^ (((sb >> 9) & 1) << 5); R = (st >> 1) * 16 + swz / 64; C = (st & 1) * 32 + (swz % 64) / 2; }
__host__ __device__ __forceinline__ int perm32(int rho) { const int n = rho >> 4, i = rho & 15; return 8 * (i >> 2) + 4 * n + (i & 3); }

struct UnitS { const char* A; const char* B; int pm, pn; };
struct StaticOrder {
    typedef UnitS Unit;
    const char* Abase; const char* Bbase; size_t tstep;
    int nM, nN, nwg, G, c;
    __device__ void init(const void* A, const void* Bt, int M_, int N_, int K_, int G_, int c_) { Abase = (const char*)A; Bbase = (const char*)Bt; tstep = (size_t)BM * K_ * 2; nM = M_ / BM; nN = N_ / BM; nwg = nM * nN; G = G_; c = c_; }
    __device__ bool next(int i, Unit& u) const {
        const long L = (long)i * G + c; if (L >= nwg) return false;
        int wgid = (int)L; { const int q = nwg / NXCD, r = nwg % NXCD, xcd = wgid % NXCD, off = wgid / NXCD; wgid = (xcd < r ? xcd * (q + 1) : r * (q + 1) + (xcd - r) * q) + off; }
        const int nig = WGM * nN, gid = wgid / nig, fm = gid * WGM, gsz = (nM - fm) < WGM ? (nM - fm) : WGM;
        u.pm = fm + ((wgid % nig) % gsz); u.pn = (wgid % nig) / gsz;
        u.A = Abase + (size_t)u.pm * tstep; u.B = Bbase + (size_t)u.pn * tstep; return true;
    }
    static constexpr bool PUBLISH = false;
    __device__ __forceinline__ const int* row_src(const Unit&, int) const { return nullptr; }
    __device__ __forceinline__ unsigned row_tok(const Unit&, int) const { return 0u; }
    __device__ __forceinline__ void a_ready(const Unit&, int) const {}
    __device__ __forceinline__ int key(const Unit&) const { return 0; }
    __device__ __forceinline__ void publish(int) const {}
};

struct OneUnit { typedef UnitS Unit; UnitS u; static constexpr bool PUBLISH = false;
    __device__ bool next(int i, Unit& o) const { if (i) return false; o = u; return true; }
    __device__ __forceinline__ const int* row_src(const Unit&, int) const { return nullptr; } __device__ __forceinline__ unsigned row_tok(const Unit&, int) const { return 0u; }
    __device__ __forceinline__ void a_ready(const Unit&, int) const {} __device__ __forceinline__ int key(const Unit&) const { return 0; } __device__ __forceinline__ void publish(int) const {} };
struct P2Order { typedef UnitS Unit; StaticOrder S; UnitS cu; bool ctx; static constexpr bool PUBLISH = false;
    __device__ bool next(int i, Unit& o) const { if (i < 3) return S.next(i, o); if (i == 3 && ctx) { o = cu; return true; } return false; }
    __device__ __forceinline__ const int* row_src(const Unit&, int) const { return nullptr; } __device__ __forceinline__ unsigned row_tok(const Unit&, int) const { return 0u; }
    __device__ __forceinline__ void a_ready(const Unit&, int) const {} __device__ __forceinline__ int key(const Unit&) const { return 0; } __device__ __forceinline__ void publish(int) const {} };
typedef int i32x4 __attribute__((ext_vector_type(4)));
typedef int i32x8 __attribute__((ext_vector_type(8)));
template <class Epi, class Sched, bool GATHER, bool ALIGN_EPI, bool SP2, bool FP8 = false>
__device__ __forceinline__ void gemm_phase(LAS unsigned char* lds, const int K, const Sched& S, const Epi& E) {
    typedef typename Sched::Unit Unit;
    const int tid = threadIdx.x, wid = __builtin_amdgcn_readfirstlane(tid >> 6), lane = tid & 63, wr = wid >> 2, wc = wid & 3, fr = lane & 15, fq = lane >> 4;
    const int nt = K / BK;
    const size_t kstep = (size_t)(BK * 2);
    const size_t kstepB = FP8 ? (size_t)4096 : kstep;
    const size_t hstep = (size_t)HALF * K * 2;
    unsigned voffB[2], cA0[2], cA1[2];
#pragma unroll
    for (int i = 0; i < 2; ++i) { int R, C; stage_rc(tid * 16 + i * 8192, R, C); const int Rb = Epi::PERM ? ((R & ~31) + perm32(R & 31)) : R;
        voffB[i] = FP8 ? (unsigned)((Rb >> 5) * 32768 + (Rb & 31) * 128 + C * 2) : (unsigned)(Rb * K + C) * 2u; cA0[i] = (unsigned)(R * K + C) * 2u; cA1[i] = cA0[i] + (unsigned)hstep; }
#define gro(p, v) ((LAS unsigned*)(lds + LDS_GOFF + (p) * 8192 + (v) * 2048 + tid * 4))
    int gp = 0;
    unsigned gcc[2] = {0u, 0u};
    if constexpr (GATHER) { int R, C; stage_rc(tid * 16, R, C); gcc[0] = (unsigned)C * 2u; stage_rc(tid * 16 + 8192, R, C); gcc[1] = (unsigned)C * 2u; }
    const unsigned ldsw = (unsigned)wid * 1024u;
    const int aoff = lds_byte(wr * 64 + fr, fq * 8), boff = lds_byte(wc * 32 + fr, fq * 8);
#define PG8_SA(b, h) (((b) * 2 + (h)) * HTB)
#define PG8_SB(b, h) ((4 + (b) * 2 + (h)) * HTB)
#define PG8_STAGE(bufoff, gbase, voff) do { _Pragma("unroll") for (int _i = 0; _i < 2; ++_i) \
        __builtin_amdgcn_global_load_lds((const unsigned*)((const char*)(gbase) + (voff)[_i]), (LAS unsigned*)(lds + (bufoff) + ldsw + _i * 8192), 16, 0, 0); } while (0)
#define PG8_LDA(dst, b, h) do { _Pragma("unroll") for (int m = 0; m < 4; ++m) { const i32x4 _p0 = *(const LAS i32x4*)(lds + PG8_SA(b, h) + aoff + m * 2048), _p1 = *(const LAS i32x4*)(lds + PG8_SA(b, h) + aoff + m * 2048 + 1024); \
        dst[m] = __builtin_shufflevector(_p0, _p1, 0, 1, 2, 3, 4, 5, 6, 7); } } while (0)
#define PG8_LDB(dst, b, h) do { _Pragma("unroll") for (int n = 0; n < 2; ++n) { const i32x4 _p0 = *(const LAS i32x4*)(lds + PG8_SB(b, h) + boff + n * 2048), _p1 = *(const LAS i32x4*)(lds + PG8_SB(b, h) + boff + n * 2048 + 1024); \
        dst[n] = __builtin_shufflevector(_p0, _p1, 0, 1, 2, 3, 4, 5, 6, 7); } } while (0)
#define PG8_ACC(ai, bj, m, n) ((n) ? __builtin_shufflevector(acc[ai][bj][m], acc[ai][bj][m], 4, 5, 6, 7) : __builtin_shufflevector(acc[ai][bj][m], acc[ai][bj][m], 0, 1, 2, 3))
#define PG8_SETACC(ai, bj, m, n, v) do { const f32x4 _v = (v); if (n) acc[ai][bj][m] = __builtin_shufflevector(acc[ai][bj][m], __builtin_shufflevector(_v, _v, 0, 1, 2, 3, 0, 1, 2, 3), 0, 1, 2, 3, 12, 13, 14, 15); \
        else acc[ai][bj][m] = __builtin_shufflevector(acc[ai][bj][m], __builtin_shufflevector(_v, _v, 0, 1, 2, 3, 0, 1, 2, 3), 8, 9, 10, 11, 4, 5, 6, 7); } while (0)
#define PG8_MMA(ai, bj, At, Bt) do { __builtin_amdgcn_s_setprio(1); _Pragma("unroll") for (int m = 0; m < 4; ++m) _Pragma("unroll") for (int n = 0; n < 2; ++n) { \
        if constexpr (FP8) { PG8_SETACC(ai, bj, m, n, __builtin_amdgcn_mfma_scale_f32_16x16x128_f8f6f4(Bt[n], At[m], PG8_ACC(ai, bj, m, n), 0, 0, 0, 127, 0, 127)); } \
        else { f32x4 _c = __builtin_amdgcn_mfma_f32_16x16x32_bf16(__builtin_bit_cast(bf16x8, __builtin_shufflevector(Bt[n], Bt[n], 0, 1, 2, 3)), __builtin_bit_cast(bf16x8, __builtin_shufflevector(At[m], At[m], 0, 1, 2, 3)), PG8_ACC(ai, bj, m, n), 0, 0, 0); \
               PG8_SETACC(ai, bj, m, n, __builtin_amdgcn_mfma_f32_16x16x32_bf16(__builtin_bit_cast(bf16x8, __builtin_shufflevector(Bt[n], Bt[n], 4, 5, 6, 7)), __builtin_bit_cast(bf16x8, __builtin_shufflevector(At[m], At[m], 4, 5, 6, 7)), _c, 0, 0, 0)); } } \
        __builtin_amdgcn_s_setprio(0); } while (0)
#define PG8_WAIT_V(n) asm volatile("s_waitcnt vmcnt(" #n ")" ::: "memory")
#define PG8_WAIT_L(n) asm volatile("s_waitcnt lgkmcnt(" #n ")" ::: "memory")
#define PG8_BAR __builtin_amdgcn_s_barrier()
#define PG8_SCHED __builtin_amdgcn_sched_barrier(0)
    Unit cur, nxt; int ui = 0; int pkey = 0;
    if (!S.next(0, cur)) return;
    S.a_ready(cur, wid);
    if constexpr (GATHER) {
#pragma unroll
        for (int i = 0; i < 2; ++i) { int R, C; int t2 = tid; asm volatile("" : "+v"(t2)); stage_rc(t2 * 16 + i * 8192, R, C);
            const unsigned r0 = S.row_tok(cur, R), r1 = S.row_tok(cur, HALF + R); *gro(0, i) = r0; *gro(0, 2 + i) = r1;
            cA0[i] = r0 + (unsigned)C * 2u; cA1[i] = r1 + (unsigned)C * 2u; }
    }
    typedef float f32x8_ __attribute__((ext_vector_type(8)));
    f32x8_ acc[2][2][4];
    float zero_; asm volatile("v_mov_b32 %0, 0" : "=v"(zero_));
#pragma unroll
    for (int a = 0; a < 2; ++a)
#pragma unroll
        for (int b = 0; b < 2; ++b)
#pragma unroll
            for (int m = 0; m < 4; ++m) acc[a][b][m] = (f32x8_){zero_, zero_, zero_, zero_, zero_, zero_, zero_, zero_};
    i32x8 At[4], B0[2], B1[2];
    const char* cA = cur.A; const char* cB = cur.B;
    if constexpr (Epi::LDS_BIAS) E.stage_bias(cur, lds + LDS_BIAS, wid, lane);
    if constexpr (SP2) {
        PG8_STAGE(PG8_SB(0, 0), cB, voffB); PG8_STAGE(PG8_SB(0, 1), cB + hstep, voffB); PG8_STAGE(PG8_SA(0, 0), cA, cA0); PG8_STAGE(PG8_SA(0, 1), cA, cA1);
        if (wr == 1) PG8_BAR;
        PG8_WAIT_V(2); PG8_BAR;
        PG8_STAGE(PG8_SB(1, 0), cB + kstepB, voffB); PG8_STAGE(PG8_SA(1, 0), cA + kstep, cA0); PG8_STAGE(PG8_SB(1, 1), cB + hstep + kstepB, voffB);
        PG8_WAIT_V(6); PG8_BAR;
    } else {
        PG8_STAGE(PG8_SB(0, 0), cB, voffB); PG8_STAGE(PG8_SA(0, 0), cA, cA0); PG8_STAGE(PG8_SB(0, 1), cB + hstep, voffB); PG8_STAGE(PG8_SA(0, 1), cA, cA1);
        if (wr == 1) PG8_BAR;
        PG8_WAIT_V(4); PG8_BAR;
        PG8_STAGE(PG8_SB(1, 0), cB + kstepB, voffB); PG8_STAGE(PG8_SA(1, 0), cA + kstep, cA0); PG8_STAGE(PG8_SB(1, 1), cB + hstep + kstepB, voffB);
        PG8_WAIT_V(6); PG8_BAR;
    }
    for (;;) {
        const bool has_next = S.next(ui + 1, nxt);
        const char* nA = has_next ? nxt.A : cA; const char* nB = has_next ? nxt.B : cB;
        if constexpr (GATHER) {
            if (has_next) {
                int R0, C0, R1, C1; int t2 = tid; asm volatile("" : "+v"(t2)); stage_rc(t2 * 16, R0, C0); stage_rc(t2 * 16 + 8192, R1, C1);
                LAS unsigned char* gb = lds + LDS_GOFF + (gp ^ 1) * 8192 + wid * 256;
                __builtin_amdgcn_global_load_lds((const unsigned*)S.row_src(nxt, R0), (LAS unsigned*)(gb), 4, 0, 0);
                __builtin_amdgcn_global_load_lds((const unsigned*)S.row_src(nxt, R1), (LAS unsigned*)(gb + 2048), 4, 0, 0);
                __builtin_amdgcn_global_load_lds((const unsigned*)S.row_src(nxt, HALF + R0), (LAS unsigned*)(gb + 4096), 4, 0, 0);
                __builtin_amdgcn_global_load_lds((const unsigned*)S.row_src(nxt, HALF + R1), (LAS unsigned*)(gb + 6144), 4, 0, 0);
            }
        }
#pragma unroll 1
        for (int t = 0; t < nt; t += 2) {
            const bool last = (t == nt - 2);
            if (last && has_next) S.a_ready(nxt, wid);
            const char* a1 = cA + (size_t)(t + 1) * kstep;
            const char* a2 = last ? nA : cA + (size_t)(t + 2) * kstep; const char* b2 = last ? nB : cB + (size_t)(t + 2) * kstepB;
            const char* a3 = a2 + kstep; const char* b3 = b2 + kstepB;
            const int gq = (last && has_next) ? (gp ^ 1) : gp;
#define PG8_GO(p, v, dst) unsigned dst[2]; if constexpr (GATHER) { dst[0] = *gro(p, v) + gcc[0]; dst[1] = *gro(p, (v) + 1) + gcc[1]; } else { dst[0] = ((v) ? cA1 : cA0)[0]; dst[1] = ((v) ? cA1 : cA0)[1]; }
            if constexpr (SP2) {
            { PG8_GO(gp, 2, y1); PG8_LDB(B0, 0, 0); PG8_LDB(B1, 0, 1); PG8_SCHED; PG8_LDA(At, 0, 0); PG8_STAGE(PG8_SA(1, 1), a1, y1); }
            PG8_WAIT_V(8); PG8_WAIT_L(0); PG8_BAR; PG8_MMA(0, 0, At, B0); PG8_MMA(0, 1, At, B1); PG8_BAR; PG8_SCHED;
            { PG8_GO(gq, 0, x0); PG8_LDA(At, 0, 1); PG8_STAGE(PG8_SB(0, 0), b2, voffB); PG8_STAGE(PG8_SB(0, 1), b2 + hstep, voffB); PG8_STAGE(PG8_SA(0, 0), a2, x0); }
            PG8_WAIT_V(8); PG8_WAIT_L(0); PG8_BAR; PG8_MMA(1, 0, At, B0); PG8_MMA(1, 1, At, B1); PG8_BAR; PG8_SCHED;
            { PG8_GO(gq, 2, x1); PG8_LDB(B0, 1, 0); PG8_LDB(B1, 1, 1); PG8_SCHED; PG8_LDA(At, 1, 0); PG8_STAGE(PG8_SA(0, 1), a2, x1); }
            PG8_WAIT_V(8); PG8_WAIT_L(0); PG8_BAR; PG8_MMA(0, 0, At, B0); PG8_MMA(0, 1, At, B1); PG8_BAR; PG8_SCHED;
            { PG8_GO(gq, 0, x0); PG8_LDA(At, 1, 1); PG8_STAGE(PG8_SB(1, 0), b3, voffB); PG8_STAGE(PG8_SB(1, 1), b3 + hstep, voffB); PG8_STAGE(PG8_SA(1, 0), a3, x0); }
            PG8_WAIT_V(8); PG8_WAIT_L(0); PG8_BAR; PG8_MMA(1, 0, At, B0); PG8_MMA(1, 1, At, B1); PG8_BAR; PG8_SCHED;
            } else {
            PG8_GO(gp, 2, y1); PG8_GO(gq, 0, x0); PG8_GO(gq, 2, x1);
            PG8_LDB(B0, 0, 0); PG8_SCHED; PG8_LDA(At, 0, 0); PG8_STAGE(PG8_SA(1, 1), a1, y1);
            PG8_WAIT_L(8); PG8_BAR; PG8_WAIT_L(0); PG8_MMA(0, 0, At, B0); PG8_BAR; PG8_SCHED;
            PG8_LDB(B1, 0, 1); PG8_STAGE(PG8_SB(0, 0), b2, voffB);
            PG8_BAR; PG8_WAIT_L(0); PG8_MMA(0, 1, At, B1); PG8_BAR;
            PG8_LDA(At, 0, 1); PG8_STAGE(PG8_SA(0, 0), a2, x0);
            PG8_BAR; PG8_WAIT_L(0); PG8_MMA(1, 0, At, B0); PG8_BAR; PG8_SCHED;
            PG8_STAGE(PG8_SB(0, 1), b2 + hstep, voffB);
            PG8_WAIT_V(6); PG8_BAR; PG8_MMA(1, 1, At, B1); PG8_BAR;
            PG8_LDB(B0, 1, 0); PG8_SCHED; PG8_LDA(At, 1, 0); PG8_STAGE(PG8_SA(0, 1), a2, x1);
            PG8_WAIT_L(8); PG8_BAR; PG8_WAIT_L(0); PG8_MMA(0, 0, At, B0); PG8_BAR; PG8_SCHED;
            PG8_LDB(B1, 1, 1); PG8_STAGE(PG8_SB(1, 0), b3, voffB);
            PG8_BAR; PG8_WAIT_L(0); PG8_MMA(0, 1, At, B1); PG8_BAR;
            PG8_LDA(At, 1, 1); PG8_STAGE(PG8_SA(1, 0), a3, x0);
            PG8_BAR; PG8_WAIT_L(0); PG8_MMA(1, 0, At, B0); PG8_BAR; PG8_SCHED;
            PG8_STAGE(PG8_SB(1, 1), b3 + hstep, voffB);
            PG8_WAIT_V(6); PG8_BAR; PG8_MMA(1, 1, At, B1); PG8_BAR;
            }
        }
        if constexpr (ALIGN_EPI) { if (wr == 0) PG8_BAR; }
        asm volatile("" ::: "memory");
        if constexpr (Sched::PUBLISH) { if (ui > 0) S.publish(pkey); }
        { f32x4 av[2][2][4][2];
#pragma unroll
          for (int a = 0; a < 2; ++a)
#pragma unroll
              for (int b = 0; b < 2; ++b)
#pragma unroll
                  for (int m = 0; m < 4; ++m) { av[a][b][m][0] = PG8_ACC(a, b, m, 0); av[a][b][m][1] = PG8_ACC(a, b, m, 1); }
          int t3 = tid; asm volatile("" : "+v"(t3)); const int fr3 = t3 & 15, fq3 = (t3 & 63) >> 4;
          if constexpr (Epi::LDS_BIAS) E(av, cur, wr, wc, fr3, fq3, lds + LDS_BIAS + (ui & 1) * 1024); else E(av, cur, wr, wc, fr3, fq3); }
        if constexpr (Sched::PUBLISH) { pkey = S.key(cur); if (!has_next) S.publish(pkey); }
        if (!has_next) break;
#pragma unroll
        for (int a = 0; a < 2; ++a)
#pragma unroll
            for (int b = 0; b < 2; ++b)
#pragma unroll
                for (int m = 0; m < 4; ++m) acc[a][b][m] = (f32x8_){zero_, zero_, zero_, zero_, zero_, zero_, zero_, zero_};
        cur = nxt; cA = nA; cB = nB; ++ui;
        if constexpr (Epi::LDS_BIAS) E.stage_bias(cur, lds + LDS_BIAS + (ui & 1) * 1024, wid, lane);
        if constexpr (GATHER) gp ^= 1;
        if constexpr (ALIGN_EPI) { if (wr == 1) PG8_BAR; }
    }
    PG8_WAIT_V(0);
    if constexpr (!ALIGN_EPI) { if (wr == 0) PG8_BAR; }
    PG8_BAR;
#undef PG8_SA
#undef PG8_SB
#undef PG8_STAGE
#undef PG8_LDA
#undef PG8_LDB
#undef PG8_MMA
#undef gro
#undef PG8_GO
#undef PG8_ACC
#undef PG8_SETACC
#undef PG8_WAIT_V
#undef PG8_WAIT_L
#undef PG8_BAR
#undef PG8_SCHED
}
}

struct EpiInProj {
    static constexpr bool PERM = true, LDS_BIAS = false;
    bf16_t* P; const float* lbl; bf16_t* U;
    __device__ __forceinline__ void operator()(const f32x4 (&acc)[2][2][4][2], const pg8::UnitS& u, int wr, int wc, int fr, int fq) const {
        typedef float f32x2 __attribute__((ext_vector_type(2)));
        const int row0 = u.pm * 256 + wr * 64 + fr, col0 = u.pn * 256 + wc * 32 + 8 * fq, type = u.pn >> 1;
        f32x2 lbv[2][4], olb[2][4];
#pragma unroll
        for (int bj = 0; bj < 2; ++bj)
#pragma unroll
            for (int p = 0; p < 4; ++p) { lbv[bj][p] = (f32x2){0.f, 0.f}; olb[bj][p] = (f32x2){1.f, 1.f}; }
        if (type == 1 || type == 2) {
#pragma unroll
            for (int bj = 0; bj < 2; ++bj) { const int ch = col0 + bj * 128 - 512;
#pragma unroll
                for (int p = 0; p < 4; ++p) { lbv[bj][p].x = sigmoidf_(lbl[ch + 2 * p] - lbl[1024 + ch + 2 * p]); lbv[bj][p].y = sigmoidf_(lbl[ch + 2 * p + 1] - lbl[1024 + ch + 2 * p + 1]); olb[bj][p] = 1.0f - lbv[bj][p]; } }
        }
#pragma unroll
        for (int ai = 0; ai < 2; ++ai)
#pragma unroll
            for (int m = 0; m < 4; ++m) { bf16_t* rowp = P + (size_t)(row0 + ai * 128 + m * 16) * NIN + col0;
#pragma unroll
                for (int bj = 0; bj < 2; ++bj) { f32x2 v[4];
#pragma unroll
                    for (int p = 0; p < 4; ++p) { const f32x4 a = acc[ai][bj][m][p >> 1]; v[p] = (p & 1) ? (f32x2){a.z, a.w} : (f32x2){a.x, a.y}; }
                    if (type == 0 || type == 1 || type == 2 || type == 4) {
#pragma unroll
                        for (int p = 0; p < 4; ++p) { const f32x2 ea = v[p] * (-1.44269504089f);
                            f32x2 t; t.x = __builtin_amdgcn_exp2f(ea.x); t.y = __builtin_amdgcn_exp2f(ea.y); t = t + 1.0f;
                            f32x2 sg; sg.x = __builtin_amdgcn_rcpf(t.x); sg.y = __builtin_amdgcn_rcpf(t.y);
                            if (type == 0) v[p] = v[p] * sg;
                            else if (type == 4) v[p] = sg;
                            else { const f32x2 f = sg * olb[bj][p] + lbv[bj][p]; f32x2 lg; lg.x = __builtin_amdgcn_logf(f.x); lg.y = __builtin_amdgcn_logf(f.y); v[p] = lg; } }
                    }
                    u32x4 w; w.x = cvt_pk_bf16(v[0].x, v[0].y); w.y = cvt_pk_bf16(v[1].x, v[1].y); w.z = cvt_pk_bf16(v[2].x, v[2].y); w.w = cvt_pk_bf16(v[3].x, v[3].y);
                    if (type == 5) { const int row = row0 + ai * 128 + m * 16, slab = (col0 + bj * 128 - 2560) >> 3;
                        *(u32x4*)(U + ((size_t)((row >> 12) * 64 + slab) * 4096 + (row & 4095)) * 8) = w; }
                    else *(u32x4*)(rowp + bj * 128) = w; } }
    }
};
struct EpiBf16Out {
    static constexpr bool PERM = true, LDS_BIAS = false;
    bf16_t* C; int ldc;
    __device__ __forceinline__ void operator()(const f32x4 (&acc)[2][2][4][2], const pg8::UnitS& u, int wr, int wc, int fr, int fq) const {
        const int row0 = u.pm * 256 + wr * 64 + fr, col0 = u.pn * 256 + wc * 32 + 8 * fq;
#pragma unroll
        for (int ai = 0; ai < 2; ++ai)
#pragma unroll
            for (int m = 0; m < 4; ++m) { bf16_t* rowp = C + (size_t)(row0 + ai * 128 + m * 16) * ldc + col0;
#pragma unroll
                for (int bj = 0; bj < 2; ++bj) { const f32x4 v0 = acc[ai][bj][m][0], v1 = acc[ai][bj][m][1];
                    u32x4 w; w.x = cvt_pk_bf16(v0[0], v0[1]); w.y = cvt_pk_bf16(v0[2], v0[3]); w.z = cvt_pk_bf16(v1[0], v1[1]); w.w = cvt_pk_bf16(v1[2], v1[3]);
                    *(u32x4*)(rowp + bj * 128) = w; } }
    }
};

struct UnitM { const char* A; const char* B; int e, mt, pn, row0, cnt; };
typedef int i32x4_ __attribute__((ext_vector_type(4)));
template <int NT_, bool GATHER_>
struct MoeOrder {
    typedef UnitM Unit;
    static constexpr int pitch = 1024; static constexpr size_t wstride = (size_t)NT_ * 256 * 1024;
    const LAS int* tab;
    const char* Abase; const char* Wbase; const int* rtok;
    unsigned* mtc;
    int cls, rank, nrank;
    static constexpr bool PUBLISH = GATHER_;
    __device__ __forceinline__ int key(const Unit& u) const { return u.row0 >> 8; }
    __device__ __forceinline__ void publish(int k) const {
        asm volatile("s_waitcnt vmcnt(0)" ::: "memory");
        if ((threadIdx.x & 63) == 0) __hip_atomic_fetch_add(mtc + 64 * k, 1u, __ATOMIC_RELAXED, __HIP_MEMORY_SCOPE_AGENT);
    }
    __device__ __forceinline__ void a_ready(const Unit& u, int wid) const {
        if constexpr (!GATHER_) {
            if (wid == 0) { unsigned sp = 0;
                while ((unsigned)__builtin_amdgcn_readfirstlane(__hip_atomic_load(mtc + 64 * (u.row0 >> 8), __ATOMIC_RELAXED, __HIP_MEMORY_SCOPE_AGENT)) < 64u) { __builtin_amdgcn_s_sleep(2); if (++sp > (1u << 22)) break; }
                __builtin_amdgcn_fence(__ATOMIC_ACQUIRE, "agent");
                asm volatile("s_waitcnt vmcnt(0)" ::: "memory"); }
            asm volatile("" ::: "memory"); __builtin_amdgcn_s_barrier(); asm volatile("" ::: "memory");
        }
    }
    __device__ bool next(int i, Unit& u) const {
        const int L = i * nrank + rank; const int mtg = L / NT_; u.pn = L - mtg * NT_;
        if (mtg >= __builtin_amdgcn_readfirstlane(tab[64])) return false;
        int ecount = 0;
#pragma unroll
        for (int q = 0; q < 8; ++q) { const i32x4_ p4 = *(const LAS i32x4_*)(tab + 32 + 4 * q); const int row = mtg * 256;
            ecount += (p4.x <= row) + (p4.y <= row) + (p4.z <= row) + (p4.w <= row); }
        const int e = __builtin_amdgcn_readfirstlane(ecount) - 1;
        const int pb = __builtin_amdgcn_readfirstlane(tab[32 + e]);
        u.e = e; u.mt = mtg - (pb >> 8); u.cnt = __builtin_amdgcn_readfirstlane(tab[e]); u.row0 = mtg * 256;
        u.B = Wbase + (size_t)e * wstride + (size_t)u.pn * 256 * pitch;
        u.A = GATHER_ ? Abase : Abase + (size_t)u.row0 * pitch;
        return true;
    }
    __device__ __forceinline__ const int* row_src(const Unit& u, int r) const { const int slot = u.mt * 256 + r; return rtok + u.e * ECAP + (slot < u.cnt ? slot : 0); }
    __device__ __forceinline__ unsigned row_tok(const Unit& u, int r) const { return (unsigned)*row_src(u, r); }
};
struct EpiGateUp {
    static constexpr bool PERM = true, LDS_BIAS = true;
    unsigned char* H; const float* bg; const float* bu;
    __device__ __forceinline__ void stage_bias(const UnitM& u, LAS unsigned char* dst, int wid, int lane) const {
        if (wid < 4) { const float* src = ((wid & 2) ? bu : bg) + u.e * FF + u.pn * 128 + (wid & 1) * 64 + lane;
            __builtin_amdgcn_global_load_lds((const unsigned*)src, (LAS unsigned*)(dst + wid * 256), 4, 0, 0); }
    }
    __device__ __forceinline__ void operator()(const f32x4 (&acc)[2][2][4][2], const UnitM& u, int wr, int wc, int fr, int fq, const LAS unsigned char* lb) const {
        typedef float f32x2 __attribute__((ext_vector_type(2)));
        const int row0 = u.row0 + wr * 64 + fr, col0 = u.pn * 128 + wc * 32 + 8 * fq;
        const f32x4 g0 = *(const LAS f32x4*)(lb + (wc * 32 + 8 * fq) * 4), g1 = *(const LAS f32x4*)(lb + (wc * 32 + 8 * fq + 4) * 4);
        const f32x4 u0 = *(const LAS f32x4*)(lb + 512 + (wc * 32 + 8 * fq) * 4), u1 = *(const LAS f32x4*)(lb + 512 + (wc * 32 + 8 * fq + 4) * 4);
        const f32x2 gb[4] = {{g0.x, g0.y}, {g0.z, g0.w}, {g1.x, g1.y}, {g1.z, g1.w}}, ub[4] = {{u0.x + 1.0f, u0.y + 1.0f}, {u0.z + 1.0f, u0.w + 1.0f}, {u1.x + 1.0f, u1.y + 1.0f}, {u1.z + 1.0f, u1.w + 1.0f}};
        unsigned pw0 = 0u, pw1 = 0u;
#pragma unroll
        for (int ai = 0; ai < 2; ++ai)
#pragma unroll
            for (int m = 0; m < 4; ++m) { f32x2 h[4];
#pragma unroll
                for (int p = 0; p < 4; ++p) {
                    const f32x4 ag = acc[ai][0][m][p >> 1], au = acc[ai][1][m][p >> 1];
                    f32x2 g = (p & 1) ? (f32x2){ag.z, ag.w} : (f32x2){ag.x, ag.y}, up1 = (p & 1) ? (f32x2){au.z, au.w} : (f32x2){au.x, au.y};
                    g = g * WSCALE_INV + gb[p]; up1 = up1 * WSCALE_INV + ub[p];
                    g.x = fminf(g.x, 7.0f); g.y = fminf(g.y, 7.0f);
                    up1.x = __builtin_amdgcn_fmed3f(up1.x, -6.0f, 8.0f); up1.y = __builtin_amdgcn_fmed3f(up1.y, -6.0f, 8.0f);
                    const f32x2 ea = g * (-1.702f * 1.44269504089f);
                    f32x2 t; t.x = __builtin_amdgcn_exp2f(ea.x); t.y = __builtin_amdgcn_exp2f(ea.y);
                    t = t + 1.0f;
                    f32x2 sg; sg.x = __builtin_amdgcn_rcpf(t.x); sg.y = __builtin_amdgcn_rcpf(t.y);
                    h[p] = (up1 * g) * sg; }
                const unsigned w0 = pk4_fp8(h[0].x, h[0].y, h[1].x, h[1].y), w1 = pk4_fp8(h[2].x, h[2].y, h[3].x, h[3].y);
                if ((m & 1) == 0) { pw0 = w0; pw1 = w1; }
                else { const auto r0 = __builtin_amdgcn_permlane16_swap(pw0, w0, false, false), r1 = __builtin_amdgcn_permlane16_swap(pw1, w1, false, false);
                    u32x4 wv; wv.x = r0[0]; wv.y = r1[0]; wv.z = r0[1]; wv.w = r1[1];
                    const unsigned long long ad = (unsigned long long)(H + (size_t)(row0 + ai * 128 + (m - 1 + (fq & 1)) * 16) * FF + col0 - 8 * (fq & 1));
                    asm volatile("global_store_dwordx4 %0, %1, off sc1\n\ts_nop 2" :: "v"(ad), "v"(wv) : "memory"); } }
    }
};
struct EpiDown {
    static constexpr bool PERM = true, LDS_BIAS = true;
    unsigned char* Y; const float* bd;
    __device__ __forceinline__ void stage_bias(const UnitM& u, LAS unsigned char* dst, int wid, int lane) const {
        if (wid < 4) { const float* src = bd + u.e * D + u.pn * 256 + wid * 64 + lane;
            __builtin_amdgcn_global_load_lds((const unsigned*)src, (LAS unsigned*)(dst + wid * 256), 4, 0, 0); }
    }
    __device__ __forceinline__ void operator()(const f32x4 (&acc)[2][2][4][2], const UnitM& u, int wr, int wc, int fr, int fq, const LAS unsigned char* lb) const {
        const int row0 = u.row0 + wr * 64 + fr, col0 = u.pn * 256 + wc * 32 + 8 * fq;
        f32x4 b8[2][2];
#pragma unroll
        for (int bj = 0; bj < 2; ++bj) { b8[bj][0] = *(const LAS f32x4*)(lb + (bj * 128 + wc * 32 + 8 * fq) * 4); b8[bj][1] = *(const LAS f32x4*)(lb + (bj * 128 + wc * 32 + 8 * fq + 4) * 4); }
        u32x2 pw[2];
#pragma unroll
        for (int ai = 0; ai < 2; ++ai)
#pragma unroll
            for (int m = 0; m < 4; ++m)
#pragma unroll
                for (int bj = 0; bj < 2; ++bj) { const f32x4 v0 = acc[ai][bj][m][0] * WSCALE_INV + b8[bj][0], v1 = acc[ai][bj][m][1] * WSCALE_INV + b8[bj][1];
                    u32x2 w; w.x = pk4_fp8(v0.x, v0.y, v0.z, v0.w); w.y = pk4_fp8(v1.x, v1.y, v1.z, v1.w);
                    if ((m & 1) == 0) pw[bj] = w;
                    else { const auto r0 = __builtin_amdgcn_permlane16_swap(pw[bj].x, w.x, false, false), r1 = __builtin_amdgcn_permlane16_swap(pw[bj].y, w.y, false, false);
                        u32x4 wv; wv.x = r0[0]; wv.y = r1[0]; wv.z = r0[1]; wv.w = r1[1];
                        *(u32x4*)(Y + (size_t)(row0 + ai * 128 + (m - 1 + (fq & 1)) * 16) * D + col0 - 8 * (fq & 1) + bj * 128) = wv; } }
    }
};

struct Args { const float* in[24]; float* out; unsigned char* ws; int ph_lo, ph_hi, li, pad; };
struct Frame {
    LAS unsigned char* lds; unsigned char* ws; unsigned* ctl;
    int tid, lane, wave, G, bid;
};

struct TItem { const float* src; unsigned char* dst; int ldw, k0, n0, drow0; };
template <int NL> __device__ __forceinline__ void titem_load(const TItem& t, float (&tv)[NL], int lane) {
    const float* wp = t.src + (size_t)(t.k0 + (lane >> 5)) * t.ldw + t.n0 + (lane & 31);
#pragma unroll
    for (int i = 0; i < NL; ++i) tv[i] = wp[(size_t)(2 * i) * t.ldw];
}
__device__ __forceinline__ void titem_finish_bf16(const TItem& t, const float (&tv)[32], LAS float* scr, int lane) {
#pragma unroll
    for (int i = 0; i < 32; ++i) scr[(2 * i + (lane >> 5)) * 33 + (lane & 31)] = tv[i];
    LDS_WAIT(); asm volatile("" ::: "memory");
    const int c = lane & 7;
#pragma unroll
    for (int j = 0; j < 4; ++j) { const int n = (lane >> 3) + 8 * j; const LAS float* s = scr + (8 * c) * 33 + n;
        u32x4 o; o.x = cvt_pk_bf16(s[0 * 33], s[1 * 33]); o.y = cvt_pk_bf16(s[2 * 33], s[3 * 33]); o.z = cvt_pk_bf16(s[4 * 33], s[5 * 33]); o.w = cvt_pk_bf16(s[6 * 33], s[7 * 33]);
        *(u32x4*)(t.dst + ((size_t)(t.drow0 + n) * 1024 + t.k0 + 8 * c) * 2) = o; }
    LDS_WAIT(); asm volatile("" ::: "memory");
}
__device__ __forceinline__ void titem_load_fp8(const TItem& t, f32x4 (&tv)[16], int lane) {
    const float* wp = t.src + (size_t)(t.k0 + (lane >> 3)) * t.ldw + t.n0 + 4 * (lane & 7);
#pragma unroll
    for (int i = 0; i < 16; ++i) tv[i] = __builtin_nontemporal_load((const f32x4*)(wp + (size_t)(8 * i) * t.ldw));
}
__device__ __forceinline__ void titem_finish_fp8(const TItem& t, const f32x4 (&tv)[16], LAS float* scr, int lane) {
#pragma unroll
    for (int i = 0; i < 16; ++i) { const int row = 8 * i + (lane >> 3); *(LAS f32x4*)(scr + row * 32 + ((4 * (lane & 7)) ^ ((8 * (row >> 4)) & 31))) = tv[i] * WSCALE; }
    LDS_WAIT(); asm volatile("" ::: "memory");
    const int c = lane & 7;
#pragma unroll
    for (int j = 0; j < 4; ++j) { const int n = (lane >> 3) + 8 * j; const LAS float* s = scr + (16 * c) * 32 + (n ^ ((8 * c) & 31));
        u32x4 o; o.x = pk4_fp8(s[0 * 32], s[1 * 32], s[2 * 32], s[3 * 32]); o.y = pk4_fp8(s[4 * 32], s[5 * 32], s[6 * 32], s[7 * 32]);
        o.z = pk4_fp8(s[8 * 32], s[9 * 32], s[10 * 32], s[11 * 32]); o.w = pk4_fp8(s[12 * 32], s[13 * 32], s[14 * 32], s[15 * 32]);
        __builtin_nontemporal_store(o, (u32x4*)(t.dst + (size_t)(t.drow0 >> 5) * 32768 + (size_t)(t.k0 >> 7) * 4096 + n * 128 + 16 * c)); }
    LDS_WAIT(); asm volatile("" ::: "memory");
}
constexpr int TI_IN = 16 * 96, TI_OUT = 8 * 32, TI_E = 8 * 32, TI_EALL = NE * 3 * TI_E;
constexpr int TSCR = 16384;
__device__ __forceinline__ void transpose_items_bf16(const Frame& F, const Args& a, int gw, int NGW, int it0, int it1) {
    const float* w_in = a.in[10]; const float* w_out = a.in[11];
    LAS float* scr = (LAS float*)(F.lds + F.wave * TSCR);
    for (int it = it0 + gw; it < it1; it += NGW) {
        TItem t; float tv[32];
        if (it < TI_IN) { const int kb = it / 96, nb = it % 96; t = TItem{w_in, F.ws + WS_WIN, NIN, kb * 64, nb * 32, nb * 32}; }
        else { const int r = it - TI_IN, kb = r / 32, nb = r % 32; t = TItem{w_out, F.ws + WS_WOUT, 1024, kb * 64, nb * 32, nb * 32}; }
        titem_load<32>(t, tv, F.lane); titem_finish_bf16(t, tv, scr, F.lane);
    }
}
__device__ __forceinline__ void transpose_items_fp8(const Frame& F, const Args& a, int gw, int NGW, int k0, int k1) {
    const float* w_gate = a.in[18]; const float* w_up = a.in[20]; const float* w_down = a.in[22];
    unsigned char* WGU = F.ws + WS_WGU; unsigned char* WDN = F.ws + WS_WDN;
    LAS float* scr = (LAS float*)(F.lds + F.wave * TSCR);
    auto decode = [&](int r, TItem& t) {
        const int e = r / (3 * TI_E), r2 = r % (3 * TI_E), mat = r2 / TI_E, r3 = r2 % TI_E, kb = r3 / 32, nb = r3 % 32, n0 = nb * 32;
        if (mat == 2) t = TItem{w_down + (size_t)e * 1048576, WDN + (size_t)e * 1048576, 1024, kb * 128, n0, n0};
        else t = TItem{(mat == 0 ? w_gate : w_up) + (size_t)e * 1048576, WGU + (size_t)e * 2097152, 1024, kb * 128, n0, 256 * (n0 >> 7) + mat * 128 + (n0 & 127)};
    };
    for (int k = k0; k < k1; ++k) { const int it = gw + k * NGW; if (it >= TI_EALL) break;
        TItem t; f32x4 tv[16]; decode(it, t); titem_load_fp8(t, tv, F.lane); titem_finish_fp8(t, tv, scr, F.lane); }
}
__device__ __forceinline__ void p0_prologue(const Frame& F, const Args& a) {
    const float* c = a.in[1]; const float* c_ctx = a.in[3]; const float* w_ada = a.in[4]; const float* b_ada = a.in[5];
    const float* w_out = a.in[11]; const float* pool_w = a.in[14]; const float* pool_scale = a.in[15];
    bf16_t* WOUT = (bf16_t*)(F.ws + WS_WOUT);
    float* mod = (float*)(F.ws + WS_MOD);
    if (F.bid < 192) {
        LAS float* s = (LAS float*)F.lds;
        LAS float* red = (LAS float*)(F.lds + 20480);
        { float t[10];
#pragma unroll
          for (int q = 0; q < 10; ++q) { const int i = F.tid + q * 512, r = i >> 10, k = i & 1023; t[q] = (r < 4) ? c[r * 1024 + k] : c_ctx[k]; }
#pragma unroll
          for (int q = 0; q < 10; ++q) s[F.tid + q * 512] = t[q] * sigmoidf_(t[q]); }
        __syncthreads();
        const int kq = F.tid >> 5, col = F.tid & 31, j = F.bid * 32 + col;
        float acc[5] = {0.f, 0.f, 0.f, 0.f, 0.f};
#pragma unroll
        for (int kh = 0; kh < 2; ++kh) { float w[32];
#pragma unroll
            for (int kk = 0; kk < 32; ++kk) w[kk] = __builtin_nontemporal_load(w_ada + (size_t)(kq * 64 + kh * 32 + kk) * 6144 + j);
#pragma unroll
            for (int kk = 0; kk < 32; ++kk) { const int k = kq * 64 + kh * 32 + kk;
#pragma unroll
                for (int r = 0; r < 5; ++r) acc[r] += s[r * 1024 + k] * w[kk]; } }
#pragma unroll
        for (int r = 0; r < 5; ++r) red[(kq * 5 + r) * 32 + col] = acc[r];
        __syncthreads();
        if (F.tid < 160) { const int r = F.tid >> 5, cc = F.tid & 31; float t = b_ada[F.bid * 32 + cc];
#pragma unroll
            for (int q = 0; q < 16; ++q) t += red[(q * 5 + r) * 32 + cc];
            mod[r * 6144 + F.bid * 32 + cc] = t; }
        asm volatile("s_waitcnt vmcnt(0)" ::: "memory");
        __syncthreads();
        if (F.tid == 0) { __builtin_amdgcn_fence(__ATOMIC_RELEASE, "agent"); asm volatile("s_waitcnt vmcnt(0)" ::: "memory");
            __hip_atomic_fetch_add(F.ctl + CW_MOD, 1u, __ATOMIC_RELAXED, __HIP_MEMORY_SCOPE_AGENT); }
    }
    __syncthreads();
    transpose_items_bf16(F, a, F.bid * 8 + F.wave, F.G * 8, 0, TI_IN);
}
__device__ __forceinline__ void p0_late(const Frame& F, const Args& a) {
    const float* w_out = a.in[11]; const float* pool_w = a.in[14]; const float* pool_scale = a.in[15];
    bf16_t* WOUT = (bf16_t*)(F.ws + WS_WOUT);
    if (F.bid >= 128 && F.bid < 256) {
        const int un = F.bid - 128, gi = un >> 5, nb = un & 31;
        LAS float* pw = (LAS float*)F.lds;
        LAS float* wo = (LAS float*)(F.lds + 128 * 129 * 4);
        { float t[32]; const float sc = pool_scale[gi * 128 + (F.tid & 127)];
#pragma unroll
          for (int q = 0; q < 32; ++q) t[q] = pool_w[(size_t)gi * 16384 + F.tid + q * 512];
#pragma unroll
          for (int q = 0; q < 32; ++q) { const int i = F.tid + q * 512; pw[(i >> 7) * 129 + (i & 127)] = t[q] * sc; }
          float u[8];
#pragma unroll
          for (int q = 0; q < 8; ++q) { const int i = F.tid + q * 512; u[q] = w_out[(size_t)(512 + gi * 128 + (i >> 5)) * 1024 + nb * 32 + (i & 31)]; }
#pragma unroll
          for (int q = 0; q < 8; ++q) wo[F.tid + q * 512] = u[q]; }
        __syncthreads();
        const int n = F.tid & 31, cq = F.tid >> 5;
        float acc[8] = {0.f, 0.f, 0.f, 0.f, 0.f, 0.f, 0.f, 0.f};
        for (int j = 0; j < 128; ++j) { const float b = wo[j * 32 + n];
#pragma unroll
            for (int i = 0; i < 8; ++i) acc[i] += pw[(cq * 8 + i) * 129 + j] * b; }
        u32x4 o; o.x = cvt_pk_bf16(acc[0], acc[1]); o.y = cvt_pk_bf16(acc[2], acc[3]); o.z = cvt_pk_bf16(acc[4], acc[5]); o.w = cvt_pk_bf16(acc[6], acc[7]);
        *(u32x4*)(WOUT + (size_t)(nb * 32 + n) * 1024 + 512 + gi * 128 + cq * 8) = o;
        __syncthreads();
    }
    if (F.bid >= 32 && F.bid < 40) {
        const float* w_router = a.in[16]; bf16_t* WRH = (bf16_t*)(F.ws + WS_WRH); bf16_t* WRL = (bf16_t*)(F.ws + WS_WRL);
        for (int i = (F.bid - 32) * 512 + F.tid; i < 32768; i += 8 * 512) { const int k = i >> 5, e = i & 31; const float w = w_router[i];
            const unsigned short hi = f2bf(w); WRH[e * 1024 + k] = hi; WRL[e * 1024 + k] = f2bf(w - bf2f(hi)); }
    }
    __syncthreads();
    transpose_items_bf16(F, a, F.bid * 8 + F.wave, F.G * 8, TI_IN, TI_IN + TI_OUT);
    __syncthreads();
}

__device__ __forceinline__ void p1_normmod(const Frame& F, const Args& a, unsigned need) {
    const float* x = a.in[0]; const float* ctx = a.in[2]; const float* g = a.in[6];
    const float* mod = (const float*)(F.ws + WS_MOD); bf16_t* HX = (bf16_t*)(F.ws + WS_HX);
    const int gw = F.bid * 8 + F.wave;
    auto rowp = [&](int m) { return (m < M) ? x + (size_t)m * D : ctx + (size_t)(m - M) * D; };
    const int NGW = F.G * 8;
    int m0 = gw * 8;
    f32x4 v[4];
    { const float* xr = rowp(m0);
#pragma unroll
      for (int j = 0; j < 4; ++j) v[j] = __builtin_nontemporal_load((const f32x4*)(xr + F.lane * 4 + 256 * j)); }
    if (F.tid == 0) { unsigned sp = 0;
        while (__hip_atomic_load(F.ctl + CW_MOD, __ATOMIC_RELAXED, __HIP_MEMORY_SCOPE_AGENT) < need) { __builtin_amdgcn_s_sleep(2); if (++sp > (1u << 22)) break; }
        __builtin_amdgcn_fence(__ATOMIC_ACQUIRE, "agent"); asm volatile("s_waitcnt vmcnt(0)" ::: "memory"); }
    __syncthreads();
    f32x4 ga[4], hb[4];
    auto ld_par = [&](int mr) { const float* sh = mod + mr * 6144, *sc = sh + 1024;
#pragma unroll
        for (int j = 0; j < 4; ++j) { const int col = F.lane * 4 + 256 * j; ga[j] = *(const f32x4*)(g + col) * (1.0f + *(const f32x4*)(sc + col)); hb[j] = *(const f32x4*)(sh + col); } };
    u32x2 res[4]; int mres = -1;
    auto st_row = [&]() { if (mres >= 0) {
#pragma unroll
        for (int j = 0; j < 4; ++j) *(u32x2*)(HX + (size_t)mres * D + F.lane * 4 + 256 * j) = res[j]; } };
    auto do_row = [&](int m) {
        float s = 0.f;
#pragma unroll
        for (int j = 0; j < 4; ++j) s += (v[j].x * v[j].x + v[j].y * v[j].y) + (v[j].z * v[j].z + v[j].w * v[j].w);
        const float rstd = rsqrtf(wave_sum(s) * (1.f / D) + EPS);
#pragma unroll
        for (int j = 0; j < 4; ++j) {
            const f32x4 o = v[j] * rstd * ga[j] + hb[j];
            res[j].x = cvt_pk_bf16(o.x, o.y); res[j].y = cvt_pk_bf16(o.z, o.w); }
        mres = m; };
    const bool hasctx = gw < MC;
#pragma unroll 1
    for (; m0 < M; m0 += NGW * 8) {
        const bool lastg = m0 + NGW * 8 >= M;
        ld_par(m0 >> 12);
#pragma unroll 1
        for (int k = 0; k < 8; ++k) {
            const int m = m0 + k, mn = (k < 7) ? m + 1 : (lastg ? (hasctx ? M + gw : m) : m0 + NGW * 8);
#pragma unroll
            for (int j = 0; j < 4; ++j) TOUCH4(v[j]);
            st_row();
            f32x4 vn[4];
            { const float* xr = rowp(mn);
#pragma unroll
              for (int j = 0; j < 4; ++j) vn[j] = __builtin_nontemporal_load((const f32x4*)(xr + F.lane * 4 + 256 * j)); }
            do_row(m);
#pragma unroll
            for (int j = 0; j < 4; ++j) v[j] = vn[j];
        }
    }
    for (int c = gw; c < MC; c += NGW) {
        if (c != gw) { const float* xr = rowp(M + c);
#pragma unroll
            for (int j = 0; j < 4; ++j) v[j] = __builtin_nontemporal_load((const f32x4*)(xr + F.lane * 4 + 256 * j)); }
        st_row(); ld_par(4); do_row(M + c); }
    st_row();
}

constexpr int G_LF = 0, G_QR = 17408, G_V = 34816, G_Q2 = 52224, G_K2 = 69632, G_ATT = 87040, G_ST = 96256, G_RED = LDS_TAB;
static_assert(G_ST + 128 * 272 <= RING_BYTES, "GLA LDS map");
typedef short s16x4 __attribute__((ext_vector_type(4)));
__device__ __forceinline__ f32x16 mfma32(bf16x8 a, bf16x8 b, f32x16 c) { return __builtin_amdgcn_mfma_f32_32x32x16_bf16(a, b, c, 0, 0, 0); }
__device__ __forceinline__ constexpr int crow0(int reg) { return (reg & 3) + 8 * (reg >> 2); }
__device__ __forceinline__ int opq(int x) { asm volatile("" : "+v"(x)); return x; }
__device__ __forceinline__ unsigned opqu(unsigned x) { asm volatile("" : "+v"(x)); return x; }
__device__ __forceinline__ bf16x8 tr_frag(const LAS unsigned char* img, int trb, int ks, int c) {
    const LAS s16x4* p = (const LAS s16x4*)(img + trb + ks * 16 * 272 + c * 64);
    const s16x4 lo = __builtin_amdgcn_ds_read_tr16_b64_v4i16((LAS s16x4*)p), hi = __builtin_amdgcn_ds_read_tr16_b64_v4i16((LAS s16x4*)(p + 4 * 272 / 8));
    return __builtin_shufflevector(lo, hi, 0, 1, 2, 3, 4, 5, 6, 7);
}
template <int MODE> __device__ __forceinline__ bf16x8 cfrag(int d) {
    u32x4 w;
#pragma unroll
    for (int i = 0; i < 4; ++i) {
        const bool lo = MODE == 0 ? (2 * i <= d) : MODE == 1 ? (2 * i >= d) : MODE == 2 ? (2 * i == d) : true;
        const bool hi = MODE == 0 ? (2 * i + 1 <= d) : MODE == 1 ? (2 * i + 1 >= d) : MODE == 2 ? (2 * i + 1 == d) : true;
        w[i] = (lo ? 0x3F80u : 0u) | (hi ? 0x3F800000u : 0u);
    }
    return __builtin_bit_cast(bf16x8, w);
}
struct RawRegs { u32x4 lf[2], v[2], q[2]; };
template <int DIR, bool WITH_Q>
__device__ __forceinline__ void gla_load_raw(const Frame& F, const bf16_t* P, int row0, int head, RawRegs& R) {
    const bf16_t* rp = P + (size_t)(row0 + (F.tid >> 3)) * NIN + head * 128 + (F.tid & 7) * 16;
    R.lf[0] = *(const u32x4*)(rp + 512 + DIR * 512); R.lf[1] = *(const u32x4*)(rp + 512 + DIR * 512 + 8);
    R.v[0] = *(const u32x4*)(rp + 1536); R.v[1] = *(const u32x4*)(rp + 1536 + 8);
    if (WITH_Q) { R.q[0] = *(const u32x4*)rp; R.q[1] = *(const u32x4*)(rp + 8); }
}
template <bool WITH_Q>
__device__ __forceinline__ void gla_store_raw(const Frame& F, const RawRegs& R) {
    const int o = (F.tid >> 3) * 272 + (F.tid & 7) * 32;
    *(LAS u32x4*)(F.lds + G_LF + o) = R.lf[0]; *(LAS u32x4*)(F.lds + G_LF + o + 16) = R.lf[1];
    *(LAS u32x4*)(F.lds + G_V + o) = R.v[0]; *(LAS u32x4*)(F.lds + G_V + o + 16) = R.v[1];
    if (WITH_Q) { *(LAS u32x4*)(F.lds + G_QR + o) = R.q[0]; *(LAS u32x4*)(F.lds + G_QR + o + 16) = R.q[1]; }
}
template <int DIR, bool WITH_Q>
__device__ __forceinline__ void gla_stage1(const Frame& F, int trb, float (&eh)[16], float* tsum) {
    const int cb = F.wave >> 1, tb = F.wave & 1, l31 = F.lane & 31, lh = F.lane >> 5;
    f32x16 b, T;
#pragma unroll
    for (int r = 0; r < 16; ++r) { b[r] = 0.f; T[r] = 0.f; }
    const u32x4 ones4 = {0x3F803F80u, 0x3F803F80u, 0x3F803F80u, 0x3F803F80u};
#pragma unroll
    for (int ks = 0; ks < 4; ++ks) {
        const int dd = 32 * tb + l31 - 16 * ks - 8 * lh;
        const bf16x8 alf = tr_frag(F.lds + G_LF, trb, ks, cb);
        T = mfma32(alf, __builtin_bit_cast(bf16x8, ones4), T);
        if (DIR ? (tb == 0 || ks >= 2) : (tb == 1 || ks < 2)) b = mfma32(alf, cfrag<DIR>(dd), b);
    }
    const int wb = opq((32 * tb + l31) * 272 + (32 * cb + 4 * lh) * 2);
    typedef float f32x2 __attribute__((ext_vector_type(2)));
    u32x2 lfw[4], qw[4];
#pragma unroll
    for (int g = 0; g < 4; ++g) { lfw[g] = *(const LAS u32x2*)(F.lds + G_LF + wb + g * 16); if (WITH_Q) qw[g] = *(const LAS u32x2*)(F.lds + G_QR + wb + g * 16); }
#pragma unroll
    for (int g = 0; g < 4; ++g) {
        f32x2 k2[2], q2[2];
#pragma unroll
        for (int h = 0; h < 2; ++h) {
            const int r = 4 * g + 2 * h;
            const unsigned lw = h ? lfw[g].y : lfw[g].x;
            const f32x2 lf = {bflo(lw), bfhi(lw)}, Tv = {T[r], T[r + 1]}, bv = {b[r], b[r + 1]};
            const f32x2 mm = Tv * 0.5f, d = mm - bv;
            eh[r] = __builtin_amdgcn_exp2f(mm.x); eh[r + 1] = __builtin_amdgcn_exp2f(mm.y);
            if (tsum) { tsum[r] += Tv.x; tsum[r + 1] += Tv.y; }
            f32x2 ef, ek; ef.x = __builtin_amdgcn_exp2f(lf.x); ef.y = __builtin_amdgcn_exp2f(lf.y); ek.x = __builtin_amdgcn_exp2f(d.x); ek.y = __builtin_amdgcn_exp2f(d.y);
            k2[h] = (1.0f - ef) * ek;
            q2[h] = (f32x2){0.f, 0.f};
            if (WITH_Q) { const unsigned qq = h ? qw[g].y : qw[g].x; const f32x2 q = {bflo(qq), bfhi(qq)}, nd = bv - mm;
                f32x2 eq; eq.x = __builtin_amdgcn_exp2f(nd.x); eq.y = __builtin_amdgcn_exp2f(nd.y); q2[h] = q * eq; }
        }
        u32x2 w; w.x = cvt_pk_bf16(k2[0].x, k2[0].y); w.y = cvt_pk_bf16(k2[1].x, k2[1].y);
        *(LAS u32x2*)(F.lds + G_K2 + wb + g * 16) = w;
        if (WITH_Q) { w.x = cvt_pk_bf16(q2[0].x, q2[0].y); w.y = cvt_pk_bf16(q2[1].x, q2[1].y); *(LAS u32x2*)(F.lds + G_Q2 + wb + g * 16) = w; }
    }
}
__device__ __forceinline__ void gla_state_mma(const Frame& F, int trb, f32x16& s0, f32x16& s1) {
    const int kb = F.wave >> 1, vb = (F.wave & 1) * 2;
#pragma unroll
    for (int ks = 0; ks < 4; ++ks) {
        const bf16x8 a = tr_frag(F.lds + G_K2, trb, ks, kb);
        const bf16x8 b0 = tr_frag(F.lds + G_V, trb, ks, vb), b1 = tr_frag(F.lds + G_V, trb, ks, vb + 1);
        s0 = mfma32(a, b0, s0); s1 = mfma32(a, b1, s1);
    }
}

template <int DIR>
__device__ __forceinline__ void gla_passA_unit(const Frame& F, const bf16_t* P, int b, int h, int blk, bf16_t* dS, float* DD) {
    const int xb = DIR ? (16 - blk) : (blk - 1);
    const int rowb = (blk == 0) ? (M + b * CTXL) : (b * SEQ + xb * 256);
    const int l31 = F.lane & 31, lh = F.lane >> 5;
    const int trb = (8 * lh + ((F.lane & 15) >> 2)) * 272 + (16 * ((F.lane >> 4) & 1) + 4 * (F.lane & 3)) * 2;
    f32x16 s0, s1;
#pragma unroll
    for (int r = 0; r < 16; ++r) { s0[r] = 0.f; s1[r] = 0.f; }
    float tsum[16], eh[16];
#pragma unroll
    for (int i = 0; i < 16; ++i) tsum[i] = 0.f;
    RawRegs R;
    gla_load_raw<DIR, false>(F, P, rowb + (DIR ? 3 : 0) * 64, h, R);
#pragma unroll 1
    for (int ci = 0; ci < 4; ++ci) {
        LSYNC();
        gla_store_raw<false>(F, R);
        if (ci < 3) gla_load_raw<DIR, false>(F, P, rowb + (DIR ? (2 - ci) : (ci + 1)) * 64, h, R);
        LSYNC();
        gla_stage1<DIR, false>(F, trb, eh, tsum);
        LSYNC();
#pragma unroll
        for (int r = 0; r < 16; ++r) { s0[r] *= eh[r]; s1[r] *= eh[r]; }
        gla_state_mma(F, trb, s0, s1);
#pragma unroll
        for (int r = 0; r < 16; ++r) { s0[r] *= eh[r]; s1[r] *= eh[r]; }
    }
    const int kb = F.wave >> 1, vb = (F.wave & 1) * 2;
    const unsigned sb = opqu((unsigned)((32 * kb + 4 * lh) * 128 + 32 * vb + l31));
#pragma unroll
    for (int r = 0; r < 16; ++r) { dS[sb + crow0(r) * 128] = f2bf(s0[r]); dS[sb + 32 + crow0(r) * 128] = f2bf(s1[r]); }
    if ((F.wave & 1) == 0 && l31 == 0) {
#pragma unroll
        for (int r = 0; r < 16; ++r) DD[32 * kb + 4 * lh + crow0(r)] = __builtin_amdgcn_exp2f(tsum[r]);
    }
}

template <int W, class Get, class Emit> __device__ __forceinline__ void win_mean64(const Get& get, const Emit& emit) {
    float s = 0.f;
#pragma unroll
    for (int q = 0; q < W - W / 2; ++q) s += get(q);
#pragma unroll
    for (int r = 0; r < 64; ++r) {
        const int lo = (r - W / 2) < 0 ? 0 : (r - W / 2), hi = (r - W / 2 + W) > 64 ? 64 : (r - W / 2 + W);
        emit(r, s * (1.0f / (float)(hi - lo)));
        if (r + 1 < 64) { if (r + 1 - W / 2 + W <= 64) s += get(r - W / 2 + W); if (r + 1 - W / 2 > 0) s -= get(r - W / 2); }
    }
}
template <int W>
__device__ __forceinline__ void pool_unit(const Frame& F, const bf16_t* __restrict__ U, bf16_t* __restrict__ A2, int b, int slab) {
    LAS float* vm = (LAS float*)F.lds;
    const int ch = F.tid & 7, cc = F.tid >> 3;
    const bf16_t* Us = U + (size_t)(b * 64 + slab) * 4096 * 8;
    {
        unsigned short v[64];
        const unsigned pb = opqu((unsigned)(cc * 8 + ch));
#pragma unroll
        for (int r = 0; r < 64; ++r) v[r] = Us[pb + (unsigned)(r * 64 * 8)];
        const int vb = opq((cc * 8 + ch) * 4);
        win_mean64<W>([&](int q) { return bf2f(v[q]); }, [&](int r, float mean) { *(LAS float*)(F.lds + vb + r * 2080) = mean; });
    }
    __syncthreads();
    {
        const int rr = F.tid >> 3;
        unsigned short uu[64];
        const unsigned pb = opqu((unsigned)(rr * 64 * 8 + ch));
#pragma unroll
        for (int c = 0; c < 64; ++c) uu[c] = Us[pb + (unsigned)(c * 8)];
        const int vb = opq((rr * 520 + ch) * 4);
        const unsigned ab = opqu((unsigned)((b * SEQ + rr * 64) * D + 512 + slab * 8 + ch));
        win_mean64<W>([&](int q) { return *(const LAS float*)(F.lds + vb + q * 32); },
                      [&](int c, float mean) { A2[ab + (unsigned)(c * D)] = f2bf(mean - bf2f(uu[c])); });
    }
    __syncthreads();
}

__device__ __forceinline__ void p4_scan(const Frame& F) {
    bf16_t* ST = (bf16_t*)(F.ws + WS_ST); const float* DDp = (const float*)(F.ws + WS_DD);
    const int gt = F.bid * 512 + F.tid, NT = F.G * 512;
    for (int i = gt; i < 32 * 4096; i += NT) {
        const int seq = i >> 12, e4 = i & 4095, k = e4 >> 5;
        float S[4];
#pragma unroll
        for (int j = 0; j < 4; ++j) S[j] = 0.f;
        u32x2 d[NBLK]; float dec[NBLK];
#pragma unroll
        for (int blk = 0; blk < NBLK; ++blk) { d[blk] = *(const u32x2*)(ST + ((size_t)(seq * NBLK + blk) * 16384) + e4 * 4); dec[blk] = DDp[(seq * NBLK + blk) * 128 + k]; }
#pragma unroll
        for (int blk = 0; blk < NBLK; ++blk) {
            u32x2 o; o.x = cvt_pk_bf16(S[0], S[1]); o.y = cvt_pk_bf16(S[2], S[3]);
            *(u32x2*)(ST + ((size_t)(seq * NBLK + blk) * 16384) + e4 * 4) = o;
            S[0] = S[0] * dec[blk] + bflo(d[blk].x); S[1] = S[1] * dec[blk] + bfhi(d[blk].x); S[2] = S[2] * dec[blk] + bflo(d[blk].y); S[3] = S[3] * dec[blk] + bfhi(d[blk].y);
        }
    }
}

__device__ __forceinline__ float row16_sum(float x) {
    int v;
    v = __builtin_amdgcn_mov_dpp(__float_as_int(x), 0x128, 0xf, 0xf, false); x += __int_as_float(v);
    v = __builtin_amdgcn_mov_dpp(__float_as_int(x), 0x124, 0xf, 0xf, false); x += __int_as_float(v);
    v = __builtin_amdgcn_mov_dpp(__float_as_int(x), 0x122, 0xf, 0xf, false); x += __int_as_float(v);
    v = __builtin_amdgcn_mov_dpp(__float_as_int(x), 0x121, 0xf, 0xf, false); x += __int_as_float(v);
    return x;
}
template <int DIR>
__device__ __forceinline__ void gla_passC_dir(const Frame& F, const bf16_t* P, int b, int h, int xb, const bf16_t* ST, bf16_t* OF, bf16_t* A2, const float* gain) {
    const int blk = DIR ? (16 - xb) : (xb + 1);
    const int seq = b * 8 + h * 2 + DIR;
    const bf16_t* S0 = ST + (size_t)(seq * NBLK + blk) * 16384;
    const int kb = F.wave >> 1, vb = (F.wave & 1) * 2, l31 = F.lane & 31, lh = F.lane >> 5;
    const int trb = (8 * lh + ((F.lane & 15) >> 2)) * 272 + (16 * ((F.lane >> 4) & 1) + 4 * (F.lane & 3)) * 2;
    f32x16 s0, s1;
    const unsigned sb = opqu((unsigned)((32 * kb + 4 * lh) * 128 + 32 * vb + l31));
#pragma unroll
    for (int r = 0; r < 16; ++r) { s0[r] = bf2f(S0[sb + crow0(r) * 128]); s1[r] = bf2f(S0[sb + 32 + crow0(r) * 128]); }
    const int rowb = b * SEQ + xb * 256;
    const int omt = F.wave >> 2, ont = F.wave & 3;
    LAS float* red = (LAS float*)(F.lds + G_RED);
    RawRegs R;
    gla_load_raw<DIR, true>(F, P, rowb + (DIR ? 3 : 0) * 64, h, R);
#pragma unroll 1
    for (int ci = 0; ci < 4; ++ci) {
        const int c = DIR ? (3 - ci) : ci;
        float eh[16];
        LSYNC();
        gla_store_raw<true>(F, R);
        if (ci < 3) gla_load_raw<DIR, true>(F, P, rowb + (DIR ? (2 - ci) : (ci + 1)) * 64, h, R);
        f32x16 o;
        const unsigned trow = (unsigned)(rowb + c * 64 + 32 * omt + l31);
        const unsigned ob = opqu(trow * 512u + (unsigned)(h * 128 + 32 * ont + 4 * lh));
        u32x2 gg[4];
        if (DIR) {
            const unsigned pb = opqu(trow * (unsigned)NIN + (unsigned)(2048 + h * 128 + 32 * ont + 4 * lh));
#pragma unroll
            for (int g = 0; g < 4; ++g) { const u32x2 t4 = *(const u32x2*)(OF + ob + g * 8); o[4 * g] = bflo(t4.x); o[4 * g + 1] = bfhi(t4.x); o[4 * g + 2] = bflo(t4.y); o[4 * g + 3] = bfhi(t4.y); gg[g] = *(const u32x2*)(P + pb + g * 8); }
        } else {
#pragma unroll
            for (int r = 0; r < 16; ++r) o[r] = 0.f;
        }
        LSYNC();
        gla_stage1<DIR, true>(F, trb, eh, nullptr);
        LSYNC();
#pragma unroll
        for (int r = 0; r < 16; ++r) { s0[r] *= eh[r]; s1[r] *= eh[r]; }
        {
            const int stb = opq(G_ST + (32 * vb + l31) * 272 + (32 * kb + 4 * lh) * 2);
#pragma unroll
            for (int g = 0; g < 4; ++g) {
                u32x2 w; w.x = cvt_pk_bf16(s0[4 * g], s0[4 * g + 1]); w.y = cvt_pk_bf16(s0[4 * g + 2], s0[4 * g + 3]);
                *(LAS u32x2*)(F.lds + stb + g * 16) = w;
                w.x = cvt_pk_bf16(s1[4 * g], s1[4 * g + 1]); w.y = cvt_pk_bf16(s1[4 * g + 2], s1[4 * g + 3]);
                *(LAS u32x2*)(F.lds + stb + 32 * 272 + g * 16) = w;
            }
        }
        if (F.wave < 4) {
            const int asb = F.wave >> 1, atb = F.wave & 1;
            f32x16 at, at2;
#pragma unroll
            for (int r = 0; r < 16; ++r) { at[r] = 0.f; at2[r] = 0.f; }
            const int ka = opq(G_K2 + (32 * asb + l31) * 272 + 16 * lh), qa = opq(G_Q2 + (32 * atb + l31) * 272 + 16 * lh);
#pragma unroll
            for (int ks = 0; ks < 8; ks += 2) {
                const bf16x8 a = *(const LAS bf16x8*)(F.lds + ka + ks * 32), a2 = *(const LAS bf16x8*)(F.lds + ka + ks * 32 + 32);
                const bf16x8 bb = *(const LAS bf16x8*)(F.lds + qa + ks * 32), bb2 = *(const LAS bf16x8*)(F.lds + qa + ks * 32 + 32);
                at = mfma32(a, bb, at); at2 = mfma32(a2, bb2, at2);
            }
#pragma unroll
            for (int r = 0; r < 16; ++r) at[r] += at2[r];
            const int dts = opq((32 * atb + l31) - (32 * asb + 4 * lh));
            float am[16];
#pragma unroll
            for (int r = 0; r < 16; ++r) { const bool keep = DIR ? (crow0(r) >= dts) : (crow0(r) <= dts); am[r] = keep ? at[r] : 0.f; }
            const int ab = opq(G_ATT + (32 * atb + l31) * 144 + (32 * asb + 4 * lh) * 2);
#pragma unroll
            for (int g = 0; g < 4; ++g) { u32x2 w; w.x = cvt_pk_bf16(am[4 * g], am[4 * g + 1]); w.y = cvt_pk_bf16(am[4 * g + 2], am[4 * g + 3]); *(LAS u32x2*)(F.lds + ab + g * 16) = w; }
        }
        LSYNC();
        {
            const int qa = opq(G_Q2 + (32 * omt + l31) * 272 + 16 * lh), sa = opq(G_ST + (32 * ont + l31) * 272 + 16 * lh), aa = opq(G_ATT + (32 * omt + l31) * 144 + 16 * lh);
            f32x16 o2;
#pragma unroll
            for (int r = 0; r < 16; ++r) o2[r] = 0.f;
#pragma unroll
            for (int ks = 0; ks < 8; ++ks) {
                const bf16x8 a = *(const LAS bf16x8*)(F.lds + sa + ks * 32);
                const bf16x8 bb = *(const LAS bf16x8*)(F.lds + qa + ks * 32);
                if (ks & 1) o2 = mfma32(a, bb, o2); else o = mfma32(a, bb, o);
            }
#pragma unroll
            for (int ks = 0; ks < 4; ++ks) {
                const bf16x8 a = tr_frag(F.lds + G_V, trb, ks, ont);
                const bf16x8 bb = *(const LAS bf16x8*)(F.lds + aa + ks * 32);
                if (ks & 1) o2 = mfma32(a, bb, o2); else o = mfma32(a, bb, o);
            }
#pragma unroll
            for (int r = 0; r < 16; ++r) o[r] += o2[r];
        }
        gla_state_mma(F, trb, s0, s1);
#pragma unroll
        for (int r = 0; r < 16; ++r) { s0[r] *= eh[r]; s1[r] *= eh[r]; }
        if (DIR == 0) {
#pragma unroll
            for (int g = 0; g < 4; ++g) { u32x2 w; w.x = cvt_pk_bf16(o[4 * g], o[4 * g + 1]); w.y = cvt_pk_bf16(o[4 * g + 2], o[4 * g + 3]); *(u32x2*)(OF + ob + g * 8) = w; }
        } else {
            float sq = 0.f;
#pragma unroll
            for (int r = 0; r < 16; ++r) sq += o[r] * o[r];
            sq += __shfl_xor(sq, 32);
            if (lh == 0) red[(32 * omt + l31) * 4 + ont] = sq;
            LSYNC();
            const f32x4 q4 = *(const LAS f32x4*)(red + (32 * omt + l31) * 4);
            const float rstd = rsqrtf(((q4.x + q4.y) + (q4.z + q4.w)) * (1.0f / 128.0f) + EPS);
            const unsigned a2b = opqu(trow * (unsigned)D + (unsigned)(h * 128 + 32 * ont + 4 * lh));
#pragma unroll
            for (int g = 0; g < 4; ++g) { const f32x4 gv = *(const f32x4*)(gain + h * 128 + 32 * ont + 4 * lh + g * 8);
                u32x2 w; w.x = cvt_pk_bf16(o[4 * g] * rstd * gv.x * bflo(gg[g].x), o[4 * g + 1] * rstd * gv.y * bfhi(gg[g].x));
                w.y = cvt_pk_bf16(o[4 * g + 2] * rstd * gv.z * bflo(gg[g].y), o[4 * g + 3] * rstd * gv.w * bfhi(gg[g].y));
                *(u32x2*)(A2 + a2b + g * 8) = w; }
        }
    }
}
__device__ __forceinline__ void gla_passC_unit(const Frame& F, const Args& a, int b, int h, int xb) {
    const bf16_t* P = (const bf16_t*)(F.ws + WS_P); const bf16_t* ST = (const bf16_t*)(F.ws + WS_ST); bf16_t* A2 = (bf16_t*)(F.ws + WS_A2);
    bf16_t* OF = (bf16_t*)(F.ws + WS_YX);
    gla_passC_dir<0>(F, P, b, h, xb, ST, OF, A2, a.in[13]);
    gla_passC_dir<1>(F, P, b, h, xb, ST, OF, A2, a.in[13]);
}

__device__ __forceinline__ void p7_rows(const Frame& F, const Args& a, const XcdBarrier& bar, bool pending) {
    const float* x = a.in[0]; const float* gpm = a.in[7]; const float* gpf = a.in[8]; const float* b_router = a.in[17];
    const float* mod = (const float*)(F.ws + WS_MOD); const bf16_t* YX = (const bf16_t*)(F.ws + WS_YXB);
    const bf16_t* WRH = (const bf16_t*)(F.ws + WS_WRH); const bf16_t* WRL = (const bf16_t*)(F.ws + WS_WRL);
    bf16_t* X1B = (bf16_t*)(F.ws + WS_X1B); unsigned char* HX2F = F.ws + WS_HX2F; int* PE = (int*)(F.ws + WS_PE); int* PSLOT = (int*)(F.ws + WS_PSLOT); float* PW = (float*)(F.ws + WS_PW);
    int* RTOK = (int*)(F.ws + WS_RTOK); unsigned* cnt = F.ctl + CW_CNT;
    LAS float* part = (LAS float*)F.lds;
    LAS float* logit = (LAS float*)(F.lds + 65536);
    LAS int* lcnt = (LAS int*)(F.lds + LDS_TAB);
    const int l31 = F.lane & 31, lh = F.lane >> 5;
    for (int g = F.bid; g < M / 64; g += F.G) {
        const int base = (F.G == 256) ? ((8 * (g & 7) + (g >> 5)) * 256 + ((g >> 3) & 3) * 64) : g * 64;
        if (F.tid < 64) lcnt[F.tid] = 0;
        f32x4 cgt[4], e2[4], f2[4];
        { const float* mrow = mod + (base >> 12) * 6144;
#pragma unroll
          for (int j = 0; j < 4; ++j) { const int col = F.lane * 4 + 256 * j; cgt[j] = *(const f32x4*)(mrow + 2048 + col) * *(const f32x4*)(gpm + col);
              e2[j] = *(const f32x4*)(gpf + col) * (1.0f + *(const f32x4*)(mrow + 4096 + col)); f2[j] = *(const f32x4*)(mrow + 3072 + col); } }
        u32x2 yw[4]; f32x4 xx[4];
        { const int m0 = base + F.wave * 8;
#pragma unroll
          for (int j = 0; j < 4; ++j) { const int col = F.lane * 4 + 256 * j; xx[j] = __builtin_nontemporal_load((const f32x4*)(x + (size_t)m0 * D + col)); }
          if (pending && g == F.bid) xcd_wait(bar);
#pragma unroll
          for (int j = 0; j < 4; ++j) { const int col = F.lane * 4 + 256 * j; yw[j] = __builtin_nontemporal_load((const u32x2*)(YX + (size_t)m0 * D + col)); } }
        u32x2 sx[4]; unsigned sf[4];
#pragma unroll 1
        for (int r = 0; r < 8; ++r) {
            const int m = base + F.wave * 8 + r, mn = base + F.wave * 8 + (r < 7 ? r + 1 : r);
#pragma unroll
            for (int j = 0; j < 4; ++j) { TOUCH2(yw[j]); TOUCH4(xx[j]); }
            if (r > 0) {
#pragma unroll
                for (int j = 0; j < 4; ++j) { const int col = F.lane * 4 + 256 * j; __builtin_nontemporal_store(sx[j], (u32x2*)(X1B + (size_t)(m - 1) * D + col)); *(unsigned*)(HX2F + (size_t)(m - 1) * D + col) = sf[j]; } }
            u32x2 ywn[4]; f32x4 xn[4];
#pragma unroll
            for (int j = 0; j < 4; ++j) { const int col = F.lane * 4 + 256 * j; ywn[j] = __builtin_nontemporal_load((const u32x2*)(YX + (size_t)mn * D + col)); xn[j] = __builtin_nontemporal_load((const f32x4*)(x + (size_t)mn * D + col)); }
            f32x4 y[4]; float s = 0.f;
#pragma unroll
            for (int j = 0; j < 4; ++j) { y[j] = (f32x4){bflo(yw[j].x), bfhi(yw[j].x), bflo(yw[j].y), bfhi(yw[j].y)};
                s += (y[j].x * y[j].x + y[j].y * y[j].y) + (y[j].z * y[j].z + y[j].w * y[j].w); }
            const float rstd = rsqrtf(wave_sum(s) * (1.f / D) + EPS);
            float s2 = 0.f;
#pragma unroll
            for (int j = 0; j < 4; ++j) { const int col = F.lane * 4 + 256 * j;
                xx[j] = xx[j] + cgt[j] * (y[j] * rstd);
                sx[j].x = cvt_pk_bf16(xx[j].x, xx[j].y); sx[j].y = cvt_pk_bf16(xx[j].z, xx[j].w);
                s2 += (xx[j].x * xx[j].x + xx[j].y * xx[j].y) + (xx[j].z * xx[j].z + xx[j].w * xx[j].w); }
            const float rstd2 = rsqrtf(wave_sum(s2) * (1.f / D) + EPS);
#pragma unroll
            for (int j = 0; j < 4; ++j) { const int col = F.lane * 4 + 256 * j;
                const f32x4 hh = xx[j] * rstd2 * e2[j] + f2[j];
                u32x2 w; w.x = cvt_pk_bf16(hh.x, hh.y); w.y = cvt_pk_bf16(hh.z, hh.w);
                const int lr = F.wave * 8 + r;
                *(LAS u32x2*)(F.lds + lr * 2048 + ((((F.lane >> 1) + 32 * j) ^ (lr & 15)) * 16) + (F.lane & 1) * 8) = w;
                sf[j] = pk4_fp8(hh.x, hh.y, hh.z, hh.w); }
#pragma unroll
            for (int j = 0; j < 4; ++j) { yw[j] = ywn[j]; xx[j] = xn[j]; }
        }
        { const int m = base + F.wave * 8 + 7;
#pragma unroll
          for (int j = 0; j < 4; ++j) { const int col = F.lane * 4 + 256 * j; __builtin_nontemporal_store(sx[j], (u32x2*)(X1B + (size_t)m * D + col)); *(unsigned*)(HX2F + (size_t)m * D + col) = sf[j]; } }
        __syncthreads();
        {
            f32x16 acc0, acc1;
#pragma unroll
            for (int r = 0; r < 16; ++r) { acc0[r] = 0.f; acc1[r] = 0.f; }
#pragma unroll
            for (int ks = 0; ks < 8; ++ks) {
                const int k0 = 128 * F.wave + 16 * ks + 8 * lh, ch = ((16 * F.wave + 2 * ks + lh) ^ (l31 & 15)) * 16;
                const bf16x8 a0 = *(const LAS bf16x8*)(F.lds + l31 * 2048 + ch), a1 = *(const LAS bf16x8*)(F.lds + (32 + l31) * 2048 + ch);
                const bf16x8 bh = *(const bf16x8*)(WRH + l31 * 1024 + k0), bl = *(const bf16x8*)(WRL + l31 * 1024 + k0);
                acc0 = mfma32(a0, bh, acc0); acc0 = mfma32(a0, bl, acc0); acc1 = mfma32(a1, bh, acc1); acc1 = mfma32(a1, bl, acc1);
            }
            const int pb = opq((F.wave * 64 + 4 * lh) * 32 + l31);
            __syncthreads();
#pragma unroll
            for (int r = 0; r < 16; ++r) { part[pb + crow0(r) * 32] = acc0[r]; part[pb + (32 + crow0(r)) * 32] = acc1[r]; }
        }
        __syncthreads();
        { f32x4 t = *(const f32x4*)(b_router + ((F.tid * 4) & 31));
#pragma unroll
          for (int w = 0; w < 8; ++w) t += *(const LAS f32x4*)(part + w * 2048 + F.tid * 4);
          *(LAS f32x4*)(logit + F.tid * 4) = t; }
        __syncthreads();
#pragma unroll 1
        for (int r = 0; r < 8; ++r) {
            const int m = base + F.wave * 8 + r;
            float v = (F.lane < 32) ? logit[(F.wave * 8 + r) * 32 + l31] : -3.0e38f; float tv[4]; int ti[4];
#pragma unroll
            for (int k = 0; k < 4; ++k) {
                float mx = v;
#pragma unroll
                for (int o = 1; o < 64; o <<= 1) mx = fmaxf(mx, __shfl_xor(mx, o));
                const unsigned long long bal = __ballot(v == mx);
                int idx = __ffsll((long long)bal) - 1; idx = idx < 0 ? 0 : (idx > 31 ? 31 : idx);
                tv[k] = mx; ti[k] = idx;
                if (F.lane == idx) v = -3.0e38f;
            }
            const float e1 = __expf(tv[1] - tv[0]), e2 = __expf(tv[2] - tv[0]), e3 = __expf(tv[3] - tv[0]);
            const float inv = 1.0f / (1.0f + e1 + e2 + e3);
            if (F.lane < 4) {
                const int e = F.lane == 0 ? ti[0] : F.lane == 1 ? ti[1] : F.lane == 2 ? ti[2] : ti[3];
                const float w = (F.lane == 0 ? 1.0f : F.lane == 1 ? e1 : F.lane == 2 ? e2 : e3) * inv;
                const int lrank = __hip_atomic_fetch_add(lcnt + e, 1, __ATOMIC_RELAXED, __HIP_MEMORY_SCOPE_WORKGROUP);
                PE[m * 4 + F.lane] = e; PSLOT[m * 4 + F.lane] = lrank; PW[m * 4 + F.lane] = w;
            }
        }
        __syncthreads();
        if (F.tid < 32) { const int c = lcnt[F.tid]; lcnt[32 + F.tid] = c ? (int)__hip_atomic_fetch_add(cnt + 64 * F.tid, (unsigned)c, __ATOMIC_RELAXED, __HIP_MEMORY_SCOPE_AGENT) : 0; }
        __syncthreads();
        if (F.tid < 256) { const int m = base + (F.tid >> 2), k = F.tid & 3; const int e = PE[m * 4 + k]; const int slot = lcnt[32 + e] + PSLOT[m * 4 + k];
            PSLOT[m * 4 + k] = slot; RTOK[e * ECAP + slot] = m * 1024; }
        __syncthreads();
    }
}

__device__ __forceinline__ void moe_tables(const Frame& F) {
    LAS int* tab = (LAS int*)(F.lds + LDS_TAB);
    __syncthreads();
    if (F.tid < 64) {
        const int c = (F.lane < 32) ? (int)__hip_atomic_load(F.ctl + CW_CNT + 64 * (F.lane & 31), __ATOMIC_RELAXED, __HIP_MEMORY_SCOPE_AGENT) : 0;
        const int padded = ((c + 255) >> 8) * 256;
        int incl = padded;
#pragma unroll
        for (int o = 1; o < 32; o <<= 1) { const int t = __shfl_up(incl, o); if (F.lane >= o) incl += t; }
        if (F.lane < 32) { tab[F.lane] = c; tab[32 + F.lane] = incl - padded; }
        if (F.lane == 31) tab[64] = incl >> 8;
    }
    __syncthreads();
}

__device__ __forceinline__ void p10_final(const Frame& F, const Args& a, const XcdBarrier& bar, bool pending) {
    const float* gpo = a.in[9]; const float* mod = (const float*)(F.ws + WS_MOD);
    const unsigned char* YB = F.ws + WS_YB; const bf16_t* X1B = (const bf16_t*)(F.ws + WS_X1B); const int* PE = (const int*)(F.ws + WS_PE); const int* PSLOT = (const int*)(F.ws + WS_PSLOT); const float* PW = (const float*)(F.ws + WS_PW);
    const LAS int* tab = (const LAS int*)(F.lds + LDS_TAB);
    const int gw = F.bid * 8 + F.wave;
    struct Rec { int e[4], s[4]; float w[4]; };
    auto ld_rec = [&](int m, Rec& r) {
#pragma unroll
        for (int k = 0; k < 4; ++k) { r.e[k] = PE[m * 4 + k]; r.s[k] = PSLOT[m * 4 + k]; r.w[k] = PW[m * 4 + k]; } };
    auto ld_x = [&](int m, u32x2 (&xw)[4]) {
#pragma unroll
        for (int j = 0; j < 4; ++j) xw[j] = __builtin_nontemporal_load((const u32x2*)(X1B + (size_t)m * D + F.lane * 4 + 256 * j)); };
    auto ld_y = [&](const Rec& r, int (&yv)[16]) {
#pragma unroll
        for (int k = 0; k < 4; ++k) { const unsigned char* yr = YB + (size_t)(tab[32 + r.e[k]] + r.s[k]) * D + F.lane * 4;
#pragma unroll
            for (int j = 0; j < 4; ++j) yv[k * 4 + j] = __builtin_nontemporal_load((const int*)(yr + 256 * j)); } };
    auto ld_row = [&](int m, const Rec& r, int (&yv)[16], u32x2 (&xw)[4]) { ld_y(r, yv); ld_x(m, xw); };
#pragma unroll 1
    for (int g8 = gw; g8 < M / 8; g8 += F.G * 8) {
    const int mbeg = g8 * 8, mend = mbeg + 7;
    int m = mbeg;
    Rec r0, r1; int yv[16]; u32x2 xw[4];
    f32x4 ggt[4];
    { const float* mrow = mod + (mbeg >> 12) * 6144;
#pragma unroll
      for (int j = 0; j < 4; ++j) { const int col = F.lane * 4 + 256 * j; ggt[j] = *(const f32x4*)(gpo + col) * *(const f32x4*)(mrow + 5120 + col); } }
    ld_rec(m, r0);
    ld_rec(m + 1, r1);
    ld_x(m, xw);
    if (pending && g8 == gw) xcd_wait(bar);
    ld_y(r0, yv);
    f32x4 ores[4];
#pragma unroll 1
    for (; m <= mend; ++m) {
        const int m1 = m + 1 <= mend ? m + 1 : m, m2 = m1 + 1 <= mend ? m1 + 1 : m1;
#pragma unroll
        for (int i = 0; i < 16; ++i) asm volatile("" : "+v"(yv[i]));
#pragma unroll
        for (int j = 0; j < 4; ++j) TOUCH2(xw[j]);
        if (m > mbeg) {
#pragma unroll
            for (int j = 0; j < 4; ++j) __builtin_nontemporal_store(ores[j], (f32x4*)(a.out + (size_t)(m - 1) * D + F.lane * 4 + 256 * j)); }
        Rec r2; ld_rec(m2, r2);
        int yn[16]; u32x2 xn[4];
        ld_row(m1, r1, yn, xn);
        f32x4 y[4];
#pragma unroll
        for (int j = 0; j < 4; ++j) y[j] = (f32x4){0.f, 0.f, 0.f, 0.f};
#pragma unroll
        for (int k = 0; k < 4; ++k) { const float w = r0.w[k];
#pragma unroll
            for (int j = 0; j < 4; ++j) { const int v = yv[k * 4 + j];
                const auto lo = __builtin_amdgcn_cvt_pk_f32_fp8(v, false), hi = __builtin_amdgcn_cvt_pk_f32_fp8(v, true);
                y[j].x += w * lo[0]; y[j].y += w * lo[1]; y[j].z += w * hi[0]; y[j].w += w * hi[1]; } }
        float s = 0.f;
#pragma unroll
        for (int j = 0; j < 4; ++j) s += (y[j].x * y[j].x + y[j].y * y[j].y) + (y[j].z * y[j].z + y[j].w * y[j].w);
        const float rstd = rsqrtf(wave_sum(s) * (1.f / D) + EPS);
#pragma unroll
        for (int j = 0; j < 4; ++j) { const f32x4 x1 = {bflo(xw[j].x), bfhi(xw[j].x), bflo(xw[j].y), bfhi(xw[j].y)};
            ores[j] = x1 + ggt[j] * (y[j] * rstd); }
        r0 = r1; r1 = r2;
#pragma unroll
        for (int i = 0; i < 16; ++i) yv[i] = yn[i];
#pragma unroll
        for (int j = 0; j < 4; ++j) xw[j] = xn[j];
    }
#pragma unroll
    for (int j = 0; j < 4; ++j) __builtin_nontemporal_store(ores[j], (f32x4*)(a.out + (size_t)mend * D + F.lane * 4 + 256 * j));
    }
}

constexpr int NPHASE = 11;
__global__ void __launch_bounds__(512, 2) mk_fwd(Args args) {
    extern __shared__ __attribute__((aligned(16))) unsigned char lds_raw[];
    Frame F;
    F.lds = (LAS unsigned char*)lds_raw; F.ws = args.ws; F.ctl = (unsigned*)(args.ws + WS_CTL);
    F.tid = threadIdx.x; F.lane = F.tid & 63; F.wave = __builtin_amdgcn_readfirstlane(F.tid >> 6); F.G = gridDim.x; F.bid = blockIdx.x;
    volatile LAS unsigned* MISC = (volatile LAS unsigned*)(F.lds + LDS_MISC);
    if (F.tid < 32) MISC[F.tid] = 0u;
    __syncthreads();
    XcdBarrier bar = xcd_barrier_post(F.ctl + CW_BAR + args.li * XCD_BAR_WORDS, MISC + 8);
    const int lo = args.ph_lo, hi = args.ph_hi;
#ifndef PHMASK
#define PHMASK 0x7ff
#endif
#define IN(k) (((PHMASK >> (k)) & 1) && lo <= (k) && (k) < hi)
#define SEAM(k) do { if (IN(k) && IN((k) + 1)) xcd_barrier(bar); } while (0)

    if (IN(0)) { p0_prologue(F, args); }
    if (IN(1)) for (int rep = 0; rep <= ((REPMASK >> 1) & 1); ++rep) { if (rep) xcd_barrier(bar); p1_normmod(F, args, 192u); }
    if (IN(1) && IN(2)) xcd_arrive(bar);
    if (IN(2)) for (int rep = 0; rep <= ((REPMASK >> 2) & 1); ++rep) { if (rep) xcd_barrier(bar);
        pg8::StaticOrder S; S.init(F.ws + WS_HX, F.ws + WS_WIN, M, NIN, D, F.G, F.bid);
        EpiInProj E{(bf16_t*)(F.ws + WS_P), args.in[12], (bf16_t*)(F.ws + WS_U)};
        const int nctx = 24;
        const bool tfirst = (F.bid >= nctx) && (((F.bid >> 3) & 1) != 0);
        const int nbefore = tfirst ? 11 : 2;
        if (F.bid >= nctx) { transpose_items_fp8(F, args, (F.bid - nctx) * 8 + F.wave, (F.G - nctx) * 8, 0, nbefore); __syncthreads(); }
        if (IN(1) && rep == 0) xcd_wait(bar);
        {
            pg8::P2Order O; O.S = S; O.ctx = (F.bid < nctx);
            O.cu.pm = 64 + F.bid / 6; O.cu.pn = 2 + F.bid % 6; O.cu.A = (const char*)(F.ws + WS_HX) + (size_t)O.cu.pm * 256 * D * 2; O.cu.B = (const char*)(F.ws + WS_WIN) + (size_t)O.cu.pn * 256 * D * 2;
            pg8::gemm_phase<EpiInProj, pg8::P2Order, false, true, true>(F.lds, D, O, E);
        }
        const bool lastrep = rep == ((REPMASK >> 2) & 1);
        if (F.bid >= nctx) {
            if (IN(3) && lastrep) xcd_arrive(bar);
            transpose_items_fp8(F, args, (F.bid - nctx) * 8 + F.wave, (F.G - nctx) * 8, nbefore, 1 << 20); __syncthreads();
        }
        if (F.bid < nctx) {
            asm volatile("s_waitcnt vmcnt(0)" ::: "memory");
            __syncthreads();
            if (F.tid == 0) { __builtin_amdgcn_fence(__ATOMIC_RELEASE, "agent"); asm volatile("s_waitcnt vmcnt(0)" ::: "memory");
                __hip_atomic_fetch_add(F.ctl + CW_CTX + 64 * (F.bid / 6), 1u, __ATOMIC_RELAXED, __HIP_MEMORY_SCOPE_AGENT); }
            if (IN(3) && lastrep) xcd_arrive(bar);
            const bf16_t* P = (const bf16_t*)(F.ws + WS_P); bf16_t* ST = (bf16_t*)(F.ws + WS_ST); float* DDp = (float*)(F.ws + WS_DD);
            for (int u = F.bid; u < 32; u += nctx) {
                const int b = u >> 3, h = (u >> 1) & 3;
                if (F.tid == 0) { unsigned sp = 0;
                    while (__hip_atomic_load(F.ctl + CW_CTX + 64 * b, __ATOMIC_RELAXED, __HIP_MEMORY_SCOPE_AGENT) < 6u * (unsigned)(rep + 1)) { __builtin_amdgcn_s_sleep(2); if (++sp > (1u << 22)) break; }
                    __builtin_amdgcn_fence(__ATOMIC_ACQUIRE, "agent"); asm volatile("s_waitcnt vmcnt(0)" ::: "memory"); }
                __syncthreads();
                if (u & 1) gla_passA_unit<1>(F, P, b, h, 0, ST + (size_t)(u * NBLK) * 16384, DDp + (u * NBLK) * 128);
                else gla_passA_unit<0>(F, P, b, h, 0, ST + (size_t)(u * NBLK) * 16384, DDp + (u * NBLK) * 128);
                __syncthreads();
            }
        }
    }
    if (IN(2) && IN(3)) xcd_wait(bar);
    if (IN(3)) for (int rep = 0; rep <= ((REPMASK >> 3) & 1); ++rep) { if (rep) xcd_barrier(bar);
        const bf16_t* P = (const bf16_t*)(F.ws + WS_P); bf16_t* A2 = (bf16_t*)(F.ws + WS_A2);
        const bf16_t* Up = (const bf16_t*)(F.ws + WS_U);
        bf16_t* ST = (bf16_t*)(F.ws + WS_ST); float* DDp = (float*)(F.ws + WS_DD);
        for (int uu = F.bid; uu < 32 * 16; uu += F.G) { const int seq = uu >> 4, blk = 1 + (uu & 15), b = seq >> 3, h = (seq >> 1) & 3, dir = seq & 1, u = seq * NBLK + blk;
            if (dir == 0) gla_passA_unit<0>(F, P, b, h, blk, ST + (size_t)u * 16384, DDp + u * 128);
            else gla_passA_unit<1>(F, P, b, h, blk, ST + (size_t)u * 16384, DDp + u * 128); }
    }
    if (IN(3) && IN(4)) xcd_arrive(bar);
    if (IN(3)) {
        bf16_t* A2 = (bf16_t*)(F.ws + WS_A2); const bf16_t* Up = (const bf16_t*)(F.ws + WS_U);
        for (int w = F.bid; w < 256; w += F.G) {
            const int grp = (w & 7) * 4 + ((w >> 3) >> 3), mem = (w >> 3) & 7, b = grp >> 3, slab = (grp & 7) * 8 + mem, gi = slab >> 4;
            if (gi == 0) pool_unit<2>(F, Up, A2, b, slab); else if (gi == 1) pool_unit<4>(F, Up, A2, b, slab); else if (gi == 2) pool_unit<8>(F, Up, A2, b, slab); else pool_unit<16>(F, Up, A2, b, slab); }
    }
    if (IN(3) && IN(4)) xcd_wait(bar);
    if (IN(4)) { p4_scan(F); }
    if (IN(4) && IN(5)) xcd_arrive(bar);
    if (IN(4)) p0_late(F, args);
    if (IN(4) && IN(5)) xcd_wait(bar);
    if (IN(5)) for (int rep = 0; rep <= ((REPMASK >> 5) & 1); ++rep) { if (rep) xcd_barrier(bar); for (int u = F.bid; u < 256; u += F.G) {
            const int x = u & 7, slot = u >> 3;
            gla_passC_unit(F, args, x >> 1, slot >> 3, (x & 1) * 8 + (slot & 7)); } }
    SEAM(5);
    if (IN(6)) for (int rep = 0; rep <= ((REPMASK >> 6) & 1); ++rep) { if (rep) xcd_barrier(bar);
        pg8::StaticOrder S; S.init(F.ws + WS_A2, F.ws + WS_WOUT, M, D, D, F.G, F.bid);
        EpiBf16Out E{(bf16_t*)(F.ws + WS_YXB), D};
        pg8::gemm_phase<EpiBf16Out, pg8::StaticOrder, false, false, true>(F.lds, D, S, E);
    }
    if (IN(6) && IN(7)) xcd_arrive(bar);
    if (IN(7)) { p7_rows(F, args, bar, IN(6) && IN(7)); }
    SEAM(7);
    if (IN(8)) for (int rep = 0; rep <= ((REPMASK >> 8) & 1); ++rep) { if (rep) xcd_barrier(bar);
        moe_tables(F);
        MoeOrder<8, true> S; S.tab = (const LAS int*)(F.lds + LDS_TAB); S.Abase = (const char*)(F.ws + WS_HX2F); S.Wbase = (const char*)(F.ws + WS_WGU); S.rtok = (const int*)(F.ws + WS_RTOK);
        S.cls = 0; S.rank = (F.bid & 7) * (F.G >> 3) + (F.bid >> 3); S.nrank = F.G; S.mtc = F.ctl + CW_MT;
        EpiGateUp E{F.ws + WS_H, args.in[19], args.in[21]};
        pg8::gemm_phase<EpiGateUp, MoeOrder<8, true>, true, true, true, true>(F.lds, 512, S, E);
    }
    if (IN(9)) for (int rep = 0; rep <= ((REPMASK >> 9) & 1); ++rep) { if (rep) xcd_barrier(bar);
        if (!IN(8) || rep) moe_tables(F);
        MoeOrder<4, false> S; S.tab = (const LAS int*)(F.lds + LDS_TAB); S.Abase = (const char*)(F.ws + WS_H); S.Wbase = (const char*)(F.ws + WS_WDN); S.rtok = nullptr;
        S.cls = 0; S.rank = F.G - 1 - ((F.bid & 7) * (F.G >> 3) + (F.bid >> 3)); S.nrank = F.G; S.mtc = F.ctl + CW_MT;
        EpiDown E{F.ws + WS_YB, args.in[23]};
        pg8::gemm_phase<EpiDown, MoeOrder<4, false>, false, true, true, true>(F.lds, 512, S, E);
    }
    if (IN(9) && IN(10)) xcd_arrive(bar);
    if (IN(10)) { if (!IN(9)) moe_tables(F);
        p10_final(F, args, bar, IN(9) && IN(10)); }
#undef IN
#undef SEAM
}

extern "C" void kernel_launch(void* const* d_in, const int* in_sizes, int n_in, void* d_out, int out_size, void* d_ws, size_t ws_size, hipStream_t stream) {
    static int grid = 0;
    if (grid == 0) {
        if (n_in != 24 || out_size != M * D || ws_size < WS_END) { fprintf(stderr, "kernel_launch: unexpected shapes (n_in %d out %d ws %zu)\n", n_in, out_size, ws_size); grid = -1; return; }
        int dev = 0, cus = 0, per_cu = 0;
        if (hipGetDevice(&dev) != hipSuccess || hipDeviceGetAttribute(&cus, hipDeviceAttributeMultiprocessorCount, dev) != hipSuccess) { grid = -1; return; }
        if (hipFuncSetAttribute((const void*)mk_fwd, hipFuncAttributeMaxDynamicSharedMemorySize, LDS_BYTES) != hipSuccess) { fprintf(stderr, "kernel_launch: hipFuncSetAttribute failed\n"); grid = -1; return; }
        if (hipOccupancyMaxActiveBlocksPerMultiprocessor(&per_cu, (const void*)mk_fwd, 512, LDS_BYTES) != hipSuccess || per_cu < 1) { fprintf(stderr, "kernel_launch: occupancy query says %d\n", per_cu); }
        (void)hipGetLastError();
        grid = cus;
        if (grid % 8 != 0 || M % grid != 0 || (M / grid) % 64 != 0) { fprintf(stderr, "kernel_launch: unsupported CU count %d\n", cus); grid = -1; return; }
    }
    if (grid < 0) return;
    if (hipMemsetAsync((char*)d_ws + WS_CTL, 0, CTL_ZERO_BYTES, stream) != hipSuccess) return;
    Args a{};
    for (int i = 0; i < 24; ++i) a.in[i] = (const float*)d_in[i];
    a.out = (float*)d_out; a.ws = (unsigned char*)d_ws; a.pad = 0;
    constexpr int NL = MK_N_LAUNCHES;
    for (int li = 0; li < NL; ++li) {
        a.ph_lo = (NL == 1) ? 0 : li; a.ph_hi = (NL == 1) ? NPHASE : li + 1; a.li = (NL == 1) ? 0 : 0;
        hipLaunchKernelGGL(mk_fwd, dim3(grid), dim3(512), LDS_BYTES, stream, a);
    }
}
```

```cpp
#include <hip/hip_runtime.h>
#include <cstdio>
#include <cstdint>

#define LAS __attribute__((address_space(3)))
typedef unsigned short bf16_t;
typedef short bf16x8 __attribute__((ext_vector_type(8)));
typedef float f32x4 __attribute__((ext_vector_type(4)));
typedef float f32x16 __attribute__((ext_vector_type(16)));
typedef unsigned u32x4 __attribute__((ext_vector_type(4)));
typedef unsigned u32x2 __attribute__((ext_vector_type(2)));

#ifndef MK_N_LAUNCHES
#define MK_N_LAUNCHES 1
#endif
#ifndef REPMASK
#define REPMASK 0x000
#endif

constexpr int D = 1024, NB = 4, SEQ = 4096, M = NB * SEQ, CTXL = 256, MC = NB * CTXL, MTOT = M + MC;
constexpr int NIN = 3072, NE = 32, TOPK = 4, FF = 1024;
constexpr int NHEAD = 4, HD = 128;
constexpr int NBLK = 17;
constexpr int ECAP = 16384;
constexpr int HROWS = 65536 + NE * 256;
constexpr float EPS = 1e-6f;

constexpr size_t MiB = 1u << 20;
constexpr size_t WS_CTL = 0, CTL_ZERO_BYTES = 1 * MiB;
constexpr size_t WS_MOD = 1 * MiB;
constexpr size_t WS_WRH = 1 * MiB + 128 * 1024;
constexpr size_t WS_WRL = 1 * MiB + 192 * 1024;
constexpr size_t WS_PE = 1 * MiB + 256 * 1024;
constexpr size_t WS_PSLOT = WS_PE + 256 * 1024;
constexpr size_t WS_PW = WS_PSLOT + 256 * 1024;
constexpr size_t WS_WIN = 2 * MiB;
constexpr size_t WS_WOUT = 8 * MiB;
constexpr size_t WS_WGU = 10 * MiB;
constexpr size_t WS_WDN = 74 * MiB;
constexpr size_t WS_HX2 = 106 * MiB;
constexpr size_t WS_HX2F = 138 * MiB;
constexpr size_t WS_U = 138 * MiB;
constexpr size_t WS_YB = 154 * MiB;
constexpr size_t WS_P = 234 * MiB;
constexpr size_t WS_X1B = 234 * MiB;
constexpr size_t WS_H = 298 * MiB;
constexpr size_t WS_HX = 336 * MiB;
constexpr size_t WS_ST = 370 * MiB;
constexpr size_t WS_DD = 405 * MiB;
constexpr size_t WS_A2 = 406 * MiB;
constexpr size_t WS_YX = 438 * MiB;
constexpr size_t WS_YXB = 470 * MiB;
constexpr size_t WS_RTOK = 502 * MiB;
constexpr size_t WS_END = 504 * MiB;
static_assert(WS_YB + (size_t)HROWS * 1024 * 2 <= WS_H && WS_H + (size_t)HROWS * 1024 <= WS_ST, "MoE buffers");
static_assert(WS_P + (size_t)MTOT * NIN * 2 <= WS_HX && WS_HX + (size_t)MTOT * D * 2 <= WS_ST && WS_ST + (size_t)32 * NBLK * 16384 * 4 <= WS_DD, "ws map");
constexpr float WSCALE = 256.0f, WSCALE_INV = 1.0f / 256.0f;

constexpr int CW_BAR = 4096;
constexpr int CW_CNT = 8192;
constexpr int CW_MT = 32768;
constexpr int CW_MOD = 12800;
constexpr int CW_CTX = 12288;

constexpr int RING_BYTES = 131072;
constexpr int LDS_TAB = RING_BYTES;
constexpr int LDS_MISC = RING_BYTES + 4096;
constexpr int LDS_BIAS = RING_BYTES + 1024;
constexpr int LDS_GOFF = RING_BYTES + 6144;
constexpr int LDS_BYTES = 155648;
static_assert(LDS_GOFF + 2 * 512 * 16 <= LDS_BYTES, "LDS map");
static_assert(8 * 16384 <= RING_BYTES, "per-wave scratch stays below the LDS tables / control words");

typedef float f32x2_ __attribute__((ext_vector_type(2)));
typedef __bf16 bf16x2_ __attribute__((ext_vector_type(2)));
__device__ __forceinline__ unsigned cvt_pk_bf16(float lo, float hi) { const bf16x2_ r = __builtin_convertvector((f32x2_){lo, hi}, bf16x2_); return __builtin_bit_cast(unsigned, r); }
__device__ __forceinline__ float bf2f(unsigned short b) { return __uint_as_float(((unsigned)b) << 16); }
__device__ __forceinline__ float bflo(unsigned w) { return __uint_as_float(w << 16); }
__device__ __forceinline__ float bfhi(unsigned w) { return __uint_as_float(w & 0xffff0000u); }
__device__ __forceinline__ unsigned short f2bf(float f) { return (unsigned short)(cvt_pk_bf16(f, 0.f) & 0xffffu); }
__device__ __forceinline__ unsigned pk4_fp8(float a, float b, float c, float d) { int w = __builtin_amdgcn_cvt_pk_fp8_f32(a, b, 0, false); w = __builtin_amdgcn_cvt_pk_fp8_f32(c, d, w, true); return (unsigned)w; }
__device__ __forceinline__ float sigmoidf_(float x) { return __builtin_amdgcn_rcpf(1.0f + __builtin_amdgcn_exp2f(-1.44269504089f * x)); }
__device__ __forceinline__ float wave_sum(float v) {
#pragma unroll
    for (int o = 1; o < 64; o <<= 1) v += __shfl_xor(v, o);
    return v;
}
#define LDS_WAIT() asm volatile("s_waitcnt lgkmcnt(0)" ::: "memory")
#define VM_WAIT() asm volatile("s_waitcnt vmcnt(0)" ::: "memory")
#define LSYNC() do { asm volatile("s_waitcnt lgkmcnt(0)" ::: "memory"); __builtin_amdgcn_s_barrier(); asm volatile("" ::: "memory"); } while (0)

#define XB_TMO      128
#define XB_XCNT(j)  (256  + 64 * (j))
#define XB_XSUB(j)  (1280 + 64 * (j))
#define XB_XGEN(j)  (2304 + 64 * (j))
#define XB_TOP      3328
#define XB_TOPGEN   3392
#define XCD_BAR_WORDS 3456
#define XB_SPIN_CAP (1u << 18)
__device__ __forceinline__ unsigned xb_ld(unsigned* p)              { return __hip_atomic_load(p, __ATOMIC_RELAXED, __HIP_MEMORY_SCOPE_AGENT); }
__device__ __forceinline__ unsigned xb_add(unsigned* p, unsigned v) { return __hip_atomic_fetch_add(p, v, __ATOMIC_RELAXED, __HIP_MEMORY_SCOPE_AGENT); }
__device__ __forceinline__ unsigned xb_xcc_id() { return (unsigned)__builtin_amdgcn_s_getreg((3 << 11) | 20) & 0xFu; }
#define XB_SPIN(cond, bar) do { unsigned _sp = 0; while (cond) { __builtin_amdgcn_s_sleep(1); \
    if ((++_sp & 255u) == 0u) { if (xb_ld(&(bar)[XB_TMO])) break; if (_sp > XB_SPIN_CAP) { atomicAdd(&(bar)[XB_TMO], 1u); break; } } } } while (0)
struct XcdBarrier { unsigned* bar; unsigned x; volatile LAS unsigned* st; };
__device__ __forceinline__ XcdBarrier xcd_barrier_post(unsigned* bar, volatile LAS unsigned* st) {
    XcdBarrier b; b.bar = bar; b.x = xb_xcc_id(); b.st = st;
    if (threadIdx.x == 0) (void)xb_add(&bar[XB_XCNT(b.x)], 1u);
    return b;
}
__device__ __forceinline__ void xcd_barrier_complete(unsigned* bar, unsigned x, unsigned& nloc, unsigned& nx) {
    const unsigned G = gridDim.x * gridDim.y * gridDim.z;
    unsigned sum, cnt, mine, sp = 0u;
    for (;;) {
        sum = 0u; cnt = 0u; mine = 0u;
#pragma unroll
        for (unsigned j = 0; j < 16; ++j) { const unsigned c = xb_ld(&bar[XB_XCNT(j)]); sum += c; cnt += (c > 0u) ? 1u : 0u; mine = (j == x) ? c : mine; }
        if (sum == G) break;
        __builtin_amdgcn_s_sleep(1);
        if ((++sp & 255u) == 0u) { if (xb_ld(&bar[XB_TMO])) break; if (sp > XB_SPIN_CAP) { atomicAdd(&bar[XB_TMO], 1u); break; } }
    }
    nloc = mine > 0u ? mine : 1u; nx = cnt > 0u ? cnt : 1u;
}
__device__ __forceinline__ void xcd_arrive(const XcdBarrier& b) {
    asm volatile("s_waitcnt vmcnt(0)" ::: "memory");
    __syncthreads();
    if (threadIdx.x == 0) {
        unsigned* bar = b.bar;
        __builtin_amdgcn_s_waitcnt(0);
        unsigned nloc = b.st[0], nx = b.st[1];
        if (nloc == 0u) { xcd_barrier_complete(bar, b.x, nloc, nx); b.st[0] = nloc; b.st[1] = nx; }
        const unsigned old = xb_add(&bar[XB_XSUB(b.x)], 1u);
        const unsigned gen = old / nloc;
        if (old + 1u == (gen + 1u) * nloc) {
            __builtin_amdgcn_fence(__ATOMIC_RELEASE, "agent");
            asm volatile("s_waitcnt vmcnt(0)" ::: "memory");
#pragma unroll
            for (unsigned j = 0; j < 16; ++j) (void)xb_add(&bar[XB_XGEN(j)], 1u);
        }
        b.st[2] = nx * (gen + 1u);
    }
}
__device__ __forceinline__ void xcd_wait(const XcdBarrier& b) {
    if (threadIdx.x == 0) {
        unsigned* bar = b.bar;
        const unsigned need = b.st[2];
        XB_SPIN((int)(xb_ld(&bar[XB_XGEN(b.x)]) - need) < 0, bar);
        __builtin_amdgcn_fence(__ATOMIC_ACQUIRE, "agent");
        asm volatile("s_waitcnt vmcnt(0)" ::: "memory");
    }
    __syncthreads();
}
__device__ __forceinline__ void xcd_barrier(const XcdBarrier& b) { xcd_arrive(b); xcd_wait(b); }

namespace pg8 {
constexpr int BM = 256, BK = 64, HALF = 128, HTB = HALF * BK * 2, STAGE_BYTES = 8 * HTB, NXCD = 8, WGM = 8;
__host__ __device__ __forceinline__ int lds_byte(int r, int c) { const int st = (r >> 4) * 2 + (c >> 5), rr = r & 15, cc = c & 31, ob = rr * 64 + cc * 2; return st * 1024 + (ob ^ (((ob >> 9) & 1) << 5)); }
__host__ __device__ __forceinline__ void stage_rc(int b, int& R, int& C) { const int st = b / 1024, sb = b % 1024, swz = sb ^ (((sb >> 9) & 1) << 5); R = (st >> 1) * 16 + swz / 64; C = (st & 1) * 32 + (swz % 64) / 2; }
__host__ __device__ __forceinline__ int perm32(int rho) { const int n = rho >> 4, i = rho & 15; return 8 * (i >> 2) + 4 * n + (i & 3); }

struct UnitS { const char* A; const char* B; int pm, pn; };
struct StaticOrder {
    typedef UnitS Unit;
    const char* Abase; const char* Bbase; size_t tstep;
    int nM, nN, nwg, G, c;
    __device__ void init(const void* A, const void* Bt, int M_, int N_, int K_, int G_, int c_) { Abase = (const char*)A; Bbase = (const char*)Bt; tstep = (size_t)BM * K_ * 2; nM = M_ / BM; nN = N_ / BM; nwg = nM * nN; G = G_; c = c_; }
    __device__ bool next(int i, Unit& u) const {
        const long L = (long)i * G + c; if (L >= nwg) return false;
        int wgid = (int)L; { const int q = nwg / NXCD, r = nwg % NXCD, xcd = wgid % NXCD, off = wgid / NXCD; wgid = (xcd < r ? xcd * (q + 1) : r * (q + 1) + (xcd - r) * q) + off; }
        const int nig = WGM * nN, gid = wgid / nig, fm = gid * WGM, gsz = (nM - fm) < WGM ? (nM - fm) : WGM;
        u.pm = fm + ((wgid % nig) % gsz); u.pn = (wgid % nig) / gsz;
        u.A = Abase + (size_t)u.pm * tstep; u.B = Bbase + (size_t)u.pn * tstep; return true;
    }
    static constexpr bool PUBLISH = false;
    __device__ __forceinline__ const int* row_src(const Unit&, int) const { return nullptr; }
    __device__ __forceinline__ unsigned row_tok(const Unit&, int) const { return 0u; }
    __device__ __forceinline__ void a_ready(const Unit&, int) const {}
    __device__ __forceinline__ int key(const Unit&) const { return 0; }
    __device__ __forceinline__ void publish(int) const {}
};

struct OneUnit { typedef UnitS Unit; UnitS u; static constexpr bool PUBLISH = false;
    __device__ bool next(int i, Unit& o) const { if (i) return false; o = u; return true; }
    __device__ __forceinline__ const int* row_src(const Unit&, int) const { return nullptr; } __device__ __forceinline__ unsigned row_tok(const Unit&, int) const { return 0u; }
    __device__ __forceinline__ void a_ready(const Unit&, int) const {} __device__ __forceinline__ int key(const Unit&) const { return 0; } __device__ __forceinline__ void publish(int) const {} };
struct P2Order { typedef UnitS Unit; StaticOrder S; UnitS cu; bool ctx; static constexpr bool PUBLISH = false;
    __device__ bool next(int i, Unit& o) const { if (i < 3) return S.next(i, o); if (i == 3 && ctx) { o = cu; return true; } return false; }
    __device__ __forceinline__ const int* row_src(const Unit&, int) const { return nullptr; } __device__ __forceinline__ unsigned row_tok(const Unit&, int) const { return 0u; }
    __device__ __forceinline__ void a_ready(const Unit&, int) const {} __device__ __forceinline__ int key(const Unit&) const { return 0; } __device__ __forceinline__ void publish(int) const {} };
typedef int i32x4 __attribute__((ext_vector_type(4)));
typedef int i32x8 __attribute__((ext_vector_type(8)));
template <class Epi, class Sched, bool GATHER, bool ALIGN_EPI, bool SP2, bool FP8 = false>
__device__ __forceinline__ void gemm_phase(LAS unsigned char* lds, const int K, const Sched& S, const Epi& E) {
    typedef typename Sched::Unit Unit;
    const int tid = threadIdx.x, wid = __builtin_amdgcn_readfirstlane(tid >> 6), lane = tid & 63, wr = wid >> 2, wc = wid & 3, fr = lane & 15, fq = lane >> 4;
    const int nt = K / BK;
    const size_t kstep = (size_t)(BK * 2);
    const size_t kstepB = FP8 ? (size_t)4096 : kstep;
    const size_t hstep = (size_t)HALF * K * 2;
    unsigned voffB[2], cA0[2], cA1[2];
#pragma unroll
    for (int i = 0; i < 2; ++i) { int R, C; stage_rc(tid * 16 + i * 8192, R, C); const int Rb = Epi::PERM ? ((R & ~31) + perm32(R & 31)) : R;
        voffB[i] = FP8 ? (unsigned)((Rb >> 5) * 32768 + (Rb & 31) * 128 + C * 2) : (unsigned)(Rb * K + C) * 2u; cA0[i] = (unsigned)(R * K + C) * 2u; cA1[i] = cA0[i] + (unsigned)hstep; }
#define gro(p, v) ((LAS unsigned*)(lds + LDS_GOFF + (p) * 8192 + (v) * 2048 + tid * 4))
    int gp = 0;
    unsigned gcc[2] = {0u, 0u};
    if constexpr (GATHER) { int R, C; stage_rc(tid * 16, R, C); gcc[0] = (unsigned)C * 2u; stage_rc(tid * 16 + 8192, R, C); gcc[1] = (unsigned)C * 2u; }
    const unsigned ldsw = (unsigned)wid * 1024u;
    const int aoff = lds_byte(wr * 64 + fr, fq * 8), boff = lds_byte(wc * 32 + fr, fq * 8);
#define PG8_SA(b, h) (((b) * 2 + (h)) * HTB)
#define PG8_SB(b, h) ((4 + (b) * 2 + (h)) * HTB)
#define PG8_STAGE(bufoff, gbase, voff) do { _Pragma("unroll") for (int _i = 0; _i < 2; ++_i) \
        __builtin_amdgcn_global_load_lds((const unsigned*)((const char*)(gbase) + (voff)[_i]), (LAS unsigned*)(lds + (bufoff) + ldsw + _i * 8192), 16, 0, 0); } while (0)
#define PG8_LDA(dst, b, h) do { _Pragma("unroll") for (int m = 0; m < 4; ++m) { const i32x4 _p0 = *(const LAS i32x4*)(lds + PG8_SA(b, h) + aoff + m * 2048), _p1 = *(const LAS i32x4*)(lds + PG8_SA(b, h) + aoff + m * 2048 + 1024); \
        dst[m] = __builtin_shufflevector(_p0, _p1, 0, 1, 2, 3, 4, 5, 6, 7); } } while (0)
#define PG8_LDB(dst, b, h) do { _Pragma("unroll") for (int n = 0; n < 2; ++n) { const i32x4 _p0 = *(const LAS i32x4*)(lds + PG8_SB(b, h) + boff + n * 2048), _p1 = *(const LAS i32x4*)(lds + PG8_SB(b, h) + boff + n * 2048 + 1024); \
        dst[n] = __builtin_shufflevector(_p0, _p1, 0, 1, 2, 3, 4, 5, 6, 7); } } while (0)
#define PG8_ACC(ai, bj, m, n) ((n) ? __builtin_shufflevector(acc[ai][bj][m], acc[ai][bj][m], 4, 5, 6, 7) : __builtin_shufflevector(acc[ai][bj][m], acc[ai][bj][m], 0, 1, 2, 3))
#define PG8_SETACC(ai, bj, m, n, v) do { const f32x4 _v = (v); if (n) acc[ai][bj][m] = __builtin_shufflevector(acc[ai][bj][m], __builtin_shufflevector(_v, _v, 0, 1, 2, 3, 0, 1, 2, 3), 0, 1, 2, 3, 12, 13, 14, 15); \
        else acc[ai][bj][m] = __builtin_shufflevector(acc[ai][bj][m], __builtin_shufflevector(_v, _v, 0, 1, 2, 3, 0, 1, 2, 3), 8, 9, 10, 11, 4, 5, 6, 7); } while (0)
#define PG8_MMA(ai, bj, At, Bt) do { __builtin_amdgcn_s_setprio(1); _Pragma("unroll") for (int m = 0; m < 4; ++m) _Pragma("unroll") for (int n = 0; n < 2; ++n) { \
        if constexpr (FP8) { PG8_SETACC(ai, bj, m, n, __builtin_amdgcn_mfma_scale_f32_16x16x128_f8f6f4(Bt[n], At[m], PG8_ACC(ai, bj, m, n), 0, 0, 0, 127, 0, 127)); } \
        else { f32x4 _c = __builtin_amdgcn_mfma_f32_16x16x32_bf16(__builtin_bit_cast(bf16x8, __builtin_shufflevector(Bt[n], Bt[n], 0, 1, 2, 3)), __builtin_bit_cast(bf16x8, __builtin_shufflevector(At[m], At[m], 0, 1, 2, 3)), PG8_ACC(ai, bj, m, n), 0, 0, 0); \
               PG8_SETACC(ai, bj, m, n, __builtin_amdgcn_mfma_f32_16x16x32_bf16(__builtin_bit_cast(bf16x8, __builtin_shufflevector(Bt[n], Bt[n], 4, 5, 6, 7)), __builtin_bit_cast(bf16x8, __builtin_shufflevector(At[m], At[m], 4, 5, 6, 7)), _c, 0, 0, 0)); } } \
        __builtin_amdgcn_s_setprio(0); } while (0)
#define PG8_WAIT_V(n) asm volatile("s_waitcnt vmcnt(" #n ")" ::: "memory")
#define PG8_WAIT_L(n) asm volatile("s_waitcnt lgkmcnt(" #n ")" ::: "memory")
#define PG8_BAR __builtin_amdgcn_s_barrier()
#define PG8_SCHED __builtin_amdgcn_sched_barrier(0)
    Unit cur, nxt; int ui = 0; int pkey = 0;
    if (!S.next(0, cur)) return;
    S.a_ready(cur, wid);
    if constexpr (GATHER) {
#pragma unroll
        for (int i = 0; i < 2; ++i) { int R, C; int t2 = tid; asm volatile("" : "+v"(t2)); stage_rc(t2 * 16 + i * 8192, R, C);
            const unsigned r0 = S.row_tok(cur, R), r1 = S.row_tok(cur, HALF + R); *gro(0, i) = r0; *gro(0, 2 + i) = r1;
            cA0[i] = r0 + (unsigned)C * 2u; cA1[i] = r1 + (unsigned)C * 2u; }
    }
    typedef float f32x8_ __attribute__((ext_vector_type(8)));
    f32x8_ acc[2][2][4];
    float zero_; asm volatile("v_mov_b32 %0, 0" : "=v"(zero_));
#pragma unroll
    for (int a = 0; a < 2; ++a)
#pragma unroll
        for (int b = 0; b < 2; ++b)
#pragma unroll
            for (int m = 0; m < 4; ++m) acc[a][b][m] = (f32x8_){zero_, zero_, zero_, zero_, zero_, zero_, zero_, zero_};
    i32x8 At[4], B0[2], B1[2];
    const char* cA = cur.A; const char* cB = cur.B;
    if constexpr (Epi::LDS_BIAS) E.stage_bias(cur, lds + LDS_BIAS, wid, lane);
    if constexpr (SP2) {
        PG8_STAGE(PG8_SB(0, 0), cB, voffB); PG8_STAGE(PG8_SB(0, 1), cB + hstep, voffB); PG8_STAGE(PG8_SA(0, 0), cA, cA0); PG8_STAGE(PG8_SA(0, 1), cA, cA1);
        if (wr == 1) PG8_BAR;
        PG8_WAIT_V(2); PG8_BAR;
        PG8_STAGE(PG8_SB(1, 0), cB + kstepB, voffB); PG8_STAGE(PG8_SA(1, 0), cA + kstep, cA0); PG8_STAGE(PG8_SB(1, 1), cB + hstep + kstepB, voffB);
        PG8_WAIT_V(6); PG8_BAR;
    } else {
        PG8_STAGE(PG8_SB(0, 0), cB, voffB); PG8_STAGE(PG8_SA(0, 0), cA, cA0); PG8_STAGE(PG8_SB(0, 1), cB + hstep, voffB); PG8_STAGE(PG8_SA(0, 1), cA, cA1);
        if (wr == 1) PG8_BAR;
        PG8_WAIT_V(4); PG8_BAR;
        PG8_STAGE(PG8_SB(1, 0), cB + kstepB, voffB); PG8_STAGE(PG8_SA(1, 0), cA + kstep, cA0); PG8_STAGE(PG8_SB(1, 1), cB + hstep + kstepB, voffB);
        PG8_WAIT_V(6); PG8_BAR;
    }
    for (;;) {
        const bool has_next = S.next(ui + 1, nxt);
        const char* nA = has_next ? nxt.A : cA; const char* nB = has_next ? nxt.B : cB;
        if constexpr (GATHER) {
            if (has_next) {
                int R0, C0, R1, C1; int t2 = tid; asm volatile("" : "+v"(t2)); stage_rc(t2 * 16, R0, C0); stage_rc(t2 * 16 + 8192, R1, C1);
                LAS unsigned char* gb = lds + LDS_GOFF + (gp ^ 1) * 8192 + wid * 256;
                __builtin_amdgcn_global_load_lds((const unsigned*)S.row_src(nxt, R0), (LAS unsigned*)(gb), 4, 0, 0);
                __builtin_amdgcn_global_load_lds((const unsigned*)S.row_src(nxt, R1), (LAS unsigned*)(gb + 2048), 4, 0, 0);
                __builtin_amdgcn_global_load_lds((const unsigned*)S.row_src(nxt, HALF + R0), (LAS unsigned*)(gb + 4096), 4, 0, 0);
                __builtin_amdgcn_global_load_lds((const unsigned*)S.row_src(nxt, HALF + R1), (LAS unsigned*)(gb + 6144), 4, 0, 0);
            }
        }
#pragma unroll 1
        for (int t = 0; t < nt; t += 2) {
            const bool last = (t == nt - 2);
            if (last && has_next) S.a_ready(nxt, wid);
            const char* a1 = cA + (size_t)(t + 1) * kstep;
            const char* a2 = last ? nA : cA + (size_t)(t + 2) * kstep; const char* b2 = last ? nB : cB + (size_t)(t + 2) * kstepB;
            const char* a3 = a2 + kstep; const char* b3 = b2 + kstepB;
            const int gq = (last && has_next) ? (gp ^ 1) : gp;
#define PG8_GO(p, v, dst) unsigned dst[2]; if constexpr (GATHER) { dst[0] = *gro(p, v) + gcc[0]; dst[1] = *gro(p, (v) + 1) + gcc[1]; } else { dst[0] = ((v) ? cA1 : cA0)[0]; dst[1] = ((v) ? cA1 : cA0)[1]; }
            if constexpr (SP2) {
            { PG8_GO(gp, 2, y1); PG8_LDB(B0, 0, 0); PG8_LDB(B1, 0, 1); PG8_SCHED; PG8_LDA(At, 0, 0); PG8_STAGE(PG8_SA(1, 1), a1, y1); }
            PG8_WAIT_V(8); PG8_WAIT_L(0); PG8_BAR; PG8_MMA(0, 0, At, B0); PG8_MMA(0, 1, At, B1); PG8_BAR; PG8_SCHED;
            { PG8_GO(gq, 0, x0); PG8_LDA(At, 0, 1); PG8_STAGE(PG8_SB(0, 0), b2, voffB); PG8_STAGE(PG8_SB(0, 1), b2 + hstep, voffB); PG8_STAGE(PG8_SA(0, 0), a2, x0); }
            PG8_WAIT_V(8); PG8_WAIT_L(0); PG8_BAR; PG8_MMA(1, 0, At, B0); PG8_MMA(1, 1, At, B1); PG8_BAR; PG8_SCHED;
            { PG8_GO(gq, 2, x1); PG8_LDB(B0, 1, 0); PG8_LDB(B1, 1, 1); PG8_SCHED; PG8_LDA(At, 1, 0); PG8_STAGE(PG8_SA(0, 1), a2, x1); }
            PG8_WAIT_V(8); PG8_WAIT_L(0); PG8_BAR; PG8_MMA(0, 0, At, B0); PG8_MMA(0, 1, At, B1); PG8_BAR; PG8_SCHED;
            { PG8_GO(gq, 0, x0); PG8_LDA(At, 1, 1); PG8_STAGE(PG8_SB(1, 0), b3, voffB); PG8_STAGE(PG8_SB(1, 1), b3 + hstep, voffB); PG8_STAGE(PG8_SA(1, 0), a3, x0); }
            PG8_WAIT_V(8); PG8_WAIT_L(0); PG8_BAR; PG8_MMA(1, 0, At, B0); PG8_MMA(1, 1, At, B1); PG8_BAR; PG8_SCHED;
            } else {
            PG8_GO(gp, 2, y1); PG8_GO(gq, 0, x0); PG8_GO(gq, 2, x1);
            PG8_LDB(B0, 0, 0); PG8_SCHED; PG8_LDA(At, 0, 0); PG8_STAGE(PG8_SA(1, 1), a1, y1);
            PG8_WAIT_L(8); PG8_BAR; PG8_WAIT_L(0); PG8_MMA(0, 0, At, B0); PG8_BAR; PG8_SCHED;
            PG8_LDB(B1, 0, 1); PG8_STAGE(PG8_SB(0, 0), b2, voffB);
            PG8_BAR; PG8_WAIT_L(0); PG8_MMA(0, 1, At, B1); PG8_BAR;
            PG8_LDA(At, 0, 1); PG8_STAGE(PG8_SA(0, 0), a2, x0);
            PG8_BAR; PG8_WAIT_L(0); PG8_MMA(1, 0, At, B0); PG8_BAR; PG8_SCHED;
            PG8_STAGE(PG8_SB(0, 1), b2 + hstep, voffB);
            PG8_WAIT_V(6); PG8_BAR; PG8_MMA(1, 1, At, B1); PG8_BAR;
            PG8_LDB(B0, 1, 0); PG8_SCHED; PG8_LDA(At, 1, 0); PG8_STAGE(PG8_SA(0, 1), a2, x1);
            PG8_WAIT_L(8); PG8_BAR; PG8_WAIT_L(0); PG8_MMA(0, 0, At, B0); PG8_BAR; PG8_SCHED;
            PG8_LDB(B1, 1, 1); PG8_STAGE(PG8_SB(1, 0), b3, voffB);
            PG8_BAR; PG8_WAIT_L(0); PG8_MMA(0, 1, At, B1); PG8_BAR;
            PG8_LDA(At, 1, 1); PG8_STAGE(PG8_SA(1, 0), a3, x0);
            PG8_BAR; PG8_WAIT_L(0); PG8_MMA(1, 0, At, B0); PG8_BAR; PG8_SCHED;
            PG8_STAGE(PG8_SB(1, 1), b3 + hstep, voffB);
            PG8_WAIT_V(6); PG8_BAR; PG8_MMA(1, 1, At, B1); PG8_BAR;
            }
        }
        if constexpr (ALIGN_EPI) { if (wr == 0) PG8_BAR; }
        asm volatile("" ::: "memory");
        if constexpr (Sched::PUBLISH) { if (ui > 0) S.publish(pkey); }
        { f32x4 av[2][2][4][2];
#pragma unroll
          for (int a = 0; a < 2; ++a)
#pragma unroll
              for (int b = 0; b < 2; ++b)
#pragma unroll
                  for (int m = 0; m < 4; ++m) { av[a][b][m][0] = PG8_ACC(a, b, m, 0); av[a][b][m][1] = PG8_ACC(a, b, m, 1); }
          int t3 = tid; asm volatile("" : "+v"(t3)); const int fr3 = t3 & 15, fq3 = (t3 & 63) >> 4;
          if constexpr (Epi::LDS_BIAS) E(av, cur, wr, wc, fr3, fq3, lds + LDS_BIAS + (ui & 1) * 1024); else E(av, cur, wr, wc, fr3, fq3); }
        if constexpr (Sched::PUBLISH) { pkey = S.key(cur); if (!has_next) S.publish(pkey); }
        if (!has_next) break;
#pragma unroll
        for (int a = 0; a < 2; ++a)
#pragma unroll
            for (int b = 0; b < 2; ++b)
#pragma unroll
                for (int m = 0; m < 4; ++m) acc[a][b][m] = (f32x8_){zero_, zero_, zero_, zero_, zero_, zero_, zero_, zero_};
        cur = nxt; cA = nA; cB = nB; ++ui;
        if constexpr (Epi::LDS_BIAS) E.stage_bias(cur, lds + LDS_BIAS + (ui & 1) * 1024, wid, lane);
        if constexpr (GATHER) gp ^= 1;
        if constexpr (ALIGN_EPI) { if (wr == 1) PG8_BAR; }
    }
    PG8_WAIT_V(0);
    if constexpr (!ALIGN_EPI) { if (wr == 0) PG8_BAR; }
    PG8_BAR;
#undef PG8_SA
#undef PG8_SB
#undef PG8_STAGE
#undef PG8_LDA
#undef PG8_LDB
#undef PG8_MMA
#undef gro
#undef PG8_GO
#undef PG8_ACC
#undef PG8_SETACC
#undef PG8_WAIT_V
#undef PG8_WAIT_L
#undef PG8_BAR
#undef PG8_SCHED
}
}

struct EpiInProj {
    static constexpr bool PERM = true, LDS_BIAS = false;
    bf16_t* P; const float* lbl; bf16_t* U; const float* gain;
    __device__ __forceinline__ void operator()(const f32x4 (&acc)[2][2][4][2], const pg8::UnitS& u, int wr, int wc, int fr, int fq) const {
        typedef float f32x2 __attribute__((ext_vector_type(2)));
        const int row0 = u.pm * 256 + wr * 64 + fr, col0 = u.pn * 256 + wc * 32 + 8 * fq, type = u.pn >> 1;
        f32x2 lbv[2][4], olb[2][4];
#pragma unroll
        for (int bj = 0; bj < 2; ++bj)
#pragma unroll
            for (int p = 0; p < 4; ++p) { lbv[bj][p] = (f32x2){0.f, 0.f}; olb[bj][p] = (f32x2){1.f, 1.f}; }
        if (type == 4) {
#pragma unroll
            for (int bj = 0; bj < 2; ++bj) { const int ch = col0 + bj * 128 - 2048;
#pragma unroll
                for (int p = 0; p < 4; ++p) { lbv[bj][p].x = gain[ch + 2 * p]; lbv[bj][p].y = gain[ch + 2 * p + 1]; } }
        }
        if (type == 1 || type == 2) {
#pragma unroll
            for (int bj = 0; bj < 2; ++bj) { const int ch = col0 + bj * 128 - 512;
#pragma unroll
                for (int p = 0; p < 4; ++p) { lbv[bj][p].x = sigmoidf_(lbl[ch + 2 * p] - lbl[1024 + ch + 2 * p]); lbv[bj][p].y = sigmoidf_(lbl[ch + 2 * p + 1] - lbl[1024 + ch + 2 * p + 1]); olb[bj][p] = 1.0f - lbv[bj][p]; } }
        }
#pragma unroll
        for (int ai = 0; ai < 2; ++ai)
#pragma unroll
            for (int m = 0; m < 4; ++m) { bf16_t* rowp = P + (size_t)(row0 + ai * 128 + m * 16) * NIN + col0;
#pragma unroll
                for (int bj = 0; bj < 2; ++bj) { f32x2 v[4];
#pragma unroll
                    for (int p = 0; p < 4; ++p) { const f32x4 a = acc[ai][bj][m][p >> 1]; v[p] = (p & 1) ? (f32x2){a.z, a.w} : (f32x2){a.x, a.y}; }
                    if (type == 0 || type == 1 || type == 2 || type == 4) {
#pragma unroll
                        for (int p = 0; p < 4; ++p) { const f32x2 ea = v[p] * (-1.44269504089f);
                            f32x2 t; t.x = __builtin_amdgcn_exp2f(ea.x); t.y = __builtin_amdgcn_exp2f(ea.y); t = t + 1.0f;
                            f32x2 sg; sg.x = __builtin_amdgcn_rcpf(t.x); sg.y = __builtin_amdgcn_rcpf(t.y);
                            if (type == 0) v[p] = v[p] * sg;
                            else if (type == 4) v[p] = sg * lbv[bj][p];
                            else { const f32x2 f = sg * olb[bj][p] + lbv[bj][p]; f32x2 lg; lg.x = __builtin_amdgcn_logf(f.x); lg.y = __builtin_amdgcn_logf(f.y); v[p] = lg; } }
                    }
                    u32x4 w; w.x = cvt_pk_bf16(v[0].x, v[0].y); w.y = cvt_pk_bf16(v[1].x, v[1].y); w.z = cvt_pk_bf16(v[2].x, v[2].y); w.w = cvt_pk_bf16(v[3].x, v[3].y);
                    if (type == 5) { const int row = row0 + ai * 128 + m * 16, slab = (col0 + bj * 128 - 2560) >> 3;
                        *(u32x4*)(U + ((size_t)((row >> 12) * 64 + slab) * 4096 + (row & 4095)) * 8) = w; }
                    else *(u32x4*)(rowp + bj * 128) = w; } }
    }
};
struct EpiBf16Out {
    static constexpr bool PERM = true, LDS_BIAS = false;
    bf16_t* C; int ldc;
    __device__ __forceinline__ void operator()(const f32x4 (&acc)[2][2][4][2], const pg8::UnitS& u, int wr, int wc, int fr, int fq) const {
        const int row0 = u.pm * 256 + wr * 64 + fr, col0 = u.pn * 256 + wc * 32 + 8 * fq;
#pragma unroll
        for (int ai = 0; ai < 2; ++ai)
#pragma unroll
            for (int m = 0; m < 4; ++m) { bf16_t* rowp = C + (size_t)(row0 + ai * 128 + m * 16) * ldc + col0;
#pragma unroll
                for (int bj = 0; bj < 2; ++bj) { const f32x4 v0 = acc[ai][bj][m][0], v1 = acc[ai][bj][m][1];
                    u32x4 w; w.x = cvt_pk_bf16(v0[0], v0[1]); w.y = cvt_pk_bf16(v0[2], v0[3]); w.z = cvt_pk_bf16(v1[0], v1[1]); w.w = cvt_pk_bf16(v1[2], v1[3]);
                    *(u32x4*)(rowp + bj * 128) = w; } }
    }
};

struct UnitM { const char* A; const char* B; int e, mt, pn, row0, cnt; };
typedef int i32x4_ __attribute__((ext_vector_type(4)));
template <int NT_, bool GATHER_>
struct MoeOrder {
    typedef UnitM Unit;
    static constexpr int pitch = 1024; static constexpr size_t wstride = (size_t)NT_ * 256 * 1024;
    const LAS int* tab;
    const char* Abase; const char* Wbase; const int* rtok;
    unsigned* mtc;
    int cls, rank, nrank;
    static constexpr bool PUBLISH = GATHER_;
    __device__ __forceinline__ int key(const Unit& u) const { return u.row0 >> 8; }
    __device__ __forceinline__ void publish(int k) const {
        asm volatile("s_waitcnt vmcnt(0)" ::: "memory");
        if ((threadIdx.x & 63) == 0) __hip_atomic_fetch_add(mtc + 64 * k, 1u, __ATOMIC_RELAXED, __HIP_MEMORY_SCOPE_AGENT);
    }
    __device__ __forceinline__ void a_ready(const Unit& u, int wid) const {
        if constexpr (!GATHER_) {
            if (wid == 0) { unsigned sp = 0;
                while ((unsigned)__builtin_amdgcn_readfirstlane(__hip_atomic_load(mtc + 64 * (u.row0 >> 8), __ATOMIC_RELAXED, __HIP_MEMORY_SCOPE_AGENT)) < 64u) { __builtin_amdgcn_s_sleep(2); if (++sp > (1u << 22)) break; }
                __builtin_amdgcn_fence(__ATOMIC_ACQUIRE, "agent");
                asm volatile("s_waitcnt vmcnt(0)" ::: "memory"); }
            asm volatile("" ::: "memory"); __builtin_amdgcn_s_barrier(); asm volatile("" ::: "memory");
        }
    }
    __device__ bool next(int i, Unit& u) const {
        const int L = i * nrank + rank; const int mtg = L / NT_; u.pn = L - mtg * NT_;
        if (mtg >= __builtin_amdgcn_readfirstlane(tab[64])) return false;
        int ecount = 0;
#pragma unroll
        for (int q = 0; q < 8; ++q) { const i32x4_ p4 = *(const LAS i32x4_*)(tab + 32 + 4 * q); const int row = mtg * 256;
            ecount += (p4.x <= row) + (p4.y <= row) + (p4.z <= row) + (p4.w <= row); }
        const int e = __builtin_amdgcn_readfirstlane(ecount) - 1;
        const int pb = __builtin_amdgcn_readfirstlane(tab[32 + e]);
        u.e = e; u.mt = mtg - (pb >> 8); u.cnt = __builtin_amdgcn_readfirstlane(tab[e]); u.row0 = mtg * 256;
        u.B = Wbase + (size_t)e * wstride + (size_t)u.pn * 256 * pitch;
        u.A = GATHER_ ? Abase : Abase + (size_t)u.row0 * pitch;
        return true;
    }
    __device__ __forceinline__ const int* row_src(const Unit& u, int r) const { const int slot = u.mt * 256 + r; return rtok + u.e * ECAP + (slot < u.cnt ? slot : 0); }
    __device__ __forceinline__ unsigned row_tok(const Unit& u, int r) const { return (unsigned)*row_src(u, r); }
};
struct EpiGateUp {
    static constexpr bool PERM = true, LDS_BIAS = true;
    unsigned char* H; const float* bg; const float* bu;
    __device__ __forceinline__ void stage_bias(const UnitM& u, LAS unsigned char* dst, int wid, int lane) const {
        if (wid < 4) { const float* src = ((wid & 2) ? bu : bg) + u.e * FF + u.pn * 128 + (wid & 1) * 64 + lane;
            __builtin_amdgcn_global_load_lds((const unsigned*)src, (LAS unsigned*)(dst + wid * 256), 4, 0, 0); }
    }
    __device__ __forceinline__ void operator()(const f32x4 (&acc)[2][2][4][2], const UnitM& u, int wr, int wc, int fr, int fq, const LAS unsigned char* lb) const {
        typedef float f32x2 __attribute__((ext_vector_type(2)));
        const int row0 = u.row0 + wr * 64 + fr, col0 = u.pn * 128 + wc * 32 + 8 * fq;
        const f32x4 g0 = *(const LAS f32x4*)(lb + (wc * 32 + 8 * fq) * 4), g1 = *(const LAS f32x4*)(lb + (wc * 32 + 8 * fq + 4) * 4);
        const f32x4 u0 = *(const LAS f32x4*)(lb + 512 + (wc * 32 + 8 * fq) * 4), u1 = *(const LAS f32x4*)(lb + 512 + (wc * 32 + 8 * fq + 4) * 4);
        const f32x2 gb[4] = {{g0.x, g0.y}, {g0.z, g0.w}, {g1.x, g1.y}, {g1.z, g1.w}}, ub[4] = {{u0.x + 1.0f, u0.y + 1.0f}, {u0.z + 1.0f, u0.w + 1.0f}, {u1.x + 1.0f, u1.y + 1.0f}, {u1.z + 1.0f, u1.w + 1.0f}};
        unsigned pw0 = 0u, pw1 = 0u;
#pragma unroll
        for (int ai = 0; ai < 2; ++ai)
#pragma unroll
            for (int m = 0; m < 4; ++m) { f32x2 h[4];
#pragma unroll
                for (int p = 0; p < 4; ++p) {
                    const f32x4 ag = acc[ai][0][m][p >> 1], au = acc[ai][1][m][p >> 1];
                    f32x2 g = (p & 1) ? (f32x2){ag.z, ag.w} : (f32x2){ag.x, ag.y}, up1 = (p & 1) ? (f32x2){au.z, au.w} : (f32x2){au.x, au.y};
                    g = g * WSCALE_INV + gb[p]; up1 = up1 * WSCALE_INV + ub[p];
                    g.x = fminf(g.x, 7.0f); g.y = fminf(g.y, 7.0f);
                    up1.x = __builtin_amdgcn_fmed3f(up1.x, -6.0f, 8.0f); up1.y = __builtin_amdgcn_fmed3f(up1.y, -6.0f, 8.0f);
                    const f32x2 ea = g * (-1.702f * 1.44269504089f);
                    f32x2 t; t.x = __builtin_amdgcn_exp2f(ea.x); t.y = __builtin_amdgcn_exp2f(ea.y);
                    t = t + 1.0f;
                    f32x2 sg; sg.x = __builtin_amdgcn_rcpf(t.x); sg.y = __builtin_amdgcn_rcpf(t.y);
                    h[p] = (up1 * g) * sg; }
                const unsigned w0 = pk4_fp8(h[0].x, h[0].y, h[1].x, h[1].y), w1 = pk4_fp8(h[2].x, h[2].y, h[3].x, h[3].y);
                if ((m & 1) == 0) { pw0 = w0; pw1 = w1; }
                else { const auto r0 = __builtin_amdgcn_permlane16_swap(pw0, w0, false, false), r1 = __builtin_amdgcn_permlane16_swap(pw1, w1, false, false);
                    u32x4 wv; wv.x = r0[0]; wv.y = r1[0]; wv.z = r0[1]; wv.w = r1[1];
                    const unsigned long long ad = (unsigned long long)(H + (size_t)(row0 + ai * 128 + (m - 1 + (fq & 1)) * 16) * FF + col0 - 8 * (fq & 1));
                    asm volatile("global_store_dwordx4 %0, %1, off sc1\n\ts_nop 2" :: "v"(ad), "v"(wv) : "memory"); } }
    }
};
struct EpiDown {
    static constexpr bool PERM = true, LDS_BIAS = true;
    unsigned char* Y; const float* bd;
    __device__ __forceinline__ void stage_bias(const UnitM& u, LAS unsigned char* dst, int wid, int lane) const {
        if (wid < 4) { const float* src = bd + u.e * D + u.pn * 256 + wid * 64 + lane;
            __builtin_amdgcn_global_load_lds((const unsigned*)src, (LAS unsigned*)(dst + wid * 256), 4, 0, 0); }
    }
    __device__ __forceinline__ void operator()(const f32x4 (&acc)[2][2][4][2], const UnitM& u, int wr, int wc, int fr, int fq, const LAS unsigned char* lb) const {
        const int row0 = u.row0 + wr * 64 + fr, col0 = u.pn * 256 + wc * 32 + 8 * fq;
        f32x4 b8[2][2];
#pragma unroll
        for (int bj = 0; bj < 2; ++bj) { b8[bj][0] = *(const LAS f32x4*)(lb + (bj * 128 + wc * 32 + 8 * fq) * 4); b8[bj][1] = *(const LAS f32x4*)(lb + (bj * 128 + wc * 32 + 8 * fq + 4) * 4); }
        u32x2 pw[2];
#pragma unroll
        for (int ai = 0; ai < 2; ++ai)
#pragma unroll
            for (int m = 0; m < 4; ++m)
#pragma unroll
                for (int bj = 0; bj < 2; ++bj) { const f32x4 v0 = acc[ai][bj][m][0] * WSCALE_INV + b8[bj][0], v1 = acc[ai][bj][m][1] * WSCALE_INV + b8[bj][1];
                    u32x2 w; w.x = pk4_fp8(v0.x, v0.y, v0.z, v0.w); w.y = pk4_fp8(v1.x, v1.y, v1.z, v1.w);
                    if ((m & 1) == 0) pw[bj] = w;
                    else { const auto r0 = __builtin_amdgcn_permlane16_swap(pw[bj].x, w.x, false, false), r1 = __builtin_amdgcn_permlane16_swap(pw[bj].y, w.y, false, false);
                        u32x4 wv; wv.x = r0[0]; wv.y = r1[0]; wv.z = r0[1]; wv.w = r1[1];
                        *(u32x4*)(Y + (size_t)(row0 + ai * 128 + (m - 1 + (fq & 1)) * 16) * D + col0 - 8 * (fq & 1) + bj * 128) = wv; } }
    }
};

struct Args { const float* in[24]; float* out; unsigned char* ws; int ph_lo, ph_hi, li, pad; };
struct Frame {
    LAS unsigned char* lds; unsigned char* ws; unsigned* ctl;
    int tid, lane, wave, G, bid;
};

struct TItem { const float* src; unsigned char* dst; int ldw, k0, n0, drow0; };
template <int NL> __device__ __forceinline__ void titem_load(const TItem& t, float (&tv)[NL], int lane) {
    const float* wp = t.src + (size_t)(t.k0 + (lane >> 5)) * t.ldw + t.n0 + (lane & 31);
#pragma unroll
    for (int i = 0; i < NL; ++i) tv[i] = wp[(size_t)(2 * i) * t.ldw];
}
__device__ __forceinline__ void titem_finish_bf16(const TItem& t, const float (&tv)[32], LAS float* scr, int lane) {
#pragma unroll
    for (int i = 0; i < 32; ++i) scr[(2 * i + (lane >> 5)) * 33 + (lane & 31)] = tv[i];
    LDS_WAIT(); asm volatile("" ::: "memory");
    const int c = lane & 7;
#pragma unroll
    for (int j = 0; j < 4; ++j) { const int n = (lane >> 3) + 8 * j; const LAS float* s = scr + (8 * c) * 33 + n;
        u32x4 o; o.x = cvt_pk_bf16(s[0 * 33], s[1 * 33]); o.y = cvt_pk_bf16(s[2 * 33], s[3 * 33]); o.z = cvt_pk_bf16(s[4 * 33], s[5 * 33]); o.w = cvt_pk_bf16(s[6 * 33], s[7 * 33]);
        *(u32x4*)(t.dst + ((size_t)(t.drow0 + n) * 1024 + t.k0 + 8 * c) * 2) = o; }
    LDS_WAIT(); asm volatile("" ::: "memory");
}
__device__ __forceinline__ void titem_load_fp8(const TItem& t, f32x4 (&tv)[16], int lane) {
    const float* wp = t.src + (size_t)(t.k0 + (lane >> 3)) * t.ldw + t.n0 + 4 * (lane & 7);
#pragma unroll
    for (int i = 0; i < 16; ++i) tv[i] = __builtin_nontemporal_load((const f32x4*)(wp + (size_t)(8 * i) * t.ldw));
}
__device__ __forceinline__ void titem_finish_fp8(const TItem& t, const f32x4 (&tv)[16], LAS float* scr, int lane) {
#pragma unroll
    for (int i = 0; i < 16; ++i) { const int row = 8 * i + (lane >> 3); *(LAS f32x4*)(scr + row * 32 + ((4 * (lane & 7)) ^ ((8 * (row >> 4)) & 31))) = tv[i] * WSCALE; }
    LDS_WAIT(); asm volatile("" ::: "memory");
    const int c = lane & 7;
#pragma unroll
    for (int j = 0; j < 4; ++j) { const int n = (lane >> 3) + 8 * j; const LAS float* s = scr + (16 * c) * 32 + (n ^ ((8 * c) & 31));
        u32x4 o; o.x = pk4_fp8(s[0 * 32], s[1 * 32], s[2 * 32], s[3 * 32]); o.y = pk4_fp8(s[4 * 32], s[5 * 32], s[6 * 32], s[7 * 32]);
        o.z = pk4_fp8(s[8 * 32], s[9 * 32], s[10 * 32], s[11 * 32]); o.w = pk4_fp8(s[12 * 32], s[13 * 32], s[14 * 32], s[15 * 32]);
        __builtin_nontemporal_store(o, (u32x4*)(t.dst + (size_t)(t.drow0 >> 5) * 32768 + (size_t)(t.k0 >> 7) * 4096 + n * 128 + 16 * c)); }
    LDS_WAIT(); asm volatile("" ::: "memory");
}
constexpr int TI_IN = 16 * 96, TI_OUT = 8 * 32, TI_E = 8 * 32, TI_EALL = NE * 3 * TI_E;
constexpr int TSCR = 16384;
__device__ __forceinline__ void transpose_items_bf16(const Frame& F, const Args& a, int gw, int NGW, int it0, int it1) {
    const float* w_in = a.in[10]; const float* w_out = a.in[11];
    LAS float* scr = (LAS float*)(F.lds + F.wave * TSCR);
    for (int it = it0 + gw; it < it1; it += NGW) {
        TItem t; float tv[32];
        if (it < TI_IN) { const int kb = it / 96, nb = it % 96; t = TItem{w_in, F.ws + WS_WIN, NIN, kb * 64, nb * 32, nb * 32}; }
        else { const int r = it - TI_IN, kb = r / 32, nb = r % 32; t = TItem{w_out, F.ws + WS_WOUT, 1024, kb * 64, nb * 32, nb * 32}; }
        titem_load<32>(t, tv, F.lane); titem_finish_bf16(t, tv, scr, F.lane);
    }
}
__device__ __forceinline__ void transpose_items_fp8(const Frame& F, const Args& a, int gw, int NGW, int k0, int k1) {
    const float* w_gate = a.in[18]; const float* w_up = a.in[20]; const float* w_down = a.in[22];
    unsigned char* WGU = F.ws + WS_WGU; unsigned char* WDN = F.ws + WS_WDN;
    LAS float* scr = (LAS float*)(F.lds + F.wave * TSCR);
    auto decode = [&](int r, TItem& t) {
        const int e = r / (3 * TI_E), r2 = r % (3 * TI_E), mat = r2 / TI_E, r3 = r2 % TI_E, kb = r3 / 32, nb = r3 % 32, n0 = nb * 32;
        if (mat == 2) t = TItem{w_down + (size_t)e * 1048576, WDN + (size_t)e * 1048576, 1024, kb * 128, n0, n0};
        else t = TItem{(mat == 0 ? w_gate : w_up) + (size_t)e * 1048576, WGU + (size_t)e * 2097152, 1024, kb * 128, n0, 256 * (n0 >> 7) + mat * 128 + (n0 & 127)};
    };
    for (int k = k0; k < k1; ++k) { const int it = gw + k * NGW; if (it >= TI_EALL) break;
        TItem t; f32x4 tv[16]; decode(it, t); titem_load_fp8(t, tv, F.lane); titem_finish_fp8(t, tv, scr, F.lane); }
}
__device__ __forceinline__ void p0_prologue(const Frame& F, const Args& a) {
    const float* c = a.in[1]; const float* c_ctx = a.in[3]; const float* w_ada = a.in[4]; const float* b_ada = a.in[5];
    const float* w_out = a.in[11]; const float* pool_w = a.in[14]; const float* pool_scale = a.in[15];
    bf16_t* WOUT = (bf16_t*)(F.ws + WS_WOUT);
    float* mod = (float*)(F.ws + WS_MOD);
    if (F.bid < 192) {
        LAS float* s = (LAS float*)F.lds;
        LAS float* red = (LAS float*)(F.lds + 20480);
        const int kq = F.tid >> 5, col = F.tid & 31, j = F.bid * 32 + col;
        float w[64];
#pragma unroll
        for (int kk = 0; kk < 64; ++kk) w[kk] = __builtin_nontemporal_load(w_ada + (size_t)(kq * 64 + kk) * 6144 + j);
        { float t[10];
#pragma unroll
          for (int q = 0; q < 10; ++q) { const int i = F.tid + q * 512, r = i >> 10, k = i & 1023; t[q] = (r < 4) ? c[r * 1024 + k] : c_ctx[k]; }
#pragma unroll
          for (int q = 0; q < 10; ++q) s[F.tid + q * 512] = t[q] * sigmoidf_(t[q]); }
        __syncthreads();
        float acc[5] = {0.f, 0.f, 0.f, 0.f, 0.f};
#pragma unroll
        for (int kk = 0; kk < 64; ++kk) { const int k = kq * 64 + kk;
#pragma unroll
            for (int r = 0; r < 5; ++r) acc[r] += s[r * 1024 + k] * w[kk]; }
#pragma unroll
        for (int r = 0; r < 5; ++r) red[(kq * 5 + r) * 32 + col] = acc[r];
        __syncthreads();
        if (F.tid < 160) { const int r = F.tid >> 5, cc = F.tid & 31; float t = b_ada[F.bid * 32 + cc];
#pragma unroll
            for (int q = 0; q < 16; ++q) t += red[(q * 5 + r) * 32 + cc];
            mod[r * 6144 + F.bid * 32 + cc] = t; }
        asm volatile("s_waitcnt vmcnt(0)" ::: "memory");
        __syncthreads();
        if (F.tid == 0) { __builtin_amdgcn_fence(__ATOMIC_RELEASE, "agent"); asm volatile("s_waitcnt vmcnt(0)" ::: "memory");
            __hip_atomic_fetch_add(F.ctl + CW_MOD, 1u, __ATOMIC_RELAXED, __HIP_MEMORY_SCOPE_AGENT); }
    }
    __syncthreads();
    transpose_items_bf16(F, a, F.bid * 8 + F.wave, F.G * 8, 0, TI_IN);
}
__device__ __forceinline__ void p0_late(const Frame& F, const Args& a) {
    const float* w_out = a.in[11]; const float* pool_w = a.in[14]; const float* pool_scale = a.in[15];
    bf16_t* WOUT = (bf16_t*)(F.ws + WS_WOUT);
    if (F.bid >= 128 && F.bid < 256) {
        const int un = F.bid - 128, gi = un >> 5, nb = un & 31;
        LAS float* pw = (LAS float*)F.lds;
        LAS float* wo = (LAS float*)(F.lds + 128 * 129 * 4);
        { float t[32]; const float sc = pool_scale[gi * 128 + (F.tid & 127)];
#pragma unroll
          for (int q = 0; q < 32; ++q) t[q] = pool_w[(size_t)gi * 16384 + F.tid + q * 512];
#pragma unroll
          for (int q = 0; q < 32; ++q) { const int i = F.tid + q * 512; pw[(i >> 7) * 129 + (i & 127)] = t[q] * sc; }
          float u[8];
#pragma unroll
          for (int q = 0; q < 8; ++q) { const int i = F.tid + q * 512; u[q] = w_out[(size_t)(512 + gi * 128 + (i >> 5)) * 1024 + nb * 32 + (i & 31)]; }
#pragma unroll
          for (int q = 0; q < 8; ++q) wo[F.tid + q * 512] = u[q]; }
        __syncthreads();
        const int n = F.tid & 31, cq = F.tid >> 5;
        float acc[8] = {0.f, 0.f, 0.f, 0.f, 0.f, 0.f, 0.f, 0.f};
        for (int j = 0; j < 128; ++j) { const float b = wo[j * 32 + n];
#pragma unroll
            for (int i = 0; i < 8; ++i) acc[i] += pw[(cq * 8 + i) * 129 + j] * b; }
        u32x4 o; o.x = cvt_pk_bf16(acc[0], acc[1]); o.y = cvt_pk_bf16(acc[2], acc[3]); o.z = cvt_pk_bf16(acc[4], acc[5]); o.w = cvt_pk_bf16(acc[6], acc[7]);
        *(u32x4*)(WOUT + (size_t)(nb * 32 + n) * 1024 + 512 + gi * 128 + cq * 8) = o;
        __syncthreads();
    }
    if (F.bid >= 32 && F.bid < 40) {
        const float* w_router = a.in[16]; bf16_t* WRH = (bf16_t*)(F.ws + WS_WRH); bf16_t* WRL = (bf16_t*)(F.ws + WS_WRL);
        for (int i = (F.bid - 32) * 512 + F.tid; i < 32768; i += 8 * 512) { const int k = i >> 5, e = i & 31; const float w = w_router[i];
            const unsigned short hi = f2bf(w); WRH[e * 1024 + k] = hi; WRL[e * 1024 + k] = f2bf(w - bf2f(hi)); }
    }
    __syncthreads();
    transpose_items_bf16(F, a, F.bid * 8 + F.wave, F.G * 8, TI_IN, TI_IN + TI_OUT);
    __syncthreads();
}

__device__ __forceinline__ void p1_normmod(const Frame& F, const Args& a, unsigned need) {
    const float* x = a.in[0]; const float* ctx = a.in[2]; const float* g = a.in[6];
    const float* mod = (const float*)(F.ws + WS_MOD); bf16_t* HX = (bf16_t*)(F.ws + WS_HX);
    const int gw = F.bid * 8 + F.wave;
    auto rowp = [&](int m) { return (m < M) ? x + (size_t)m * D : ctx + (size_t)(m - M) * D; };
    const int NGW = F.G * 8;
    int m0 = gw * 8;
    f32x4 v[4];
    { const float* xr = rowp(m0);
#pragma unroll
      for (int j = 0; j < 4; ++j) v[j] = __builtin_nontemporal_load((const f32x4*)(xr + F.lane * 4 + 256 * j)); }
    if (F.tid == 0) { unsigned sp = 0;
        while (__hip_atomic_load(F.ctl + CW_MOD, __ATOMIC_RELAXED, __HIP_MEMORY_SCOPE_AGENT) < need) { __builtin_amdgcn_s_sleep(2); if (++sp > (1u << 22)) break; }
        __builtin_amdgcn_fence(__ATOMIC_ACQUIRE, "agent"); asm volatile("s_waitcnt vmcnt(0)" ::: "memory"); }
    __syncthreads();
    f32x4 ga[4], hb[4];
    auto ld_par = [&](int mr) { const float* sh = mod + mr * 6144, *sc = sh + 1024;
#pragma unroll
        for (int j = 0; j < 4; ++j) { const int col = F.lane * 4 + 256 * j; ga[j] = *(const f32x4*)(g + col) * (1.0f + *(const f32x4*)(sc + col)); hb[j] = *(const f32x4*)(sh + col); } };
    auto do_row = [&](int m) {
        float s = 0.f;
#pragma unroll
        for (int j = 0; j < 4; ++j) s += (v[j].x * v[j].x + v[j].y * v[j].y) + (v[j].z * v[j].z + v[j].w * v[j].w);
        const float rstd = rsqrtf(wave_sum(s) * (1.f / D) + EPS);
#pragma unroll
        for (int j = 0; j < 4; ++j) { const int col = F.lane * 4 + 256 * j;
            const f32x4 o = v[j] * rstd * ga[j] + hb[j];
            u32x2 w; w.x = cvt_pk_bf16(o.x, o.y); w.y = cvt_pk_bf16(o.z, o.w);
            *(u32x2*)(HX + (size_t)m * D + col) = w; } };
    const bool hasctx = gw < MC;
#pragma unroll 1
    for (; m0 < M; m0 += NGW * 8) {
        const bool lastg = m0 + NGW * 8 >= M;
        ld_par(m0 >> 12);
#pragma unroll 1
        for (int k = 0; k < 8; ++k) {
            const int m = m0 + k, mn = (k < 7) ? m + 1 : (lastg ? (hasctx ? M + gw : m) : m0 + NGW * 8);
            f32x4 vn[4];
            { const float* xr = rowp(mn);
#pragma unroll
              for (int j = 0; j < 4; ++j) vn[j] = __builtin_nontemporal_load((const f32x4*)(xr + F.lane * 4 + 256 * j)); }
            do_row(m);
#pragma unroll
            for (int j = 0; j < 4; ++j) v[j] = vn[j];
        }
    }
    for (int c = gw; c < MC; c += NGW) {
        if (c != gw) { const float* xr = rowp(M + c);
#pragma unroll
            for (int j = 0; j < 4; ++j) v[j] = __builtin_nontemporal_load((const f32x4*)(xr + F.lane * 4 + 256 * j)); }
        ld_par(4); do_row(M + c); }
}

constexpr int G_LF = 0, G_QR = 17408, G_V = 34816, G_Q2 = 52224, G_K2 = 69632, G_ATT = 87040, G_ST = 96256, G_RED = LDS_TAB;
static_assert(G_ST + 128 * 272 <= RING_BYTES, "GLA LDS map");
typedef short s16x4 __attribute__((ext_vector_type(4)));
__device__ __forceinline__ f32x16 mfma32(bf16x8 a, bf16x8 b, f32x16 c) { return __builtin_amdgcn_mfma_f32_32x32x16_bf16(a, b, c, 0, 0, 0); }
__device__ __forceinline__ constexpr int crow0(int reg) { return (reg & 3) + 8 * (reg >> 2); }
__device__ __forceinline__ int opq(int x) { asm volatile("" : "+v"(x)); return x; }
__device__ __forceinline__ unsigned opqu(unsigned x) { asm volatile("" : "+v"(x)); return x; }
__device__ __forceinline__ bf16x8 tr_frag(const LAS unsigned char* img, int trb, int ks, int c) {
    const LAS s16x4* p = (const LAS s16x4*)(img + trb + ks * 16 * 272 + c * 64);
    const s16x4 lo = __builtin_amdgcn_ds_read_tr16_b64_v4i16((LAS s16x4*)p), hi = __builtin_amdgcn_ds_read_tr16_b64_v4i16((LAS s16x4*)(p + 4 * 272 / 8));
    return __builtin_shufflevector(lo, hi, 0, 1, 2, 3, 4, 5, 6, 7);
}
template <int MODE> __device__ __forceinline__ bf16x8 cfrag(int d) {
    u32x4 w;
#pragma unroll
    for (int i = 0; i < 4; ++i) {
        const bool lo = MODE == 0 ? (2 * i <= d) : MODE == 1 ? (2 * i >= d) : MODE == 2 ? (2 * i == d) : true;
        const bool hi = MODE == 0 ? (2 * i + 1 <= d) : MODE == 1 ? (2 * i + 1 >= d) : MODE == 2 ? (2 * i + 1 == d) : true;
        w[i] = (lo ? 0x3F80u : 0u) | (hi ? 0x3F800000u : 0u);
    }
    return __builtin_bit_cast(bf16x8, w);
}
struct RawRegs { u32x4 lf[2], v[2], q[2]; };
template <int DIR, bool WITH_Q>
__device__ __forceinline__ void gla_load_raw(const Frame& F, const bf16_t* P, int row0, int head, RawRegs& R) {
    const bf16_t* rp = P + (size_t)(row0 + (F.tid >> 3)) * NIN + head * 128 + (F.tid & 7) * 16;
    R.lf[0] = *(const u32x4*)(rp + 512 + DIR * 512); R.lf[1] = *(const u32x4*)(rp + 512 + DIR * 512 + 8);
    R.v[0] = *(const u32x4*)(rp + 1536); R.v[1] = *(const u32x4*)(rp + 1536 + 8);
    if (WITH_Q) { R.q[0] = *(const u32x4*)rp; R.q[1] = *(const u32x4*)(rp + 8); }
}
template <bool WITH_Q>
__device__ __forceinline__ void gla_store_raw(const Frame& F, const RawRegs& R) {
    const int o = (F.tid >> 3) * 272 + (F.tid & 7) * 32;
    *(LAS u32x4*)(F.lds + G_LF + o) = R.lf[0]; *(LAS u32x4*)(F.lds + G_LF + o + 16) = R.lf[1];
    *(LAS u32x4*)(F.lds + G_V + o) = R.v[0]; *(LAS u32x4*)(F.lds + G_V + o + 16) = R.v[1];
    if (WITH_Q) { *(LAS u32x4*)(F.lds + G_QR + o) = R.q[0]; *(LAS u32x4*)(F.lds + G_QR + o + 16) = R.q[1]; }
}
template <int DIR, bool WITH_Q>
__device__ __forceinline__ void gla_stage1(const Frame& F, int trb, float (&eh)[16], float* tsum) {
    const int cb = F.wave >> 1, tb = F.wave & 1, l31 = F.lane & 31, lh = F.lane >> 5;
    f32x16 b, T;
#pragma unroll
    for (int r = 0; r < 16; ++r) { b[r] = 0.f; T[r] = 0.f; }
    const u32x4 ones4 = {0x3F803F80u, 0x3F803F80u, 0x3F803F80u, 0x3F803F80u};
#pragma unroll
    for (int ks = 0; ks < 4; ++ks) {
        const int dd = 32 * tb + l31 - 16 * ks - 8 * lh;
        const bf16x8 alf = tr_frag(F.lds + G_LF, trb, ks, cb);
        T = mfma32(alf, __builtin_bit_cast(bf16x8, ones4), T);
        if (DIR ? (tb == 0 || ks >= 2) : (tb == 1 || ks < 2)) b = mfma32(alf, cfrag<DIR>(dd), b);
    }
    const int wb = opq((32 * tb + l31) * 272 + (32 * cb + 4 * lh) * 2);
    typedef float f32x2 __attribute__((ext_vector_type(2)));
    u32x2 lfw[4], qw[4];
#pragma unroll
    for (int g = 0; g < 4; ++g) { lfw[g] = *(const LAS u32x2*)(F.lds + G_LF + wb + g * 16); if (WITH_Q) qw[g] = *(const LAS u32x2*)(F.lds + G_QR + wb + g * 16); }
#pragma unroll
    for (int g = 0; g < 4; ++g) {
        f32x2 k2[2], q2[2];
#pragma unroll
        for (int h = 0; h < 2; ++h) {
            const int r = 4 * g + 2 * h;
            const unsigned lw = h ? lfw[g].y : lfw[g].x;
            const f32x2 lf = {bflo(lw), bfhi(lw)}, Tv = {T[r], T[r + 1]}, bv = {b[r], b[r + 1]};
            const f32x2 mm = Tv * 0.5f, d = mm - bv;
            eh[r] = __builtin_amdgcn_exp2f(mm.x); eh[r + 1] = __builtin_amdgcn_exp2f(mm.y);
            if (tsum) { tsum[r] += Tv.x; tsum[r + 1] += Tv.y; }
            f32x2 ef, ek; ef.x = __builtin_amdgcn_exp2f(lf.x); ef.y = __builtin_amdgcn_exp2f(lf.y); ek.x = __builtin_amdgcn_exp2f(d.x); ek.y = __builtin_amdgcn_exp2f(d.y);
            k2[h] = (1.0f - ef) * ek;
            q2[h] = (f32x2){0.f, 0.f};
            if (WITH_Q) { const unsigned qq = h ? qw[g].y : qw[g].x; const f32x2 q = {bflo(qq), bfhi(qq)}, nd = bv - mm;
                f32x2 eq; eq.x = __builtin_amdgcn_exp2f(nd.x); eq.y = __builtin_amdgcn_exp2f(nd.y); q2[h] = q * eq; }
        }
        u32x2 w; w.x = cvt_pk_bf16(k2[0].x, k2[0].y); w.y = cvt_pk_bf16(k2[1].x, k2[1].y);
        *(LAS u32x2*)(F.lds + G_K2 + wb + g * 16) = w;
        if (WITH_Q) { w.x = cvt_pk_bf16(q2[0].x, q2[0].y); w.y = cvt_pk_bf16(q2[1].x, q2[1].y); *(LAS u32x2*)(F.lds + G_Q2 + wb + g * 16) = w; }
    }
}
__device__ __forceinline__ void gla_state_mma(const Frame& F, int trb, f32x16& s0, f32x16& s1) {
    const int kb = F.wave >> 1, vb = (F.wave & 1) * 2;
#pragma unroll
    for (int ks = 0; ks < 4; ++ks) {
        const bf16x8 a = tr_frag(F.lds + G_K2, trb, ks, kb);
        const bf16x8 b0 = tr_frag(F.lds + G_V, trb, ks, vb), b1 = tr_frag(F.lds + G_V, trb, ks, vb + 1);
        s0 = mfma32(a, b0, s0); s1 = mfma32(a, b1, s1);
    }
}

template <int DIR>
__device__ __forceinline__ void gla_passA_unit(const Frame& F, const bf16_t* P, int b, int h, int blk, bf16_t* dS, float* DD) {
    const int xb = DIR ? (16 - blk) : (blk - 1);
    const int rowb = (blk == 0) ? (M + b * CTXL) : (b * SEQ + xb * 256);
    const int l31 = F.lane & 31, lh = F.lane >> 5;
    const int trb = (8 * lh + ((F.lane & 15) >> 2)) * 272 + (16 * ((F.lane >> 4) & 1) + 4 * (F.lane & 3)) * 2;
    f32x16 s0, s1;
#pragma unroll
    for (int r = 0; r < 16; ++r) { s0[r] = 0.f; s1[r] = 0.f; }
    float tsum[16], eh[16];
#pragma unroll
    for (int i = 0; i < 16; ++i) tsum[i] = 0.f;
    RawRegs R;
    gla_load_raw<DIR, false>(F, P, rowb + (DIR ? 3 : 0) * 64, h, R);
#pragma unroll 1
    for (int ci = 0; ci < 4; ++ci) {
        LSYNC();
        gla_store_raw<false>(F, R);
        if (ci < 3) gla_load_raw<DIR, false>(F, P, rowb + (DIR ? (2 - ci) : (ci + 1)) * 64, h, R);
        LSYNC();
        gla_stage1<DIR, false>(F, trb, eh, tsum);
        LSYNC();
#pragma unroll
        for (int r = 0; r < 16; ++r) { s0[r] *= eh[r]; s1[r] *= eh[r]; }
        gla_state_mma(F, trb, s0, s1);
#pragma unroll
        for (int r = 0; r < 16; ++r) { s0[r] *= eh[r]; s1[r] *= eh[r]; }
    }
    const int kb = F.wave >> 1, vb = (F.wave & 1) * 2;
    const unsigned sb = opqu((unsigned)((32 * kb + 4 * lh) * 128 + 32 * vb + l31));
#pragma unroll
    for (int r = 0; r < 16; ++r) { dS[sb + crow0(r) * 128] = f2bf(s0[r]); dS[sb + 32 + crow0(r) * 128] = f2bf(s1[r]); }
    if ((F.wave & 1) == 0 && l31 == 0) {
#pragma unroll
        for (int r = 0; r < 16; ++r) DD[32 * kb + 4 * lh + crow0(r)] = __builtin_amdgcn_exp2f(tsum[r]);
    }
}

template <int W, class Get, class Emit> __device__ __forceinline__ void win_mean64(const Get& get, const Emit& emit) {
    float s = 0.f;
#pragma unroll
    for (int q = 0; q < W - W / 2; ++q) s += get(q);
#pragma unroll
    for (int r = 0; r < 64; ++r) {
        const int lo = (r - W / 2) < 0 ? 0 : (r - W / 2), hi = (r - W / 2 + W) > 64 ? 64 : (r - W / 2 + W);
        emit(r, s * (1.0f / (float)(hi - lo)));
        if (r + 1 < 64) { if (r + 1 - W / 2 + W <= 64) s += get(r - W / 2 + W); if (r + 1 - W / 2 > 0) s -= get(r - W / 2); }
    }
}
template <int W>
__device__ __forceinline__ void pool_unit(const Frame& F, const bf16_t* __restrict__ U, bf16_t* __restrict__ A2, int b, int slab) {
    LAS float* vm = (LAS float*)F.lds;
    const int ch = F.tid & 7, cc = F.tid >> 3;
    const bf16_t* Us = U + (size_t)(b * 64 + slab) * 4096 * 8;
    {
        unsigned short v[64];
        const unsigned pb = opqu((unsigned)(cc * 8 + ch));
#pragma unroll
        for (int r = 0; r < 64; ++r) v[r] = Us[pb + (unsigned)(r * 64 * 8)];
        const int vb = opq((cc * 8 + ch) * 4);
        win_mean64<W>([&](int q) { return bf2f(v[q]); }, [&](int r, float mean) { *(LAS float*)(F.lds + vb + r * 2080) = mean; });
    }
    __syncthreads();
    {
        const int rr = F.tid >> 3;
        unsigned short uu[64];
        const unsigned pb = opqu((unsigned)(rr * 64 * 8 + ch));
#pragma unroll
        for (int c = 0; c < 64; ++c) uu[c] = Us[pb + (unsigned)(c * 8)];
        const int vb = opq((rr * 520 + ch) * 4);
        const unsigned ab = opqu((unsigned)((b * SEQ + rr * 64) * D + 512 + slab * 8 + ch));
        win_mean64<W>([&](int q) { return *(const LAS float*)(F.lds + vb + q * 32); },
                      [&](int c, float mean) { A2[ab + (unsigned)(c * D)] = f2bf(mean - bf2f(uu[c])); });
    }
    __syncthreads();
}

__device__ __forceinline__ void p4_scan(const Frame& F) {
    bf16_t* ST = (bf16_t*)(F.ws + WS_ST); const float* DDp = (const float*)(F.ws + WS_DD);
    const int gt = F.bid * 512 + F.tid, NT = F.G * 512;
    for (int i = gt; i < 32 * 4096; i += NT) {
        const int seq = i >> 12, e4 = i & 4095, k = e4 >> 5;
        float S[4];
#pragma unroll
        for (int j = 0; j < 4; ++j) S[j] = 0.f;
        u32x2 d[NBLK]; float dec[NBLK];
#pragma unroll
        for (int blk = 0; blk < NBLK; ++blk) { d[blk] = *(const u32x2*)(ST + ((size_t)(seq * NBLK + blk) * 16384) + e4 * 4); dec[blk] = DDp[(seq * NBLK + blk) * 128 + k]; }
#pragma unroll
        for (int blk = 0; blk < NBLK; ++blk) {
            u32x2 o; o.x = cvt_pk_bf16(S[0], S[1]); o.y = cvt_pk_bf16(S[2], S[3]);
            *(u32x2*)(ST + ((size_t)(seq * NBLK + blk) * 16384) + e4 * 4) = o;
            S[0] = S[0] * dec[blk] + bflo(d[blk].x); S[1] = S[1] * dec[blk] + bfhi(d[blk].x); S[2] = S[2] * dec[blk] + bflo(d[blk].y); S[3] = S[3] * dec[blk] + bfhi(d[blk].y);
        }
    }
}

__device__ __forceinline__ float row16_sum(float x) {
    int v;
    v = __builtin_amdgcn_mov_dpp(__float_as_int(x), 0x128, 0xf, 0xf, false); x += __int_as_float(v);
    v = __builtin_amdgcn_mov_dpp(__float_as_int(x), 0x124, 0xf, 0xf, false); x += __int_as_float(v);
    v = __builtin_amdgcn_mov_dpp(__float_as_int(x), 0x122, 0xf, 0xf, false); x += __int_as_float(v);
    v = __builtin_amdgcn_mov_dpp(__float_as_int(x), 0x121, 0xf, 0xf, false); x += __int_as_float(v);
    return x;
}
template <int DIR>
__device__ __forceinline__ void gla_passC_dir(const Frame& F, const bf16_t* P, int b, int h, int xb, const bf16_t* ST, bf16_t* OF, bf16_t* A2, const float* gain) {
    const int blk = DIR ? (16 - xb) : (xb + 1);
    const int seq = b * 8 + h * 2 + DIR;
    const bf16_t* S0 = ST + (size_t)(seq * NBLK + blk) * 16384;
    const int kb = F.wave >> 1, vb = (F.wave & 1) * 2, l31 = F.lane & 31, lh = F.lane >> 5;
    const int trb = (8 * lh + ((F.lane & 15) >> 2)) * 272 + (16 * ((F.lane >> 4) & 1) + 4 * (F.lane & 3)) * 2;
    f32x16 s0, s1;
    const unsigned sb = opqu((unsigned)((32 * kb + 4 * lh) * 128 + 32 * vb + l31));
#pragma unroll
    for (int r = 0; r < 16; ++r) { s0[r] = bf2f(S0[sb + crow0(r) * 128]); s1[r] = bf2f(S0[sb + 32 + crow0(r) * 128]); }
    const int rowb = b * SEQ + xb * 256;
    const int omt = F.wave >> 2, ont = F.wave & 3;
    LAS float* red = (LAS float*)(F.lds + G_RED);
    RawRegs R;
    gla_load_raw<DIR, true>(F, P, rowb + (DIR ? 3 : 0) * 64, h, R);
#pragma unroll 1
    for (int ci = 0; ci < 4; ++ci) {
        const int c = DIR ? (3 - ci) : ci;
        float eh[16];
        LSYNC();
        gla_store_raw<true>(F, R);
        if (ci < 3) gla_load_raw<DIR, true>(F, P, rowb + (DIR ? (2 - ci) : (ci + 1)) * 64, h, R);
        f32x16 o;
        const unsigned trow = (unsigned)(rowb + c * 64 + 32 * omt + l31);
        const unsigned ob = opqu(trow * 512u + (unsigned)(h * 128 + 32 * ont + 4 * lh));
        u32x2 gg[4];
        if (DIR) {
            const unsigned pb = opqu(trow * (unsigned)NIN + (unsigned)(2048 + h * 128 + 32 * ont + 4 * lh));
#pragma unroll
            for (int g = 0; g < 4; ++g) { const u32x2 t4 = *(const u32x2*)(OF + ob + g * 8); o[4 * g] = bflo(t4.x); o[4 * g + 1] = bfhi(t4.x); o[4 * g + 2] = bflo(t4.y); o[4 * g + 3] = bfhi(t4.y); gg[g] = *(const u32x2*)(P + pb + g * 8); }
        } else {
#pragma unroll
            for (int r = 0; r < 16; ++r) o[r] = 0.f;
        }
        LSYNC();
        gla_stage1<DIR, true>(F, trb, eh, nullptr);
        LSYNC();
#pragma unroll
        for (int r = 0; r < 16; ++r) { s0[r] *= eh[r]; s1[r] *= eh[r]; }
        {
            const int stb = opq(G_ST + (32 * vb + l31) * 272 + (32 * kb + 4 * lh) * 2);
#pragma unroll
            for (int g = 0; g < 4; ++g) {
                u32x2 w; w.x = cvt_pk_bf16(s0[4 * g], s0[4 * g + 1]); w.y = cvt_pk_bf16(s0[4 * g + 2], s0[4 * g + 3]);
                *(LAS u32x2*)(F.lds + stb + g * 16) = w;
                w.x = cvt_pk_bf16(s1[4 * g], s1[4 * g + 1]); w.y = cvt_pk_bf16(s1[4 * g + 2], s1[4 * g + 3]);
                *(LAS u32x2*)(F.lds + stb + 32 * 272 + g * 16) = w;
            }
        }
        if (F.wave < 4) {
            const int asb = F.wave >> 1, atb = F.wave & 1;
            f32x16 at, at2;
#pragma unroll
            for (int r = 0; r < 16; ++r) { at[r] = 0.f; at2[r] = 0.f; }
            const int ka = opq(G_K2 + (32 * asb + l31) * 272 + 16 * lh), qa = opq(G_Q2 + (32 * atb + l31) * 272 + 16 * lh);
#pragma unroll
            for (int ks = 0; ks < 8; ks += 2) {
                const bf16x8 a = *(const LAS bf16x8*)(F.lds + ka + ks * 32), a2 = *(const LAS bf16x8*)(F.lds + ka + ks * 32 + 32);
                const bf16x8 bb = *(const LAS bf16x8*)(F.lds + qa + ks * 32), bb2 = *(const LAS bf16x8*)(F.lds + qa + ks * 32 + 32);
                at = mfma32(a, bb, at); at2 = mfma32(a2, bb2, at2);
            }
#pragma unroll
            for (int r = 0; r < 16; ++r) at[r] += at2[r];
            const int dts = opq((32 * atb + l31) - (32 * asb + 4 * lh));
            float am[16];
#pragma unroll
            for (int r = 0; r < 16; ++r) { const bool keep = DIR ? (crow0(r) >= dts) : (crow0(r) <= dts); am[r] = keep ? at[r] : 0.f; }
            const int ab = opq(G_ATT + (32 * atb + l31) * 144 + (32 * asb + 4 * lh) * 2);
#pragma unroll
            for (int g = 0; g < 4; ++g) { u32x2 w; w.x = cvt_pk_bf16(am[4 * g], am[4 * g + 1]); w.y = cvt_pk_bf16(am[4 * g + 2], am[4 * g + 3]); *(LAS u32x2*)(F.lds + ab + g * 16) = w; }
        }
        LSYNC();
        {
            const int qa = opq(G_Q2 + (32 * omt + l31) * 272 + 16 * lh), sa = opq(G_ST + (32 * ont + l31) * 272 + 16 * lh), aa = opq(G_ATT + (32 * omt + l31) * 144 + 16 * lh);
            f32x16 o2;
#pragma unroll
            for (int r = 0; r < 16; ++r) o2[r] = 0.f;
#pragma unroll
            for (int ks = 0; ks < 8; ++ks) {
                const bf16x8 a = *(const LAS bf16x8*)(F.lds + sa + ks * 32);
                const bf16x8 bb = *(const LAS bf16x8*)(F.lds + qa + ks * 32);
                if (ks & 1) o2 = mfma32(a, bb, o2); else o = mfma32(a, bb, o);
            }
#pragma unroll
            for (int ks = 0; ks < 4; ++ks) {
                const bf16x8 a = tr_frag(F.lds + G_V, trb, ks, ont);
                const bf16x8 bb = *(const LAS bf16x8*)(F.lds + aa + ks * 32);
                if (ks & 1) o2 = mfma32(a, bb, o2); else o = mfma32(a, bb, o);
            }
#pragma unroll
            for (int r = 0; r < 16; ++r) o[r] += o2[r];
        }
        gla_state_mma(F, trb, s0, s1);
#pragma unroll
        for (int r = 0; r < 16; ++r) { s0[r] *= eh[r]; s1[r] *= eh[r]; }
        if (DIR == 0) {
#pragma unroll
            for (int g = 0; g < 4; ++g) { u32x2 w; w.x = cvt_pk_bf16(o[4 * g], o[4 * g + 1]); w.y = cvt_pk_bf16(o[4 * g + 2], o[4 * g + 3]); *(u32x2*)(OF + ob + g * 8) = w; }
        } else {
            float sq = 0.f;
#pragma unroll
            for (int r = 0; r < 16; ++r) sq += o[r] * o[r];
            sq += __shfl_xor(sq, 32);
            if (lh == 0) red[(32 * omt + l31) * 4 + ont] = sq;
            LSYNC();
            const f32x4 q4 = *(const LAS f32x4*)(red + (32 * omt + l31) * 4);
            const float rstd = rsqrtf(((q4.x + q4.y) + (q4.z + q4.w)) * (1.0f / 128.0f) + EPS);
            const unsigned a2b = opqu(trow * (unsigned)D + (unsigned)(h * 128 + 32 * ont + 4 * lh));
#pragma unroll
            for (int g = 0; g < 4; ++g) {
                u32x2 w; w.x = cvt_pk_bf16(o[4 * g] * rstd * bflo(gg[g].x), o[4 * g + 1] * rstd * bfhi(gg[g].x));
                w.y = cvt_pk_bf16(o[4 * g + 2] * rstd * bflo(gg[g].y), o[4 * g + 3] * rstd * bfhi(gg[g].y));
                *(u32x2*)(A2 + a2b + g * 8) = w; }
        }
    }
}
__device__ __forceinline__ void gla_passC_unit(const Frame& F, const Args& a, int b, int h, int xb) {
    const bf16_t* P = (const bf16_t*)(F.ws + WS_P); const bf16_t* ST = (const bf16_t*)(F.ws + WS_ST); bf16_t* A2 = (bf16_t*)(F.ws + WS_A2);
    bf16_t* OF = (bf16_t*)(F.ws + WS_YX);
    gla_passC_dir<0>(F, P, b, h, xb, ST, OF, A2, a.in[13]);
    gla_passC_dir<1>(F, P, b, h, xb, ST, OF, A2, a.in[13]);
}

__device__ __forceinline__ void p7_rows(const Frame& F, const Args& a, const XcdBarrier& bar, bool pending) {
    const float* x = a.in[0]; const float* gpm = a.in[7]; const float* gpf = a.in[8]; const float* b_router = a.in[17];
    const float* mod = (const float*)(F.ws + WS_MOD); const bf16_t* YX = (const bf16_t*)(F.ws + WS_YXB);
    const bf16_t* WRH = (const bf16_t*)(F.ws + WS_WRH); const bf16_t* WRL = (const bf16_t*)(F.ws + WS_WRL);
    bf16_t* X1B = (bf16_t*)(F.ws + WS_X1B); unsigned char* HX2F = F.ws + WS_HX2F; int* PE = (int*)(F.ws + WS_PE); int* PSLOT = (int*)(F.ws + WS_PSLOT); float* PW = (float*)(F.ws + WS_PW);
    int* RTOK = (int*)(F.ws + WS_RTOK); unsigned* cnt = F.ctl + CW_CNT;
    LAS float* part = (LAS float*)F.lds;
    LAS float* logit = (LAS float*)(F.lds + 65536);
    LAS int* lcnt = (LAS int*)(F.lds + LDS_TAB);
    const int l31 = F.lane & 31, lh = F.lane >> 5;
    for (int g = F.bid; g < M / 64; g += F.G) {
        const int base = (F.G == 256) ? ((8 * (g & 7) + (g >> 5)) * 256 + ((g >> 3) & 3) * 64) : g * 64;
        if (F.tid < 64) lcnt[F.tid] = 0;
        f32x4 cgt[4], e2[4], f2[4];
        { const float* mrow = mod + (base >> 12) * 6144;
#pragma unroll
          for (int j = 0; j < 4; ++j) { const int col = F.lane * 4 + 256 * j; cgt[j] = *(const f32x4*)(mrow + 2048 + col) * *(const f32x4*)(gpm + col);
              e2[j] = *(const f32x4*)(gpf + col) * (1.0f + *(const f32x4*)(mrow + 4096 + col)); f2[j] = *(const f32x4*)(mrow + 3072 + col); } }
        u32x2 yw[4]; f32x4 xx[4];
        { const int m0 = base + F.wave * 8;
#pragma unroll
          for (int j = 0; j < 4; ++j) { const int col = F.lane * 4 + 256 * j; xx[j] = __builtin_nontemporal_load((const f32x4*)(x + (size_t)m0 * D + col)); }
          if (pending && g == F.bid) xcd_wait(bar);
#pragma unroll
          for (int j = 0; j < 4; ++j) { const int col = F.lane * 4 + 256 * j; yw[j] = __builtin_nontemporal_load((const u32x2*)(YX + (size_t)m0 * D + col)); } }
#pragma unroll 1
        for (int r = 0; r < 8; ++r) {
            const int m = base + F.wave * 8 + r, mn = base + F.wave * 8 + (r < 7 ? r + 1 : r);
            u32x2 ywn[4]; f32x4 xn[4];
#pragma unroll
            for (int j = 0; j < 4; ++j) { const int col = F.lane * 4 + 256 * j; ywn[j] = __builtin_nontemporal_load((const u32x2*)(YX + (size_t)mn * D + col)); xn[j] = __builtin_nontemporal_load((const f32x4*)(x + (size_t)mn * D + col)); }
            f32x4 y[4]; float s = 0.f;
#pragma unroll
            for (int j = 0; j < 4; ++j) { y[j] = (f32x4){bflo(yw[j].x), bfhi(yw[j].x), bflo(yw[j].y), bfhi(yw[j].y)};
                s += (y[j].x * y[j].x + y[j].y * y[j].y) + (y[j].z * y[j].z + y[j].w * y[j].w); }
            const float rstd = rsqrtf(wave_sum(s) * (1.f / D) + EPS);
            float s2 = 0.f;
#pragma unroll
            for (int j = 0; j < 4; ++j) { const int col = F.lane * 4 + 256 * j;
                xx[j] = xx[j] + cgt[j] * (y[j] * rstd);
                { u32x2 w1; w1.x = cvt_pk_bf16(xx[j].x, xx[j].y); w1.y = cvt_pk_bf16(xx[j].z, xx[j].w); __builtin_nontemporal_store(w1, (u32x2*)(X1B + (size_t)m * D + col)); }
                s2 += (xx[j].x * xx[j].x + xx[j].y * xx[j].y) + (xx[j].z * xx[j].z + xx[j].w * xx[j].w); }
            const float rstd2 = rsqrtf(wave_sum(s2) * (1.f / D) + EPS);
#pragma unroll
            for (int j = 0; j < 4; ++j) { const int col = F.lane * 4 + 256 * j;
                const f32x4 hh = xx[j] * rstd2 * e2[j] + f2[j];
                u32x2 w; w.x = cvt_pk_bf16(hh.x, hh.y); w.y = cvt_pk_bf16(hh.z, hh.w);
                const int lr = F.wave * 8 + r;
                *(LAS u32x2*)(F.lds + lr * 2048 + ((((F.lane >> 1) + 32 * j) ^ (lr & 15)) * 16) + (F.lane & 1) * 8) = w;
                *(unsigned*)(HX2F + (size_t)m * D + col) = pk4_fp8(hh.x, hh.y, hh.z, hh.w); }
#pragma unroll
            for (int j = 0; j < 4; ++j) { yw[j] = ywn[j]; xx[j] = xn[j]; }
        }
        __syncthreads();
        {
            f32x16 acc0, acc1;
#pragma unroll
            for (int r = 0; r < 16; ++r) { acc0[r] = 0.f; acc1[r] = 0.f; }
#pragma unroll
            for (int ks = 0; ks < 8; ++ks) {
                const int k0 = 128 * F.wave + 16 * ks + 8 * lh, ch = ((16 * F.wave + 2 * ks + lh) ^ (l31 & 15)) * 16;
                const bf16x8 a0 = *(const LAS bf16x8*)(F.lds + l31 * 2048 + ch), a1 = *(const LAS bf16x8*)(F.lds + (32 + l31) * 2048 + ch);
                const bf16x8 bh = *(const bf16x8*)(WRH + l31 * 1024 + k0), bl = *(const bf16x8*)(WRL + l31 * 1024 + k0);
                acc0 = mfma32(a0, bh, acc0); acc0 = mfma32(a0, bl, acc0); acc1 = mfma32(a1, bh, acc1); acc1 = mfma32(a1, bl, acc1);
            }
            const int pb = opq((F.wave * 64 + 4 * lh) * 32 + l31);
            __syncthreads();
#pragma unroll
            for (int r = 0; r < 16; ++r) { part[pb + crow0(r) * 32] = acc0[r]; part[pb + (32 + crow0(r)) * 32] = acc1[r]; }
        }
        __syncthreads();
        { f32x4 t = *(const f32x4*)(b_router + ((F.tid * 4) & 31));
#pragma unroll
          for (int w = 0; w < 8; ++w) t += *(const LAS f32x4*)(part + w * 2048 + F.tid * 4);
          *(LAS f32x4*)(logit + F.tid * 4) = t; }
        __syncthreads();
#pragma unroll 1
        for (int r = 0; r < 8; ++r) {
            const int m = base + F.wave * 8 + r;
            float v = (F.lane < 32) ? logit[(F.wave * 8 + r) * 32 + l31] : -3.0e38f; float tv[4]; int ti[4];
#pragma unroll
            for (int k = 0; k < 4; ++k) {
                float mx = v;
#pragma unroll
                for (int o = 1; o < 64; o <<= 1) mx = fmaxf(mx, __shfl_xor(mx, o));
                const unsigned long long bal = __ballot(v == mx);
                int idx = __ffsll((long long)bal) - 1; idx = idx < 0 ? 0 : (idx > 31 ? 31 : idx);
                tv[k] = mx; ti[k] = idx;
                if (F.lane == idx) v = -3.0e38f;
            }
            const float e1 = __expf(tv[1] - tv[0]), e2 = __expf(tv[2] - tv[0]), e3 = __expf(tv[3] - tv[0]);
            const float inv = 1.0f / (1.0f + e1 + e2 + e3);
            if (F.lane < 4) {
                const int e = F.lane == 0 ? ti[0] : F.lane == 1 ? ti[1] : F.lane == 2 ? ti[2] : ti[3];
                const float w = (F.lane == 0 ? 1.0f : F.lane == 1 ? e1 : F.lane == 2 ? e2 : e3) * inv;
                const int lrank = __hip_atomic_fetch_add(lcnt + e, 1, __ATOMIC_RELAXED, __HIP_MEMORY_SCOPE_WORKGROUP);
                PE[m * 4 + F.lane] = e; PSLOT[m * 4 + F.lane] = lrank; PW[m * 4 + F.lane] = w;
            }
        }
        __syncthreads();
        if (F.tid < 32) { const int c = lcnt[F.tid]; lcnt[32 + F.tid] = c ? (int)__hip_atomic_fetch_add(cnt + 64 * F.tid, (unsigned)c, __ATOMIC_RELAXED, __HIP_MEMORY_SCOPE_AGENT) : 0; }
        __syncthreads();
        if (F.tid < 256) { const int m = base + (F.tid >> 2), k = F.tid & 3; const int e = PE[m * 4 + k]; const int slot = lcnt[32 + e] + PSLOT[m * 4 + k];
            PSLOT[m * 4 + k] = slot; RTOK[e * ECAP + slot] = m * 1024; }
        __syncthreads();
    }
}

__device__ __forceinline__ void moe_tables(const Frame& F) {
    LAS int* tab = (LAS int*)(F.lds + LDS_TAB);
    __syncthreads();
    if (F.tid < 64) {
        const int c = (F.lane < 32) ? (int)__hip_atomic_load(F.ctl + CW_CNT + 64 * (F.lane & 31), __ATOMIC_RELAXED, __HIP_MEMORY_SCOPE_AGENT) : 0;
        const int padded = ((c + 255) >> 8) * 256;
        int incl = padded;
#pragma unroll
        for (int o = 1; o < 32; o <<= 1) { const int t = __shfl_up(incl, o); if (F.lane >= o) incl += t; }
        if (F.lane < 32) { tab[F.lane] = c; tab[32 + F.lane] = incl - padded; }
        if (F.lane == 31) tab[64] = incl >> 8;
    }
    __syncthreads();
}

__device__ __forceinline__ void p10_final(const Frame& F, const Args& a, const XcdBarrier& bar, bool pending) {
    const float* gpo = a.in[9]; const float* mod = (const float*)(F.ws + WS_MOD);
    const unsigned char* YB = F.ws + WS_YB; const bf16_t* X1B = (const bf16_t*)(F.ws + WS_X1B); const int* PE = (const int*)(F.ws + WS_PE); const int* PSLOT = (const int*)(F.ws + WS_PSLOT); const float* PW = (const float*)(F.ws + WS_PW);
    const LAS int* tab = (const LAS int*)(F.lds + LDS_TAB);
    const int gw = F.bid * 8 + F.wave;
    struct Rec { int e[4], s[4]; float w[4]; };
    auto ld_rec = [&](int m, Rec& r) {
#pragma unroll
        for (int k = 0; k < 4; ++k) { r.e[k] = PE[m * 4 + k]; r.s[k] = PSLOT[m * 4 + k]; r.w[k] = PW[m * 4 + k]; } };
    auto ld_x = [&](int m, u32x2 (&xw)[4]) {
#pragma unroll
        for (int j = 0; j < 4; ++j) xw[j] = __builtin_nontemporal_load((const u32x2*)(X1B + (size_t)m * D + F.lane * 4 + 256 * j)); };
    auto ld_y = [&](const Rec& r, int (&yv)[16]) {
#pragma unroll
        for (int k = 0; k < 4; ++k) { const unsigned char* yr = YB + (size_t)(tab[32 + r.e[k]] + r.s[k]) * D + F.lane * 4;
#pragma unroll
            for (int j = 0; j < 4; ++j) yv[k * 4 + j] = __builtin_nontemporal_load((const int*)(yr + 256 * j)); } };
    auto ld_row = [&](int m, const Rec& r, int (&yv)[16], u32x2 (&xw)[4]) { ld_y(r, yv); ld_x(m, xw); };
#pragma unroll 1
    for (int g8 = gw; g8 < M / 8; g8 += F.G * 8) {
    const int mbeg = g8 * 8, mend = mbeg + 7;
    int m = mbeg;
    Rec r0, r1; int yv[16]; u32x2 xw[4];
    f32x4 ggt[4];
    { const float* mrow = mod + (mbeg >> 12) * 6144;
#pragma unroll
      for (int j = 0; j < 4; ++j) { const int col = F.lane * 4 + 256 * j; ggt[j] = *(const f32x4*)(gpo + col) * *(const f32x4*)(mrow + 5120 + col); } }
    ld_rec(m, r0);
    ld_rec(m + 1, r1);
    ld_x(m, xw);
    if (pending && g8 == gw) xcd_wait(bar);
    ld_y(r0, yv);
#pragma unroll 1
    for (; m <= mend; ++m) {
        const int m1 = m + 1 <= mend ? m + 1 : m, m2 = m1 + 1 <= mend ? m1 + 1 : m1;
        Rec r2; ld_rec(m2, r2);
        int yn[16]; u32x2 xn[4];
        ld_row(m1, r1, yn, xn);
        f32x4 y[4];
#pragma unroll
        for (int j = 0; j < 4; ++j) y[j] = (f32x4){0.f, 0.f, 0.f, 0.f};
#pragma unroll
        for (int k = 0; k < 4; ++k) { const float w = r0.w[k];
#pragma unroll
            for (int j = 0; j < 4; ++j) { const int v = yv[k * 4 + j];
                const auto lo = __builtin_amdgcn_cvt_pk_f32_fp8(v, false), hi = __builtin_amdgcn_cvt_pk_f32_fp8(v, true);
                y[j].x += w * lo[0]; y[j].y += w * lo[1]; y[j].z += w * hi[0]; y[j].w += w * hi[1]; } }
        float s = 0.f;
#pragma unroll
        for (int j = 0; j < 4; ++j) s += (y[j].x * y[j].x + y[j].y * y[j].y) + (y[j].z * y[j].z + y[j].w * y[j].w);
        const float rstd = rsqrtf(wave_sum(s) * (1.f / D) + EPS);
#pragma unroll
        for (int j = 0; j < 4; ++j) { const int col = F.lane * 4 + 256 * j;
            float* op = a.out + (size_t)m * D + col; const f32x4 x1 = {bflo(xw[j].x), bfhi(xw[j].x), bflo(xw[j].y), bfhi(xw[j].y)};
            __builtin_nontemporal_store(x1 + ggt[j] * (y[j] * rstd), (f32x4*)op); }
        r0 = r1; r1 = r2;
#pragma unroll
        for (int i = 0; i < 16; ++i) yv[i] = yn[i];
#pragma unroll
        for (int j = 0; j < 4; ++j) xw[j] = xn[j];
    }
    }
}

constexpr int NPHASE = 11;
__global__ void __launch_bounds__(512, 2) mk_fwd(Args args) {
    extern __shared__ __attribute__((aligned(16))) unsigned char lds_raw[];
    Frame F;
    F.lds = (LAS unsigned char*)lds_raw; F.ws = args.ws; F.ctl = (unsigned*)(args.ws + WS_CTL);
    F.tid = threadIdx.x; F.lane = F.tid & 63; F.wave = __builtin_amdgcn_readfirstlane(F.tid >> 6); F.G = gridDim.x; F.bid = blockIdx.x;
    volatile LAS unsigned* MISC = (volatile LAS unsigned*)(F.lds + LDS_MISC);
    if (F.tid < 32) MISC[F.tid] = 0u;
    __syncthreads();
    XcdBarrier bar = xcd_barrier_post(F.ctl + CW_BAR + args.li * XCD_BAR_WORDS, MISC + 8);
    const int lo = args.ph_lo, hi = args.ph_hi;
#ifndef PHMASK
#define PHMASK 0x7ff
#endif
#define IN(k) (((PHMASK >> (k)) & 1) && lo <= (k) && (k) < hi)
#define SEAM(k) do { if (IN(k) && IN((k) + 1)) xcd_barrier(bar); } while (0)

    if (IN(0)) { p0_prologue(F, args); }
    if (IN(1)) for (int rep = 0; rep <= ((REPMASK >> 1) & 1); ++rep) { if (rep) xcd_barrier(bar); p1_normmod(F, args, 192u); }
    if (IN(1) && IN(2)) xcd_arrive(bar);
    if (IN(2)) for (int rep = 0; rep <= ((REPMASK >> 2) & 1); ++rep) { if (rep) xcd_barrier(bar);
        pg8::StaticOrder S; S.init(F.ws + WS_HX, F.ws + WS_WIN, M, NIN, D, F.G, F.bid);
        EpiInProj E{(bf16_t*)(F.ws + WS_P), args.in[12], (bf16_t*)(F.ws + WS_U), args.in[13]};
        const int nctx = 24;
        const bool tfirst = (F.bid >= nctx) && (((F.bid >> 3) & 1) != 0);
        const int nbefore = tfirst ? 11 : 2;
        if (F.bid >= nctx) { transpose_items_fp8(F, args, (F.bid - nctx) * 8 + F.wave, (F.G - nctx) * 8, 0, nbefore); __syncthreads(); }
        if (IN(1) && rep == 0) xcd_wait(bar);
        {
            pg8::P2Order O; O.S = S; O.ctx = (F.bid < nctx);
            O.cu.pm = 64 + F.bid / 6; O.cu.pn = 2 + F.bid % 6; O.cu.A = (const char*)(F.ws + WS_HX) + (size_t)O.cu.pm * 256 * D * 2; O.cu.B = (const char*)(F.ws + WS_WIN) + (size_t)O.cu.pn * 256 * D * 2;
            pg8::gemm_phase<EpiInProj, pg8::P2Order, false, true, true>(F.lds, D, O, E);
        }
        const bool lastrep = rep == ((REPMASK >> 2) & 1);
        if (F.bid >= nctx) {
            if (IN(3) && lastrep) xcd_arrive(bar);
            transpose_items_fp8(F, args, (F.bid - nctx) * 8 + F.wave, (F.G - nctx) * 8, nbefore, 1 << 20); __syncthreads();
        }
        if (F.bid < nctx) {
            asm volatile("s_waitcnt vmcnt(0)" ::: "memory");
            __syncthreads();
            if (F.tid == 0) { __builtin_amdgcn_fence(__ATOMIC_RELEASE, "agent"); asm volatile("s_waitcnt vmcnt(0)" ::: "memory");
                __hip_atomic_fetch_add(F.ctl + CW_CTX + 64 * (F.bid / 6), 1u, __ATOMIC_RELAXED, __HIP_MEMORY_SCOPE_AGENT); }
            if (IN(3) && lastrep) xcd_arrive(bar);
            const bf16_t* P = (const bf16_t*)(F.ws + WS_P); bf16_t* ST = (bf16_t*)(F.ws + WS_ST); float* DDp = (float*)(F.ws + WS_DD);
            for (int u = F.bid; u < 32; u += nctx) {
                const int b = u >> 3, h = (u >> 1) & 3;
                if (F.tid == 0) { unsigned sp = 0;
                    while (__hip_atomic_load(F.ctl + CW_CTX + 64 * b, __ATOMIC_RELAXED, __HIP_MEMORY_SCOPE_AGENT) < 6u * (unsigned)(rep + 1)) { __builtin_amdgcn_s_sleep(2); if (++sp > (1u << 22)) break; }
                    __builtin_amdgcn_fence(__ATOMIC_ACQUIRE, "agent"); asm volatile("s_waitcnt vmcnt(0)" ::: "memory"); }
                __syncthreads();
                if (u & 1) gla_passA_unit<1>(F, P, b, h, 0, ST + (size_t)(u * NBLK) * 16384, DDp + (u * NBLK) * 128);
                else gla_passA_unit<0>(F, P, b, h, 0, ST + (size_t)(u * NBLK) * 16384, DDp + (u * NBLK) * 128);
                __syncthreads();
            }
        }
    }
    if (IN(2) && IN(3)) xcd_wait(bar);
    if (IN(3)) for (int rep = 0; rep <= ((REPMASK >> 3) & 1); ++rep) { if (rep) xcd_barrier(bar);
        const bf16_t* P = (const bf16_t*)(F.ws + WS_P); bf16_t* A2 = (bf16_t*)(F.ws + WS_A2);
        const bf16_t* Up = (const bf16_t*)(F.ws + WS_U);
        bf16_t* ST = (bf16_t*)(F.ws + WS_ST); float* DDp = (float*)(F.ws + WS_DD);
        for (int uu = F.bid; uu < 32 * 16; uu += F.G) { const int seq = uu >> 4, blk = 1 + (uu & 15), b = seq >> 3, h = (seq >> 1) & 3, dir = seq & 1, u = seq * NBLK + blk;
            if (dir == 0) gla_passA_unit<0>(F, P, b, h, blk, ST + (size_t)u * 16384, DDp + u * 128);
            else gla_passA_unit<1>(F, P, b, h, blk, ST + (size_t)u * 16384, DDp + u * 128); }
    }
    if (IN(3) && IN(4)) xcd_arrive(bar);
    if (IN(3)) {
        bf16_t* A2 = (bf16_t*)(F.ws + WS_A2); const bf16_t* Up = (const bf16_t*)(F.ws + WS_U);
        for (int w = F.bid; w < 256; w += F.G) {
            const int grp = (w & 7) * 4 + ((w >> 3) >> 3), mem = (w >> 3) & 7, b = grp >> 3, slab = (grp & 7) * 8 + mem, gi = slab >> 4;
            if (gi == 0) pool_unit<2>(F, Up, A2, b, slab); else if (gi == 1) pool_unit<4>(F, Up, A2, b, slab); else if (gi == 2) pool_unit<8>(F, Up, A2, b, slab); else pool_unit<16>(F, Up, A2, b, slab); }
    }
    if (IN(3) && IN(4)) xcd_wait(bar);
    if (IN(4)) { p4_scan(F); }
    if (IN(4) && IN(5)) xcd_arrive(bar);
    if (IN(4)) p0_late(F, args);
    if (IN(4) && IN(5)) xcd_wait(bar);
    if (IN(5)) for (int rep = 0; rep <= ((REPMASK >> 5) & 1); ++rep) { if (rep) xcd_barrier(bar); for (int u = F.bid; u < 256; u += F.G) {
            const int x = u & 7, slot = u >> 3;
            gla_passC_unit(F, args, x >> 1, slot >> 3, (x & 1) * 8 + (slot & 7)); } }
    SEAM(5);
    if (IN(6)) for (int rep = 0; rep <= ((REPMASK >> 6) & 1); ++rep) { if (rep) xcd_barrier(bar);
        pg8::StaticOrder S; S.init(F.ws + WS_A2, F.ws + WS_WOUT, M, D, D, F.G, F.bid);
        EpiBf16Out E{(bf16_t*)(F.ws + WS_YXB), D};
        pg8::gemm_phase<EpiBf16Out, pg8::StaticOrder, false, false, true>(F.lds, D, S, E);
    }
    if (IN(6) && IN(7)) xcd_arrive(bar);
    if (IN(7)) { p7_rows(F, args, bar, IN(6) && IN(7)); }
    SEAM(7);
    if (IN(8)) for (int rep = 0; rep <= ((REPMASK >> 8) & 1); ++rep) { if (rep) xcd_barrier(bar);
        moe_tables(F);
        MoeOrder<8, true> S; S.tab = (const LAS int*)(F.lds + LDS_TAB); S.Abase = (const char*)(F.ws + WS_HX2F); S.Wbase = (const char*)(F.ws + WS_WGU); S.rtok = (const int*)(F.ws + WS_RTOK);
        S.cls = 0; S.rank = (F.bid & 7) * (F.G >> 3) + (F.bid >> 3); S.nrank = F.G; S.mtc = F.ctl + CW_MT;
        EpiGateUp E{F.ws + WS_H, args.in[19], args.in[21]};
        pg8::gemm_phase<EpiGateUp, MoeOrder<8, true>, true, true, true, true>(F.lds, 512, S, E);
    }
    if (IN(9)) for (int rep = 0; rep <= ((REPMASK >> 9) & 1); ++rep) { if (rep) xcd_barrier(bar);
        if (!IN(8) || rep) moe_tables(F);
        MoeOrder<4, false> S; S.tab = (const LAS int*)(F.lds + LDS_TAB); S.Abase = (const char*)(F.ws + WS_H); S.Wbase = (const char*)(F.ws + WS_WDN); S.rtok = nullptr;
        S.cls = 0; S.rank = F.G - 1 - ((F.bid & 7) * (F.G >> 3) + (F.bid >> 3)); S.nrank = F.G; S.mtc = F.ctl + CW_MT;
        EpiDown E{F.ws + WS_YB, args.in[23]};
        pg8::gemm_phase<EpiDown, MoeOrder<4, false>, false, true, true, true>(F.lds, 512, S, E);
    }
    if (IN(9) && IN(10)) xcd_arrive(bar);
    if (IN(10)) { if (!IN(9)) moe_tables(F);
        p10_final(F, args, bar, IN(9) && IN(10)); }
#undef IN
#undef SEAM
}

extern "C" void kernel_launch(void* const* d_in, const int* in_sizes, int n_in, void* d_out, int out_size, void* d_ws, size_t ws_size, hipStream_t stream) {
    static int grid = 0;
    if (grid == 0) {
        if (n_in != 24 || out_size != M * D || ws_size < WS_END) { fprintf(stderr, "kernel_launch: unexpected shapes (n_in %d out %d ws %zu)\n", n_in, out_size, ws_size); grid = -1; return; }
        int dev = 0, cus = 0, per_cu = 0;
        if (hipGetDevice(&dev) != hipSuccess || hipDeviceGetAttribute(&cus, hipDeviceAttributeMultiprocessorCount, dev) != hipSuccess) { grid = -1; return; }
        if (hipFuncSetAttribute((const void*)mk_fwd, hipFuncAttributeMaxDynamicSharedMemorySize, LDS_BYTES) != hipSuccess) { fprintf(stderr, "kernel_launch: hipFuncSetAttribute failed\n"); grid = -1; return; }
        if (hipOccupancyMaxActiveBlocksPerMultiprocessor(&per_cu, (const void*)mk_fwd, 512, LDS_BYTES) != hipSuccess || per_cu < 1) { fprintf(stderr, "kernel_launch: occupancy query says %d\n", per_cu); }
        (void)hipGetLastError();
        grid = cus;
        if (grid % 8 != 0 || M % grid != 0 || (M / grid) % 64 != 0) { fprintf(stderr, "kernel_launch: unsupported CU count %d\n", cus); grid = -1; return; }
    }
    if (grid < 0) return;
    if (hipMemsetAsync((char*)d_ws + WS_CTL, 0, CTL_ZERO_BYTES, stream) != hipSuccess) return;
    Args a{};
    for (int i = 0; i < 24; ++i) a.in[i] = (const float*)d_in[i];
    a.out = (float*)d_out; a.ws = (unsigned char*)d_ws; a.pad = 0;
    constexpr int NL = MK_N_LAUNCHES;
    for (int li = 0; li < NL; ++li) {
        a.ph_lo = (NL == 1) ? 0 : li; a.ph_hi = (NL == 1) ? NPHASE : li + 1; a.li = (NL == 1) ? 0 : 0;
        hipLaunchKernelGGL(mk_fwd, dim3(grid), dim3(512), LDS_BYTES, stream, a);
    }
}
```

```cpp
#include <hip/hip_runtime.h>
#include <cstdio>
#include <cstdint>

#define LAS __attribute__((address_space(3)))
typedef unsigned short bf16_t;
typedef short bf16x8 __attribute__((ext_vector_type(8)));
typedef float f32x4 __attribute__((ext_vector_type(4)));
typedef float f32x16 __attribute__((ext_vector_type(16)));
typedef unsigned u32x4 __attribute__((ext_vector_type(4)));
typedef unsigned u32x2 __attribute__((ext_vector_type(2)));

#ifndef MK_N_LAUNCHES
#define MK_N_LAUNCHES 1
#endif
#ifndef REPMASK
#define REPMASK 0x000
#endif

constexpr int D = 1024, NB = 4, SEQ = 4096, M = NB * SEQ, CTXL = 256, MC = NB * CTXL, MTOT = M + MC;
constexpr int NIN = 3072, NE = 32, TOPK = 4, FF = 1024;
constexpr int NHEAD = 4, HD = 128;
constexpr int NBLK = 17;
constexpr int ECAP = 16384;
constexpr int HROWS = 65536 + NE * 256;
constexpr float EPS = 1e-6f;

constexpr size_t MiB = 1u << 20;
constexpr size_t WS_CTL = 0, CTL_ZERO_BYTES = 1 * MiB;
constexpr size_t WS_MOD = 1 * MiB;
constexpr size_t WS_WRH = 1 * MiB + 128 * 1024;
constexpr size_t WS_WRL = 1 * MiB + 192 * 1024;
constexpr size_t WS_PE = 1 * MiB + 256 * 1024;
constexpr size_t WS_PSLOT = WS_PE + 256 * 1024;
constexpr size_t WS_PW = WS_PSLOT + 256 * 1024;
constexpr size_t WS_WIN = 2 * MiB;
constexpr size_t WS_WOUT = 8 * MiB;
constexpr size_t WS_WGU = 10 * MiB;
constexpr size_t WS_WDN = 74 * MiB;
constexpr size_t WS_HX2 = 106 * MiB;
constexpr size_t WS_HX2F = 138 * MiB;
constexpr size_t WS_U = 138 * MiB;
constexpr size_t WS_YB = 154 * MiB;
constexpr size_t WS_P = 234 * MiB;
constexpr size_t WS_X1B = 234 * MiB;
constexpr size_t WS_H = 298 * MiB;
constexpr size_t WS_HX = 336 * MiB;
constexpr size_t WS_ST = 370 * MiB;
constexpr size_t WS_DD = 405 * MiB;
constexpr size_t WS_A2 = 406 * MiB;
constexpr size_t WS_YX = 438 * MiB;
constexpr size_t WS_YXB = 470 * MiB;
constexpr size_t WS_RTOK = 502 * MiB;
constexpr size_t WS_END = 504 * MiB;
static_assert(WS_YB + (size_t)HROWS * 1024 * 2 <= WS_H && WS_H + (size_t)HROWS * 1024 <= WS_ST, "MoE buffers");
static_assert(WS_P + (size_t)MTOT * NIN * 2 <= WS_HX && WS_HX + (size_t)MTOT * D * 2 <= WS_ST && WS_ST + (size_t)32 * NBLK * 16384 * 4 <= WS_DD, "ws map");
constexpr float WSCALE = 256.0f, WSCALE_INV = 1.0f / 256.0f;

constexpr int CW_BAR = 4096;
constexpr int CW_CNT = 8192;
constexpr int CW_MT = 32768;
constexpr int CW_MOD = 12800;
constexpr int CW_CTX = 12288;

constexpr int RING_BYTES = 131072;
constexpr int LDS_TAB = RING_BYTES;
constexpr int LDS_MISC = RING_BYTES + 4096;
constexpr int LDS_BIAS = RING_BYTES + 1024;
constexpr int LDS_GOFF = RING_BYTES + 6144;
constexpr int LDS_BYTES = 155648;
static_assert(LDS_GOFF + 2 * 512 * 16 <= LDS_BYTES, "LDS map");
static_assert(8 * 16384 <= RING_BYTES, "per-wave scratch stays below the LDS tables / control words");

typedef float f32x2_ __attribute__((ext_vector_type(2)));
typedef __bf16 bf16x2_ __attribute__((ext_vector_type(2)));
__device__ __forceinline__ unsigned cvt_pk_bf16(float lo, float hi) { const bf16x2_ r = __builtin_convertvector((f32x2_){lo, hi}, bf16x2_); return __builtin_bit_cast(unsigned, r); }
__device__ __forceinline__ float bf2f(unsigned short b) { return __uint_as_float(((unsigned)b) << 16); }
__device__ __forceinline__ float bflo(unsigned w) { return __uint_as_float(w << 16); }
__device__ __forceinline__ float bfhi(unsigned w) { return __uint_as_float(w & 0xffff0000u); }
__device__ __forceinline__ unsigned short f2bf(float f) { return (unsigned short)(cvt_pk_bf16(f, 0.f) & 0xffffu); }
__device__ __forceinline__ unsigned pk4_fp8(float a, float b, float c, float d) { int w = __builtin_amdgcn_cvt_pk_fp8_f32(a, b, 0, false); w = __builtin_amdgcn_cvt_pk_fp8_f32(c, d, w, true); return (unsigned)w; }
__device__ __forceinline__ float sigmoidf_(float x) { return __builtin_amdgcn_rcpf(1.0f + __builtin_amdgcn_exp2f(-1.44269504089f * x)); }
__device__ __forceinline__ float wave_sum(float v) {
#pragma unroll
    for (int o = 1; o < 64; o <<= 1) v += __shfl_xor(v, o);
    return v;
}
#define LDS_WAIT() asm volatile("s_waitcnt lgkmcnt(0)" ::: "memory")
#define VM_WAIT() asm volatile("s_waitcnt vmcnt(0)" ::: "memory")
#define LSYNC() do { asm volatile("s_waitcnt lgkmcnt(0)" ::: "memory"); __builtin_amdgcn_s_barrier(); asm volatile("" ::: "memory"); } while (0)

#define XB_TMO      128
#define XB_XCNT(j)  (256  + 64 * (j))
#define XB_XSUB(j)  (1280 + 64 * (j))
#define XB_XGEN(j)  (2304 + 64 * (j))
#define XB_TOP      3328
#define XB_TOPGEN   3392
#define XCD_BAR_WORDS 3456
#define XB_SPIN_CAP (1u << 18)
__device__ __forceinline__ unsigned xb_ld(unsigned* p)              { return __hip_atomic_load(p, __ATOMIC_RELAXED, __HIP_MEMORY_SCOPE_AGENT); }
__device__ __forceinline__ unsigned xb_add(unsigned* p, unsigned v) { return __hip_atomic_fetch_add(p, v, __ATOMIC_RELAXED, __HIP_MEMORY_SCOPE_AGENT); }
__device__ __forceinline__ unsigned xb_xcc_id() { return (unsigned)__builtin_amdgcn_s_getreg((3 << 11) | 20) & 0xFu; }
#define XB_SPIN(cond, bar) do { unsigned _sp = 0; while (cond) { __builtin_amdgcn_s_sleep(1); \
    if ((++_sp & 255u) == 0u) { if (xb_ld(&(bar)[XB_TMO])) break; if (_sp > XB_SPIN_CAP) { atomicAdd(&(bar)[XB_TMO], 1u); break; } } } } while (0)
struct XcdBarrier { unsigned* bar; unsigned x; volatile LAS unsigned* st; };
__device__ __forceinline__ XcdBarrier xcd_barrier_post(unsigned* bar, volatile LAS unsigned* st) {
    XcdBarrier b; b.bar = bar; b.x = xb_xcc_id(); b.st = st;
    if (threadIdx.x == 0) (void)xb_add(&bar[XB_XCNT(b.x)], 1u);
    return b;
}
__device__ __forceinline__ void xcd_barrier_complete(unsigned* bar, unsigned x, unsigned& nloc, unsigned& nx) {
    const unsigned G = gridDim.x * gridDim.y * gridDim.z;
    unsigned sum, cnt, mine, sp = 0u;
    for (;;) {
        sum = 0u; cnt = 0u; mine = 0u;
#pragma unroll
        for (unsigned j = 0; j < 16; ++j) { const unsigned c = xb_ld(&bar[XB_XCNT(j)]); sum += c; cnt += (c > 0u) ? 1u : 0u; mine = (j == x) ? c : mine; }
        if (sum == G) break;
        __builtin_amdgcn_s_sleep(1);
        if ((++sp & 255u) == 0u) { if (xb_ld(&bar[XB_TMO])) break; if (sp > XB_SPIN_CAP) { atomicAdd(&bar[XB_TMO], 1u); break; } }
    }
    nloc = mine > 0u ? mine : 1u; nx = cnt > 0u ? cnt : 1u;
}
__device__ __forceinline__ void xcd_arrive(const XcdBarrier& b) {
    asm volatile("s_waitcnt vmcnt(0)" ::: "memory");
    __syncthreads();
    if (threadIdx.x == 0) {
        unsigned* bar = b.bar;
        __builtin_amdgcn_s_waitcnt(0);
        unsigned nloc = b.st[0], nx = b.st[1];
        if (nloc == 0u) { xcd_barrier_complete(bar, b.x, nloc, nx); b.st[0] = nloc; b.st[1] = nx; }
        const unsigned old = xb_add(&bar[XB_XSUB(b.x)], 1u);
        const unsigned gen = old / nloc;
        if (old + 1u == (gen + 1u) * nloc) {
            __builtin_amdgcn_fence(__ATOMIC_RELEASE, "agent");
            asm volatile("s_waitcnt vmcnt(0)" ::: "memory");
#pragma unroll
            for (unsigned j = 0; j < 16; ++j) (void)xb_add(&bar[XB_XGEN(j)], 1u);
        }
        b.st[2] = nx * (gen + 1u);
    }
}
__device__ __forceinline__ void xcd_wait(const XcdBarrier& b) {
    if (threadIdx.x == 0) {
        unsigned* bar = b.bar;
        const unsigned need = b.st[2];
        XB_SPIN((int)(xb_ld(&bar[XB_XGEN(b.x)]) - need) < 0, bar);
        __builtin_amdgcn_fence(__ATOMIC_ACQUIRE, "agent");
        asm volatile("s_waitcnt vmcnt(0)" ::: "memory");
    }
    __syncthreads();
}
__device__ __forceinline__ void xcd_barrier(const XcdBarrier& b) { xcd_arrive(b); xcd_wait(b); }

namespace pg8 {
constexpr int BM = 256, BK = 64, HALF = 128, HTB = HALF * BK * 2, STAGE_BYTES = 8 * HTB, NXCD = 8, WGM = 8;
__host__ __device__ __forceinline__ int lds_byte(int r, int c) { const int st = (r >> 4) * 2 + (c >> 5), rr = r & 15, cc = c & 31, ob = rr * 64 + cc * 2; return st * 1024 + (ob ^ (((ob >> 9) & 1) << 5)); }
__host__ __device__ __forceinline__ void stage_rc(int b, int& R, int& C) { const int st = b / 1024, sb = b % 1024, swz = sb ^ (((sb >> 9) & 1) << 5); R = (st >> 1) * 16 + swz / 64; C = (st & 1) * 32 + (swz % 64) / 2; }
__host__ __device__ __forceinline__ int perm32(int rho) { const int n = rho >> 4, i = rho & 15; return 8 * (i >> 2) + 4 * n + (i & 3); }

struct UnitS { const char* A; const char* B; int pm, pn; };
struct StaticOrder {
    typedef UnitS Unit;
    const char* Abase; const char* Bbase; size_t tstep;
    int nM, nN, nwg, G, c;
    __device__ void init(const void* A, const void* Bt, int M_, int N_, int K_, int G_, int c_) { Abase = (const char*)A; Bbase = (const char*)Bt; tstep = (size_t)BM * K_ * 2; nM = M_ / BM; nN = N_ / BM; nwg = nM * nN; G = G_; c = c_; }
    __device__ bool next(int i, Unit& u) const {
        const long L = (long)i * G + c; if (L >= nwg) return false;
        int wgid = (int)L; { const int q = nwg / NXCD, r = nwg % NXCD, xcd = wgid % NXCD, off = wgid / NXCD; wgid = (xcd < r ? xcd * (q + 1) : r * (q + 1) + (xcd - r) * q) + off; }
        const int nig = WGM * nN, gid = wgid / nig, fm = gid * WGM, gsz = (nM - fm) < WGM ? (nM - fm) : WGM;
        u.pm = fm + ((wgid % nig) % gsz); u.pn = (wgid % nig) / gsz;
        u.A = Abase + (size_t)u.pm * tstep; u.B = Bbase + (size_t)u.pn * tstep; return true;
    }
    static constexpr bool PUBLISH = false;
    __device__ __forceinline__ const int* row_src(const Unit&, int) const { return nullptr; }
    __device__ __forceinline__ unsigned row_tok(const Unit&, int) const { return 0u; }
    __device__ __forceinline__ void a_ready(const Unit&, int) const {}
    __device__ __forceinline__ int key(const Unit&) const { return 0; }
    __device__ __forceinline__ void publish(int) const {}
};

struct OneUnit { typedef UnitS Unit; UnitS u; static constexpr bool PUBLISH = false;
    __device__ bool next(int i, Unit& o) const { if (i) return false; o = u; return true; }
    __device__ __forceinline__ const int* row_src(const Unit&, int) const { return nullptr; } __device__ __forceinline__ unsigned row_tok(const Unit&, int) const { return 0u; }
    __device__ __forceinline__ void a_ready(const Unit&, int) const {} __device__ __forceinline__ int key(const Unit&) const { return 0; } __device__ __forceinline__ void publish(int) const {} };
struct P2Order { typedef UnitS Unit; StaticOrder S; UnitS cu; bool ctx; static constexpr bool PUBLISH = false;
    __device__ bool next(int i, Unit& o) const { if (i < 3) return S.next(i, o); if (i == 3 && ctx) { o = cu; return true; } return false; }
    __device__ __forceinline__ const int* row_src(const Unit&, int) const { return nullptr; } __device__ __forceinline__ unsigned row_tok(const Unit&, int) const { return 0u; }
    __device__ __forceinline__ void a_ready(const Unit&, int) const {} __device__ __forceinline__ int key(const Unit&) const { return 0; } __device__ __forceinline__ void publish(int) const {} };
typedef int i32x4 __attribute__((ext_vector_type(4)));
typedef int i32x8 __attribute__((ext_vector_type(8)));
template <class Epi, class Sched, bool GATHER, bool ALIGN_EPI, bool SP2, bool FP8 = false>
__device__ __forceinline__ void gemm_phase(LAS unsigned char* lds, const int K, const Sched& S, const Epi& E) {
    typedef typename Sched::Unit Unit;
    const int tid = threadIdx.x, wid = __builtin_amdgcn_readfirstlane(tid >> 6), lane = tid & 63, wr = wid >> 2, wc = wid & 3, fr = lane & 15, fq = lane >> 4;
    const int nt = K / BK;
    const size_t kstep = (size_t)(BK * 2);
    const size_t kstepB = FP8 ? (size_t)4096 : kstep;
    const size_t hstep = (size_t)HALF * K * 2;
    unsigned voffB[2], cA0[2], cA1[2];
#pragma unroll
    for (int i = 0; i < 2; ++i) { int R, C; stage_rc(tid * 16 + i * 8192, R, C); const int Rb = Epi::PERM ? ((R & ~31) + perm32(R & 31)) : R;
        voffB[i] = FP8 ? (unsigned)((Rb >> 5) * 32768 + (Rb & 31) * 128 + C * 2) : (unsigned)(Rb * K + C) * 2u; cA0[i] = (unsigned)(R * K + C) * 2u; cA1[i] = cA0[i] + (unsigned)hstep; }
#define gro(p, v) ((LAS unsigned*)(lds + LDS_GOFF + (p) * 8192 + (v) * 2048 + tid * 4))
    int gp = 0;
    unsigned gcc[2] = {0u, 0u};
    if constexpr (GATHER) { int R, C; stage_rc(tid * 16, R, C); gcc[0] = (unsigned)C * 2u; stage_rc(tid * 16 + 8192, R, C); gcc[1] = (unsigned)C * 2u; }
    const unsigned ldsw = (unsigned)wid * 1024u;
    const int aoff = lds_byte(wr * 64 + fr, fq * 8), boff = lds_byte(wc * 32 + fr, fq * 8);
#define PG8_SA(b, h) (((b) * 2 + (h)) * HTB)
#define PG8_SB(b, h) ((4 + (b) * 2 + (h)) * HTB)
#define PG8_STAGE(bufoff, gbase, voff) do { _Pragma("unroll") for (int _i = 0; _i < 2; ++_i) \
        __builtin_amdgcn_global_load_lds((const unsigned*)((const char*)(gbase) + (voff)[_i]), (LAS unsigned*)(lds + (bufoff) + ldsw + _i * 8192), 16, 0, 0); } while (0)
#define PG8_LDA(dst, b, h) do { _Pragma("unroll") for (int m = 0; m < 4; ++m) { const i32x4 _p0 = *(const LAS i32x4*)(lds + PG8_SA(b, h) + aoff + m * 2048), _p1 = *(const LAS i32x4*)(lds + PG8_SA(b, h) + aoff + m * 2048 + 1024); \
        dst[m] = __builtin_shufflevector(_p0, _p1, 0, 1, 2, 3, 4, 5, 6, 7); } } while (0)
#define PG8_LDB(dst, b, h) do { _Pragma("unroll") for (int n = 0; n < 2; ++n) { const i32x4 _p0 = *(const LAS i32x4*)(lds + PG8_SB(b, h) + boff + n * 2048), _p1 = *(const LAS i32x4*)(lds + PG8_SB(b, h) + boff + n * 2048 + 1024); \
        dst[n] = __builtin_shufflevector(_p0, _p1, 0, 1, 2, 3, 4, 5, 6, 7); } } while (0)
#define PG8_ACC(ai, bj, m, n) ((n) ? __builtin_shufflevector(acc[ai][bj][m], acc[ai][bj][m], 4, 5, 6, 7) : __builtin_shufflevector(acc[ai][bj][m], acc[ai][bj][m], 0, 1, 2, 3))
#define PG8_SETACC(ai, bj, m, n, v) do { const f32x4 _v = (v); if (n) acc[ai][bj][m] = __builtin_shufflevector(acc[ai][bj][m], __builtin_shufflevector(_v, _v, 0, 1, 2, 3, 0, 1, 2, 3), 0, 1, 2, 3, 12, 13, 14, 15); \
        else acc[ai][bj][m] = __builtin_shufflevector(acc[ai][bj][m], __builtin_shufflevector(_v, _v, 0, 1, 2, 3, 0, 1, 2, 3), 8, 9, 10, 11, 4, 5, 6, 7); } while (0)
#define PG8_MMA(ai, bj, At, Bt) do { __builtin_amdgcn_s_setprio(1); _Pragma("unroll") for (int m = 0; m < 4; ++m) _Pragma("unroll") for (int n = 0; n < 2; ++n) { \
        if constexpr (FP8) { PG8_SETACC(ai, bj, m, n, __builtin_amdgcn_mfma_scale_f32_16x16x128_f8f6f4(Bt[n], At[m], PG8_ACC(ai, bj, m, n), 0, 0, 0, 127, 0, 127)); } \
        else { f32x4 _c = __builtin_amdgcn_mfma_f32_16x16x32_bf16(__builtin_bit_cast(bf16x8, __builtin_shufflevector(Bt[n], Bt[n], 0, 1, 2, 3)), __builtin_bit_cast(bf16x8, __builtin_shufflevector(At[m], At[m], 0, 1, 2, 3)), PG8_ACC(ai, bj, m, n), 0, 0, 0); \
               PG8_SETACC(ai, bj, m, n, __builtin_amdgcn_mfma_f32_16x16x32_bf16(__builtin_bit_cast(bf16x8, __builtin_shufflevector(Bt[n], Bt[n], 4, 5, 6, 7)), __builtin_bit_cast(bf16x8, __builtin_shufflevector(At[m], At[m], 4, 5, 6, 7)), _c, 0, 0, 0)); } } \
        __builtin_amdgcn_s_setprio(0); } while (0)
#define PG8_WAIT_V(n) asm volatile("s_waitcnt vmcnt(" #n ")" ::: "memory")
#define PG8_WAIT_L(n) asm volatile("s_waitcnt lgkmcnt(" #n ")" ::: "memory")
#define PG8_BAR __builtin_amdgcn_s_barrier()
#define PG8_SCHED __builtin_amdgcn_sched_barrier(0)
    Unit cur, nxt; int ui = 0; int pkey = 0;
    if (!S.next(0, cur)) return;
    S.a_ready(cur, wid);
    if constexpr (GATHER) {
#pragma unroll
        for (int i = 0; i < 2; ++i) { int R, C; int t2 = tid; asm volatile("" : "+v"(t2)); stage_rc(t2 * 16 + i * 8192, R, C);
            const unsigned r0 = S.row_tok(cur, R), r1 = S.row_tok(cur, HALF + R); *gro(0, i) = r0; *gro(0, 2 + i) = r1;
            cA0[i] = r0 + (unsigned)C * 2u; cA1[i] = r1 + (unsigned)C * 2u; }
    }
    typedef float f32x8_ __attribute__((ext_vector_type(8)));
    f32x8_ acc[2][2][4];
    float zero_; asm volatile("v_mov_b32 %0, 0" : "=v"(zero_));
#pragma unroll
    for (int a = 0; a < 2; ++a)
#pragma unroll
        for (int b = 0; b < 2; ++b)
#pragma unroll
            for (int m = 0; m < 4; ++m) acc[a][b][m] = (f32x8_){zero_, zero_, zero_, zero_, zero_, zero_, zero_, zero_};
    i32x8 At[4], B0[2], B1[2];
    const char* cA = cur.A; const char* cB = cur.B;
    if constexpr (Epi::LDS_BIAS) E.stage_bias(cur, lds + LDS_BIAS, wid, lane);
    if constexpr (SP2) {
        PG8_STAGE(PG8_SB(0, 0), cB, voffB); PG8_STAGE(PG8_SB(0, 1), cB + hstep, voffB); PG8_STAGE(PG8_SA(0, 0), cA, cA0); PG8_STAGE(PG8_SA(0, 1), cA, cA1);
        if (wr == 1) PG8_BAR;
        PG8_WAIT_V(2); PG8_BAR;
        PG8_STAGE(PG8_SB(1, 0), cB + kstepB, voffB); PG8_STAGE(PG8_SA(1, 0), cA + kstep, cA0); PG8_STAGE(PG8_SB(1, 1), cB + hstep + kstepB, voffB);
        PG8_WAIT_V(6); PG8_BAR;
    } else {
        PG8_STAGE(PG8_SB(0, 0), cB, voffB); PG8_STAGE(PG8_SA(0, 0), cA, cA0); PG8_STAGE(PG8_SB(0, 1), cB + hstep, voffB); PG8_STAGE(PG8_SA(0, 1), cA, cA1);
        if (wr == 1) PG8_BAR;
        PG8_WAIT_V(4); PG8_BAR;
        PG8_STAGE(PG8_SB(1, 0), cB + kstepB, voffB); PG8_STAGE(PG8_SA(1, 0), cA + kstep, cA0); PG8_STAGE(PG8_SB(1, 1), cB + hstep + kstepB, voffB);
        PG8_WAIT_V(6); PG8_BAR;
    }
    for (;;) {
        const bool has_next = S.next(ui + 1, nxt);
        const char* nA = has_next ? nxt.A : cA; const char* nB = has_next ? nxt.B : cB;
        if constexpr (GATHER) {
            if (has_next) {
                int R0, C0, R1, C1; int t2 = tid; asm volatile("" : "+v"(t2)); stage_rc(t2 * 16, R0, C0); stage_rc(t2 * 16 + 8192, R1, C1);
                LAS unsigned char* gb = lds + LDS_GOFF + (gp ^ 1) * 8192 + wid * 256;
                __builtin_amdgcn_global_load_lds((const unsigned*)S.row_src(nxt, R0), (LAS unsigned*)(gb), 4, 0, 0);
                __builtin_amdgcn_global_load_lds((const unsigned*)S.row_src(nxt, R1), (LAS unsigned*)(gb + 2048), 4, 0, 0);
                __builtin_amdgcn_global_load_lds((const unsigned*)S.row_src(nxt, HALF + R0), (LAS unsigned*)(gb + 4096), 4, 0, 0);
                __builtin_amdgcn_global_load_lds((const unsigned*)S.row_src(nxt, HALF + R1), (LAS unsigned*)(gb + 6144), 4, 0, 0);
            }
        }
#pragma unroll 1
        for (int t = 0; t < nt; t += 2) {
            const bool last = (t == nt - 2);
            if (last && has_next) S.a_ready(nxt, wid);
            const char* a1 = cA + (size_t)(t + 1) * kstep;
            const char* a2 = last ? nA : cA + (size_t)(t + 2) * kstep; const char* b2 = last ? nB : cB + (size_t)(t + 2) * kstepB;
            const char* a3 = a2 + kstep; const char* b3 = b2 + kstepB;
            const int gq = (last && has_next) ? (gp ^ 1) : gp;
#define PG8_GO(p, v, dst) unsigned dst[2]; if constexpr (GATHER) { dst[0] = *gro(p, v) + gcc[0]; dst[1] = *gro(p, (v) + 1) + gcc[1]; } else { dst[0] = ((v) ? cA1 : cA0)[0]; dst[1] = ((v) ? cA1 : cA0)[1]; }
            if constexpr (SP2) {
            { PG8_GO(gp, 2, y1); PG8_LDB(B0, 0, 0); PG8_LDB(B1, 0, 1); PG8_SCHED; PG8_LDA(At, 0, 0); PG8_STAGE(PG8_SA(1, 1), a1, y1); }
            PG8_WAIT_V(8); PG8_WAIT_L(0); PG8_BAR; PG8_MMA(0, 0, At, B0); PG8_MMA(0, 1, At, B1); PG8_BAR; PG8_SCHED;
            { PG8_GO(gq, 0, x0); PG8_LDA(At, 0, 1); PG8_STAGE(PG8_SB(0, 0), b2, voffB); PG8_STAGE(PG8_SB(0, 1), b2 + hstep, voffB); PG8_STAGE(PG8_SA(0, 0), a2, x0); }
            PG8_WAIT_V(8); PG8_WAIT_L(0); PG8_BAR; PG8_MMA(1, 0, At, B0); PG8_MMA(1, 1, At, B1); PG8_BAR; PG8_SCHED;
            { PG8_GO(gq, 2, x1); PG8_LDB(B0, 1, 0); PG8_LDB(B1, 1, 1); PG8_SCHED; PG8_LDA(At, 1, 0); PG8_STAGE(PG8_SA(0, 1), a2, x1); }
            PG8_WAIT_V(8); PG8_WAIT_L(0); PG8_BAR; PG8_MMA(0, 0, At, B0); PG8_MMA(0, 1, At, B1); PG8_BAR; PG8_SCHED;
            { PG8_GO(gq, 0, x0); PG8_LDA(At, 1, 1); PG8_STAGE(PG8_SB(1, 0), b3, voffB); PG8_STAGE(PG8_SB(1, 1), b3 + hstep, voffB); PG8_STAGE(PG8_SA(1, 0), a3, x0); }
            PG8_WAIT_V(8); PG8_WAIT_L(0); PG8_BAR; PG8_MMA(1, 0, At, B0); PG8_MMA(1, 1, At, B1); PG8_BAR; PG8_SCHED;
            } else {
            PG8_GO(gp, 2, y1); PG8_GO(gq, 0, x0); PG8_GO(gq, 2, x1);
            PG8_LDB(B0, 0, 0); PG8_SCHED; PG8_LDA(At, 0, 0); PG8_STAGE(PG8_SA(1, 1), a1, y1);
            PG8_WAIT_L(8); PG8_BAR; PG8_WAIT_L(0); PG8_MMA(0, 0, At, B0); PG8_BAR; PG8_SCHED;
            PG8_LDB(B1, 0, 1); PG8_STAGE(PG8_SB(0, 0), b2, voffB);
            PG8_BAR; PG8_WAIT_L(0); PG8_MMA(0, 1, At, B1); PG8_BAR;
            PG8_LDA(At, 0, 1); PG8_STAGE(PG8_SA(0, 0), a2, x0);
            PG8_BAR; PG8_WAIT_L(0); PG8_MMA(1, 0, At, B0); PG8_BAR; PG8_SCHED;
            PG8_STAGE(PG8_SB(0, 1), b2 + hstep, voffB);
            PG8_WAIT_V(6); PG8_BAR; PG8_MMA(1, 1, At, B1); PG8_BAR;
            PG8_LDB(B0, 1, 0); PG8_SCHED; PG8_LDA(At, 1, 0); PG8_STAGE(PG8_SA(0, 1), a2, x1);
            PG8_WAIT_L(8); PG8_BAR; PG8_WAIT_L(0); PG8_MMA(0, 0, At, B0); PG8_BAR; PG8_SCHED;
            PG8_LDB(B1, 1, 1); PG8_STAGE(PG8_SB(1, 0), b3, voffB);
            PG8_BAR; PG8_WAIT_L(0); PG8_MMA(0, 1, At, B1); PG8_BAR;
            PG8_LDA(At, 1, 1); PG8_STAGE(PG8_SA(1, 0), a3, x0);
            PG8_BAR; PG8_WAIT_L(0); PG8_MMA(1, 0, At, B0); PG8_BAR; PG8_SCHED;
            PG8_STAGE(PG8_SB(1, 1), b3 + hstep, voffB);
            PG8_WAIT_V(6); PG8_BAR; PG8_MMA(1, 1, At, B1); PG8_BAR;
            }
        }
        if constexpr (ALIGN_EPI) { if (wr == 0) PG8_BAR; }
        asm volatile("" ::: "memory");
        if constexpr (Sched::PUBLISH) { if (ui > 0) S.publish(pkey); }
        { f32x4 av[2][2][4][2];
#pragma unroll
          for (int a = 0; a < 2; ++a)
#pragma unroll
              for (int b = 0; b < 2; ++b)
#pragma unroll
                  for (int m = 0; m < 4; ++m) { av[a][b][m][0] = PG8_ACC(a, b, m, 0); av[a][b][m][1] = PG8_ACC(a, b, m, 1); }
          int t3 = tid; asm volatile("" : "+v"(t3)); const int fr3 = t3 & 15, fq3 = (t3 & 63) >> 4;
          if constexpr (Epi::LDS_BIAS) E(av, cur, wr, wc, fr3, fq3, lds + LDS_BIAS + (ui & 1) * 1024); else E(av, cur, wr, wc, fr3, fq3); }
        if constexpr (Sched::PUBLISH) { pkey = S.key(cur); if (!has_next) S.publish(pkey); }
        if (!has_next) break;
#pragma unroll
        for (int a = 0; a < 2; ++a)
#pragma unroll
            for (int b = 0; b < 2; ++b)
#pragma unroll
                for (int m = 0; m < 4; ++m) acc[a][b][m] = (f32x8_){zero_, zero_, zero_, zero_, zero_, zero_, zero_, zero_};
        cur = nxt; cA = nA; cB = nB; ++ui;
        if constexpr (Epi::LDS_BIAS) E.stage_bias(cur, lds + LDS_BIAS + (ui & 1) * 1024, wid, lane);
        if constexpr (GATHER) gp ^= 1;
        if constexpr (ALIGN_EPI) { if (wr == 1) PG8_BAR; }
    }
    PG8_WAIT_V(0);
    if constexpr (!ALIGN_EPI) { if (wr == 0) PG8_BAR; }
    PG8_BAR;
#undef PG8_SA
#undef PG8_SB
#undef PG8_STAGE
#undef PG8_LDA
#undef PG8_LDB
#undef PG8_MMA
#undef gro
#undef PG8_GO
#undef PG8_ACC
#undef PG8_SETACC
#undef PG8_WAIT_V
#undef PG8_WAIT_L
#undef PG8_BAR
#undef PG8_SCHED
}
}

struct EpiInProj {
    static constexpr bool PERM = true, LDS_BIAS = false;
    bf16_t* P; const float* lbl; bf16_t* U; const float* gain;
    __device__ __forceinline__ void operator()(const f32x4 (&acc)[2][2][4][2], const pg8::UnitS& u, int wr, int wc, int fr, int fq) const {
        typedef float f32x2 __attribute__((ext_vector_type(2)));
        const int row0 = u.pm * 256 + wr * 64 + fr, col0 = u.pn * 256 + wc * 32 + 8 * fq, type = u.pn >> 1;
        f32x2 lbv[2][4], olb[2][4];
#pragma unroll
        for (int bj = 0; bj < 2; ++bj)
#pragma unroll
            for (int p = 0; p < 4; ++p) { lbv[bj][p] = (f32x2){0.f, 0.f}; olb[bj][p] = (f32x2){1.f, 1.f}; }
        if (type == 4) {
#pragma unroll
            for (int bj = 0; bj < 2; ++bj) { const int ch = col0 + bj * 128 - 2048;
#pragma unroll
                for (int p = 0; p < 4; ++p) { lbv[bj][p].x = gain[ch + 2 * p]; lbv[bj][p].y = gain[ch + 2 * p + 1]; } }
        }
        if (type == 1 || type == 2) {
#pragma unroll
            for (int bj = 0; bj < 2; ++bj) { const int ch = col0 + bj * 128 - 512;
#pragma unroll
                for (int p = 0; p < 4; ++p) { lbv[bj][p].x = sigmoidf_(lbl[ch + 2 * p] - lbl[1024 + ch + 2 * p]); lbv[bj][p].y = sigmoidf_(lbl[ch + 2 * p + 1] - lbl[1024 + ch + 2 * p + 1]); olb[bj][p] = 1.0f - lbv[bj][p]; } }
        }
#pragma unroll
        for (int ai = 0; ai < 2; ++ai)
#pragma unroll
            for (int m = 0; m < 4; ++m) { bf16_t* rowp = P + (size_t)(row0 + ai * 128 + m * 16) * NIN + col0;
#pragma unroll
                for (int bj = 0; bj < 2; ++bj) { f32x2 v[4];
#pragma unroll
                    for (int p = 0; p < 4; ++p) { const f32x4 a = acc[ai][bj][m][p >> 1]; v[p] = (p & 1) ? (f32x2){a.z, a.w} : (f32x2){a.x, a.y}; }
                    if (type == 0 || type == 1 || type == 2 || type == 4) {
#pragma unroll
                        for (int p = 0; p < 4; ++p) { const f32x2 ea = v[p] * (-1.44269504089f);
                            f32x2 t; t.x = __builtin_amdgcn_exp2f(ea.x); t.y = __builtin_amdgcn_exp2f(ea.y); t = t + 1.0f;
                            f32x2 sg; sg.x = __builtin_amdgcn_rcpf(t.x); sg.y = __builtin_amdgcn_rcpf(t.y);
                            if (type == 0) v[p] = v[p] * sg;
                            else if (type == 4) v[p] = sg * lbv[bj][p];
                            else { const f32x2 f = sg * olb[bj][p] + lbv[bj][p]; f32x2 lg; lg.x = __builtin_amdgcn_logf(f.x); lg.y = __builtin_amdgcn_logf(f.y); v[p] = lg; } }
                    }
                    u32x4 w; w.x = cvt_pk_bf16(v[0].x, v[0].y); w.y = cvt_pk_bf16(v[1].x, v[1].y); w.z = cvt_pk_bf16(v[2].x, v[2].y); w.w = cvt_pk_bf16(v[3].x, v[3].y);
                    if (type == 5) { const int row = row0 + ai * 128 + m * 16, slab = (col0 + bj * 128 - 2560) >> 3;
                        *(u32x4*)(U + ((size_t)((row >> 12) * 64 + slab) * 4096 + (row & 4095)) * 8) = w; }
                    else *(u32x4*)(rowp + bj * 128) = w; } }
    }
};
struct EpiBf16Out {
    static constexpr bool PERM = true, LDS_BIAS = false;
    bf16_t* C; int ldc;
    __device__ __forceinline__ void operator()(const f32x4 (&acc)[2][2][4][2], const pg8::UnitS& u, int wr, int wc, int fr, int fq) const {
        const int row0 = u.pm * 256 + wr * 64 + fr, col0 = u.pn * 256 + wc * 32 + 8 * fq;
#pragma unroll
        for (int ai = 0; ai < 2; ++ai)
#pragma unroll
            for (int m = 0; m < 4; ++m) { bf16_t* rowp = C + (size_t)(row0 + ai * 128 + m * 16) * ldc + col0;
#pragma unroll
                for (int bj = 0; bj < 2; ++bj) { const f32x4 v0 = acc[ai][bj][m][0], v1 = acc[ai][bj][m][1];
                    u32x4 w; w.x = cvt_pk_bf16(v0[0], v0[1]); w.y = cvt_pk_bf16(v0[2], v0[3]); w.z = cvt_pk_bf16(v1[0], v1[1]); w.w = cvt_pk_bf16(v1[2], v1[3]);
                    *(u32x4*)(rowp + bj * 128) = w; } }
    }
};

struct UnitM { const char* A; const char* B; int e, mt, pn, row0, cnt; };
typedef int i32x4_ __attribute__((ext_vector_type(4)));
template <int NT_, bool GATHER_>
struct MoeOrder {
    typedef UnitM Unit;
    static constexpr int pitch = 1024; static constexpr size_t wstride = (size_t)NT_ * 256 * 1024;
    const LAS int* tab;
    const char* Abase; const char* Wbase; const int* rtok;
    unsigned* mtc;
    int cls, rank, nrank;
    static constexpr bool PUBLISH = GATHER_;
    __device__ __forceinline__ int key(const Unit& u) const { return u.row0 >> 8; }
    __device__ __forceinline__ void publish(int k) const {
        asm volatile("s_waitcnt vmcnt(0)" ::: "memory");
        if ((threadIdx.x & 63) == 0) __hip_atomic_fetch_add(mtc + 64 * k, 1u, __ATOMIC_RELAXED, __HIP_MEMORY_SCOPE_AGENT);
    }
    __device__ __forceinline__ void a_ready(const Unit& u, int wid) const {
        if constexpr (!GATHER_) {
            if (wid == 0) { unsigned sp = 0;
                while ((unsigned)__builtin_amdgcn_readfirstlane(__hip_atomic_load(mtc + 64 * (u.row0 >> 8), __ATOMIC_RELAXED, __HIP_MEMORY_SCOPE_AGENT)) < 64u) { __builtin_amdgcn_s_sleep(2); if (++sp > (1u << 22)) break; }
                __builtin_amdgcn_fence(__ATOMIC_ACQUIRE, "agent");
                asm volatile("s_waitcnt vmcnt(0)" ::: "memory"); }
            asm volatile("" ::: "memory"); __builtin_amdgcn_s_barrier(); asm volatile("" ::: "memory");
        }
    }
    __device__ bool next(int i, Unit& u) const {
        const int L = i * nrank + rank; const int mtg = L / NT_; u.pn = L - mtg * NT_;
        if (mtg >= __builtin_amdgcn_readfirstlane(tab[64])) return false;
        int ecount = 0;
#pragma unroll
        for (int q = 0; q < 8; ++q) { const i32x4_ p4 = *(const LAS i32x4_*)(tab + 32 + 4 * q); const int row = mtg * 256;
            ecount += (p4.x <= row) + (p4.y <= row) + (p4.z <= row) + (p4.w <= row); }
        const int e = __builtin_amdgcn_readfirstlane(ecount) - 1;
        const int pb = __builtin_amdgcn_readfirstlane(tab[32 + e]);
        u.e = e; u.mt = mtg - (pb >> 8); u.cnt = __builtin_amdgcn_readfirstlane(tab[e]); u.row0 = mtg * 256;
        u.B = Wbase + (size_t)e * wstride + (size_t)u.pn * 256 * pitch;
        u.A = GATHER_ ? Abase : Abase + (size_t)u.row0 * pitch;
        return true;
    }
    __device__ __forceinline__ const int* row_src(const Unit& u, int r) const { const int slot = u.mt * 256 + r; return rtok + u.e * ECAP + (slot < u.cnt ? slot : 0); }
    __device__ __forceinline__ unsigned row_tok(const Unit& u, int r) const { return (unsigned)*row_src(u, r); }
};
struct EpiGateUp {
    static constexpr bool PERM = true, LDS_BIAS = true;
    unsigned char* H; const float* bg; const float* bu;
    __device__ __forceinline__ void stage_bias(const UnitM& u, LAS unsigned char* dst, int wid, int lane) const {
        if (wid < 4) { const float* src = ((wid & 2) ? bu : bg) + u.e * FF + u.pn * 128 + (wid & 1) * 64 + lane;
            __builtin_amdgcn_global_load_lds((const unsigned*)src, (LAS unsigned*)(dst + wid * 256), 4, 0, 0); }
    }
    __device__ __forceinline__ void operator()(const f32x4 (&acc)[2][2][4][2], const UnitM& u, int wr, int wc, int fr, int fq, const LAS unsigned char* lb) const {
        typedef float f32x2 __attribute__((ext_vector_type(2)));
        const int row0 = u.row0 + wr * 64 + fr, col0 = u.pn * 128 + wc * 32 + 8 * fq;
        const f32x4 g0 = *(const LAS f32x4*)(lb + (wc * 32 + 8 * fq) * 4), g1 = *(const LAS f32x4*)(lb + (wc * 32 + 8 * fq + 4) * 4);
        const f32x4 u0 = *(const LAS f32x4*)(lb + 512 + (wc * 32 + 8 * fq) * 4), u1 = *(const LAS f32x4*)(lb + 512 + (wc * 32 + 8 * fq + 4) * 4);
        const f32x2 gb[4] = {{g0.x, g0.y}, {g0.z, g0.w}, {g1.x, g1.y}, {g1.z, g1.w}}, ub[4] = {{u0.x + 1.0f, u0.y + 1.0f}, {u0.z + 1.0f, u0.w + 1.0f}, {u1.x + 1.0f, u1.y + 1.0f}, {u1.z + 1.0f, u1.w + 1.0f}};
        unsigned pw0 = 0u, pw1 = 0u;
#pragma unroll
        for (int ai = 0; ai < 2; ++ai)
#pragma unroll
            for (int m = 0; m < 4; ++m) { f32x2 h[4];
#pragma unroll
                for (int p = 0; p < 4; ++p) {
                    const f32x4 ag = acc[ai][0][m][p >> 1], au = acc[ai][1][m][p >> 1];
                    f32x2 g = (p & 1) ? (f32x2){ag.z, ag.w} : (f32x2){ag.x, ag.y}, up1 = (p & 1) ? (f32x2){au.z, au.w} : (f32x2){au.x, au.y};
                    g = g * WSCALE_INV + gb[p]; up1 = up1 * WSCALE_INV + ub[p];
                    g.x = fminf(g.x, 7.0f); g.y = fminf(g.y, 7.0f);
                    up1.x = __builtin_amdgcn_fmed3f(up1.x, -6.0f, 8.0f); up1.y = __builtin_amdgcn_fmed3f(up1.y, -6.0f, 8.0f);
                    const f32x2 ea = g * (-1.702f * 1.44269504089f);
                    f32x2 t; t.x = __builtin_amdgcn_exp2f(ea.x); t.y = __builtin_amdgcn_exp2f(ea.y);
                    t = t + 1.0f;
                    f32x2 sg; sg.x = __builtin_amdgcn_rcpf(t.x); sg.y = __builtin_amdgcn_rcpf(t.y);
                    h[p] = (up1 * g) * sg; }
                const unsigned w0 = pk4_fp8(h[0].x, h[0].y, h[1].x, h[1].y), w1 = pk4_fp8(h[2].x, h[2].y, h[3].x, h[3].y);
                if ((m & 1) == 0) { pw0 = w0; pw1 = w1; }
                else { const auto r0 = __builtin_amdgcn_permlane16_swap(pw0, w0, false, false), r1 = __builtin_amdgcn_permlane16_swap(pw1, w1, false, false);
                    u32x4 wv; wv.x = r0[0]; wv.y = r1[0]; wv.z = r0[1]; wv.w = r1[1];
                    const unsigned long long ad = (unsigned long long)(H + (size_t)(row0 + ai * 128 + (m - 1 + (fq & 1)) * 16) * FF + col0 - 8 * (fq & 1));
                    asm volatile("global_store_dwordx4 %0, %1, off sc1\n\ts_nop 2" :: "v"(ad), "v"(wv) : "memory"); } }
    }
};
struct EpiDown {
    static constexpr bool PERM = true, LDS_BIAS = true;
    unsigned char* Y; const float* bd;
    __device__ __forceinline__ void stage_bias(const UnitM& u, LAS unsigned char* dst, int wid, int lane) const {
        if (wid < 4) { const float* src = bd + u.e * D + u.pn * 256 + wid * 64 + lane;
            __builtin_amdgcn_global_load_lds((const unsigned*)src, (LAS unsigned*)(dst + wid * 256), 4, 0, 0); }
    }
    __device__ __forceinline__ void operator()(const f32x4 (&acc)[2][2][4][2], const UnitM& u, int wr, int wc, int fr, int fq, const LAS unsigned char* lb) const {
        const int row0 = u.row0 + wr * 64 + fr, col0 = u.pn * 256 + wc * 32 + 8 * fq;
        f32x4 b8[2][2];
#pragma unroll
        for (int bj = 0; bj < 2; ++bj) { b8[bj][0] = *(const LAS f32x4*)(lb + (bj * 128 + wc * 32 + 8 * fq) * 4); b8[bj][1] = *(const LAS f32x4*)(lb + (bj * 128 + wc * 32 + 8 * fq + 4) * 4); }
        u32x2 pw[2];
#pragma unroll
        for (int ai = 0; ai < 2; ++ai)
#pragma unroll
            for (int m = 0; m < 4; ++m)
#pragma unroll
                for (int bj = 0; bj < 2; ++bj) { const f32x4 v0 = acc[ai][bj][m][0] * WSCALE_INV + b8[bj][0], v1 = acc[ai][bj][m][1] * WSCALE_INV + b8[bj][1];
                    u32x2 w; w.x = pk4_fp8(v0.x, v0.y, v0.z, v0.w); w.y = pk4_fp8(v1.x, v1.y, v1.z, v1.w);
                    if ((m & 1) == 0) pw[bj] = w;
                    else { const auto r0 = __builtin_amdgcn_permlane16_swap(pw[bj].x, w.x, false, false), r1 = __builtin_amdgcn_permlane16_swap(pw[bj].y, w.y, false, false);
                        u32x4 wv; wv.x = r0[0]; wv.y = r1[0]; wv.z = r0[1]; wv.w = r1[1];
                        *(u32x4*)(Y + (size_t)(row0 + ai * 128 + (m - 1 + (fq & 1)) * 16) * D + col0 - 8 * (fq & 1) + bj * 128) = wv; } }
    }
};

struct Args { const float* in[24]; float* out; unsigned char* ws; int ph_lo, ph_hi, li, pad; };
struct Frame {
    LAS unsigned char* lds; unsigned char* ws; unsigned* ctl;
    int tid, lane, wave, G, bid;
};

struct TItem { const float* src; unsigned char* dst; int ldw, k0, n0, drow0; };
template <int NL> __device__ __forceinline__ void titem_load(const TItem& t, float (&tv)[NL], int lane) {
    const float* wp = t.src + (size_t)(t.k0 + (lane >> 5)) * t.ldw + t.n0 + (lane & 31);
#pragma unroll
    for (int i = 0; i < NL; ++i) tv[i] = wp[(size_t)(2 * i) * t.ldw];
}
__device__ __forceinline__ void titem_finish_bf16(const TItem& t, const float (&tv)[32], LAS float* scr, int lane) {
#pragma unroll
    for (int i = 0; i < 32; ++i) scr[(2 * i + (lane >> 5)) * 33 + (lane & 31)] = tv[i];
    LDS_WAIT(); asm volatile("" ::: "memory");
    const int c = lane & 7;
#pragma unroll
    for (int j = 0; j < 4; ++j) { const int n = (lane >> 3) + 8 * j; const LAS float* s = scr + (8 * c) * 33 + n;
        u32x4 o; o.x = cvt_pk_bf16(s[0 * 33], s[1 * 33]); o.y = cvt_pk_bf16(s[2 * 33], s[3 * 33]); o.z = cvt_pk_bf16(s[4 * 33], s[5 * 33]); o.w = cvt_pk_bf16(s[6 * 33], s[7 * 33]);
        *(u32x4*)(t.dst + ((size_t)(t.drow0 + n) * 1024 + t.k0 + 8 * c) * 2) = o; }
    LDS_WAIT(); asm volatile("" ::: "memory");
}
__device__ __forceinline__ void titem_load_fp8(const TItem& t, f32x4 (&tv)[16], int lane) {
    const float* wp = t.src + (size_t)(t.k0 + (lane >> 3)) * t.ldw + t.n0 + 4 * (lane & 7);
#pragma unroll
    for (int i = 0; i < 16; ++i) tv[i] = __builtin_nontemporal_load((const f32x4*)(wp + (size_t)(8 * i) * t.ldw));
}
__device__ __forceinline__ void titem_finish_fp8(const TItem& t, const f32x4 (&tv)[16], LAS float* scr, int lane) {
#pragma unroll
    for (int i = 0; i < 16; ++i) { const int row = 8 * i + (lane >> 3); *(LAS f32x4*)(scr + row * 32 + ((4 * (lane & 7)) ^ ((8 * (row >> 4)) & 31))) = tv[i] * WSCALE; }
    LDS_WAIT(); asm volatile("" ::: "memory");
    const int c = lane & 7;
#pragma unroll
    for (int j = 0; j < 4; ++j) { const int n = (lane >> 3) + 8 * j; const LAS float* s = scr + (16 * c) * 32 + (n ^ ((8 * c) & 31));
        u32x4 o; o.x = pk4_fp8(s[0 * 32], s[1 * 32], s[2 * 32], s[3 * 32]); o.y = pk4_fp8(s[4 * 32], s[5 * 32], s[6 * 32], s[7 * 32]);
        o.z = pk4_fp8(s[8 * 32], s[9 * 32], s[10 * 32], s[11 * 32]); o.w = pk4_fp8(s[12 * 32], s[13 * 32], s[14 * 32], s[15 * 32]);
        __builtin_nontemporal_store(o, (u32x4*)(t.dst + (size_t)(t.drow0 >> 5) * 32768 + (size_t)(t.k0 >> 7) * 4096 + n * 128 + 16 * c)); }
    LDS_WAIT(); asm volatile("" ::: "memory");
}
constexpr int TI_IN = 16 * 96, TI_OUT = 8 * 32, TI_E = 8 * 32, TI_EALL = NE * 3 * TI_E;
constexpr int TSCR = 16384;
__device__ __forceinline__ void transpose_items_bf16(const Frame& F, const Args& a, int gw, int NGW, int it0, int it1) {
    const float* w_in = a.in[10]; const float* w_out = a.in[11];
    LAS float* scr = (LAS float*)(F.lds + F.wave * TSCR);
    for (int it = it0 + gw; it < it1; it += NGW) {
        TItem t; float tv[32];
        if (it < TI_IN) { const int kb = it / 96, nb = it % 96; t = TItem{w_in, F.ws + WS_WIN, NIN, kb * 64, nb * 32, nb * 32}; }
        else { const int r = it - TI_IN, kb = r / 32, nb = r % 32; t = TItem{w_out, F.ws + WS_WOUT, 1024, kb * 64, nb * 32, nb * 32}; }
        titem_load<32>(t, tv, F.lane); titem_finish_bf16(t, tv, scr, F.lane);
    }
}
__device__ __forceinline__ void transpose_items_fp8(const Frame& F, const Args& a, int gw, int NGW, int k0, int k1) {
    const float* w_gate = a.in[18]; const float* w_up = a.in[20]; const float* w_down = a.in[22];
    unsigned char* WGU = F.ws + WS_WGU; unsigned char* WDN = F.ws + WS_WDN;
    LAS float* scr = (LAS float*)(F.lds + F.wave * TSCR);
    auto decode = [&](int r, TItem& t) {
        const int e = r / (3 * TI_E), r2 = r % (3 * TI_E), mat = r2 / TI_E, r3 = r2 % TI_E, kb = r3 / 32, nb = r3 % 32, n0 = nb * 32;
        if (mat == 2) t = TItem{w_down + (size_t)e * 1048576, WDN + (size_t)e * 1048576, 1024, kb * 128, n0, n0};
        else t = TItem{(mat == 0 ? w_gate : w_up) + (size_t)e * 1048576, WGU + (size_t)e * 2097152, 1024, kb * 128, n0, 256 * (n0 >> 7) + mat * 128 + (n0 & 127)};
    };
    for (int k = k0; k < k1; ++k) { const int it = gw + k * NGW; if (it >= TI_EALL) break;
        TItem t; f32x4 tv[16]; decode(it, t); titem_load_fp8(t, tv, F.lane); titem_finish_fp8(t, tv, scr, F.lane); }
}
__device__ __forceinline__ void p0_prologue(const Frame& F, const Args& a) {
    const float* c = a.in[1]; const float* c_ctx = a.in[3]; const float* w_ada = a.in[4]; const float* b_ada = a.in[5];
    const float* w_out = a.in[11]; const float* pool_w = a.in[14]; const float* pool_scale = a.in[15];
    bf16_t* WOUT = (bf16_t*)(F.ws + WS_WOUT);
    float* mod = (float*)(F.ws + WS_MOD);
    if (F.bid < 192) {
        LAS float* s = (LAS float*)F.lds;
        LAS float* red = (LAS float*)(F.lds + 20480);
        const int kq = F.tid >> 5, col = F.tid & 31, j = F.bid * 32 + col;
        float w[64];
#pragma unroll
        for (int kk = 0; kk < 64; ++kk) w[kk] = __builtin_nontemporal_load(w_ada + (size_t)(kq * 64 + kk) * 6144 + j);
        { float t[10];
#pragma unroll
          for (int q = 0; q < 10; ++q) { const int i = F.tid + q * 512, r = i >> 10, k = i & 1023; t[q] = (r < 4) ? c[r * 1024 + k] : c_ctx[k]; }
#pragma unroll
          for (int q = 0; q < 10; ++q) s[F.tid + q * 512] = t[q] * sigmoidf_(t[q]); }
        __syncthreads();
        float acc[5] = {0.f, 0.f, 0.f, 0.f, 0.f};
#pragma unroll
        for (int kk = 0; kk < 64; ++kk) { const int k = kq * 64 + kk;
#pragma unroll
            for (int r = 0; r < 5; ++r) acc[r] += s[r * 1024 + k] * w[kk]; }
#pragma unroll
        for (int r = 0; r < 5; ++r) red[(kq * 5 + r) * 32 + col] = acc[r];
        __syncthreads();
        if (F.tid < 160) { const int r = F.tid >> 5, cc = F.tid & 31; float t = b_ada[F.bid * 32 + cc];
#pragma unroll
            for (int q = 0; q < 16; ++q) t += red[(q * 5 + r) * 32 + cc];
            mod[r * 6144 + F.bid * 32 + cc] = t; }
        asm volatile("s_waitcnt vmcnt(0)" ::: "memory");
        __syncthreads();
        if (F.tid == 0) { __builtin_amdgcn_fence(__ATOMIC_RELEASE, "agent"); asm volatile("s_waitcnt vmcnt(0)" ::: "memory");
            __hip_atomic_fetch_add(F.ctl + CW_MOD, 1u, __ATOMIC_RELAXED, __HIP_MEMORY_SCOPE_AGENT); }
    }
    __syncthreads();
    transpose_items_bf16(F, a, F.bid * 8 + F.wave, F.G * 8, 0, TI_IN);
}
__device__ __forceinline__ void p0_late(const Frame& F, const Args& a) {
    const float* w_out = a.in[11]; const float* pool_w = a.in[14]; const float* pool_scale = a.in[15];
    bf16_t* WOUT = (bf16_t*)(F.ws + WS_WOUT);
    if (F.bid >= 128 && F.bid < 256) {
        const int un = F.bid - 128, gi = un >> 5, nb = un & 31;
        LAS float* pw = (LAS float*)F.lds;
        LAS float* wo = (LAS float*)(F.lds + 128 * 129 * 4);
        { float t[32]; const float sc = pool_scale[gi * 128 + (F.tid & 127)];
#pragma unroll
          for (int q = 0; q < 32; ++q) t[q] = pool_w[(size_t)gi * 16384 + F.tid + q * 512];
#pragma unroll
          for (int q = 0; q < 32; ++q) { const int i = F.tid + q * 512; pw[(i >> 7) * 129 + (i & 127)] = t[q] * sc; }
          float u[8];
#pragma unroll
          for (int q = 0; q < 8; ++q) { const int i = F.tid + q * 512; u[q] = w_out[(size_t)(512 + gi * 128 + (i >> 5)) * 1024 + nb * 32 + (i & 31)]; }
#pragma unroll
          for (int q = 0; q < 8; ++q) wo[F.tid + q * 512] = u[q]; }
        __syncthreads();
        const int n = F.tid & 31, cq = F.tid >> 5;
        float acc[8] = {0.f, 0.f, 0.f, 0.f, 0.f, 0.f, 0.f, 0.f};
        for (int j = 0; j < 128; ++j) { const float b = wo[j * 32 + n];
#pragma unroll
            for (int i = 0; i < 8; ++i) acc[i] += pw[(cq * 8 + i) * 129 + j] * b; }
        u32x4 o; o.x = cvt_pk_bf16(acc[0], acc[1]); o.y = cvt_pk_bf16(acc[2], acc[3]); o.z = cvt_pk_bf16(acc[4], acc[5]); o.w = cvt_pk_bf16(acc[6], acc[7]);
        *(u32x4*)(WOUT + (size_t)(nb * 32 + n) * 1024 + 512 + gi * 128 + cq * 8) = o;
        __syncthreads();
    }
    if (F.bid >= 32 && F.bid < 40) {
        const float* w_router = a.in[16]; bf16_t* WRH = (bf16_t*)(F.ws + WS_WRH); bf16_t* WRL = (bf16_t*)(F.ws + WS_WRL);
        for (int i = (F.bid - 32) * 512 + F.tid; i < 32768; i += 8 * 512) { const int k = i >> 5, e = i & 31; const float w = w_router[i];
            const unsigned short hi = f2bf(w); WRH[e * 1024 + k] = hi; WRL[e * 1024 + k] = f2bf(w - bf2f(hi)); }
    }
    __syncthreads();
    transpose_items_bf16(F, a, F.bid * 8 + F.wave, F.G * 8, TI_IN, TI_IN + TI_OUT);
    __syncthreads();
}

__device__ __forceinline__ void p1_normmod(const Frame& F, const Args& a, unsigned need) {
    const float* x = a.in[0]; const float* ctx = a.in[2]; const float* g = a.in[6];
    const float* mod = (const float*)(F.ws + WS_MOD); bf16_t* HX = (bf16_t*)(F.ws + WS_HX);
    const int gw = F.bid * 8 + F.wave;
    auto rowp = [&](int m) { return (m < M) ? x + (size_t)m * D : ctx + (size_t)(m - M) * D; };
    const int NGW = F.G * 8;
    int m0 = gw * 8;
    f32x4 v[4];
    { const float* xr = rowp(m0);
#pragma unroll
      for (int j = 0; j < 4; ++j) v[j] = __builtin_nontemporal_load((const f32x4*)(xr + F.lane * 4 + 256 * j)); }
    if (F.tid == 0) { unsigned sp = 0;
        while (__hip_atomic_load(F.ctl + CW_MOD, __ATOMIC_RELAXED, __HIP_MEMORY_SCOPE_AGENT) < need) { __builtin_amdgcn_s_sleep(2); if (++sp > (1u << 22)) break; }
        __builtin_amdgcn_fence(__ATOMIC_ACQUIRE, "agent"); asm volatile("s_waitcnt vmcnt(0)" ::: "memory"); }
    __syncthreads();
    f32x4 ga[4], hb[4];
    auto ld_par = [&](int mr) { const float* sh = mod + mr * 6144, *sc = sh + 1024;
#pragma unroll
        for (int j = 0; j < 4; ++j) { const int col = F.lane * 4 + 256 * j; ga[j] = *(const f32x4*)(g + col) * (1.0f + *(const f32x4*)(sc + col)); hb[j] = *(const f32x4*)(sh + col); } };
    auto do_row = [&](int m) {
        float s = 0.f;
#pragma unroll
        for (int j = 0; j < 4; ++j) s += (v[j].x * v[j].x + v[j].y * v[j].y) + (v[j].z * v[j].z + v[j].w * v[j].w);
        const float rstd = rsqrtf(wave_sum(s) * (1.f / D) + EPS);
#pragma unroll
        for (int j = 0; j < 4; ++j) { const int col = F.lane * 4 + 256 * j;
            const f32x4 o = v[j] * rstd * ga[j] + hb[j];
            u32x2 w; w.x = cvt_pk_bf16(o.x, o.y); w.y = cvt_pk_bf16(o.z, o.w);
            *(u32x2*)(HX + (size_t)m * D + col) = w; } };
    const bool hasctx = gw < MC;
#pragma unroll 1
    for (; m0 < M; m0 += NGW * 8) {
        const bool lastg = m0 + NGW * 8 >= M;
        ld_par(m0 >> 12);
#pragma unroll 1
        for (int k = 0; k < 8; ++k) {
            const int m = m0 + k, mn = (k < 7) ? m + 1 : (lastg ? (hasctx ? M + gw : m) : m0 + NGW * 8);
            f32x4 vn[4];
            { const float* xr = rowp(mn);
#pragma unroll
              for (int j = 0; j < 4; ++j) vn[j] = __builtin_nontemporal_load((const f32x4*)(xr + F.lane * 4 + 256 * j)); }
            do_row(m);
#pragma unroll
            for (int j = 0; j < 4; ++j) v[j] = vn[j];
        }
    }
    for (int c = gw; c < MC; c += NGW) {
        if (c != gw) { const float* xr = rowp(M + c);
#pragma unroll
            for (int j = 0; j < 4; ++j) v[j] = __builtin_nontemporal_load((const f32x4*)(xr + F.lane * 4 + 256 * j)); }
        ld_par(4); do_row(M + c); }
}

constexpr int G_LF = 0, G_QR = 17408, G_V = 34816, G_Q2 = 52224, G_K2 = 69632, G_ATT = 87040, G_ST = 96256, G_RED = LDS_TAB;
static_assert(G_ST + 128 * 272 <= RING_BYTES, "GLA LDS map");
typedef short s16x4 __attribute__((ext_vector_type(4)));
__device__ __forceinline__ f32x16 mfma32(bf16x8 a, bf16x8 b, f32x16 c) { return __builtin_amdgcn_mfma_f32_32x32x16_bf16(a, b, c, 0, 0, 0); }
__device__ __forceinline__ constexpr int crow0(int reg) { return (reg & 3) + 8 * (reg >> 2); }
__device__ __forceinline__ int opq(int x) { asm volatile("" : "+v"(x)); return x; }
__device__ __forceinline__ unsigned opqu(unsigned x) { asm volatile("" : "+v"(x)); return x; }
__device__ __forceinline__ bf16x8 tr_frag(const LAS unsigned char* img, int trb, int ks, int c) {
    const LAS s16x4* p = (const LAS s16x4*)(img + trb + ks * 16 * 272 + c * 64);
    const s16x4 lo = __builtin_amdgcn_ds_read_tr16_b64_v4i16((LAS s16x4*)p), hi = __builtin_amdgcn_ds_read_tr16_b64_v4i16((LAS s16x4*)(p + 4 * 272 / 8));
    return __builtin_shufflevector(lo, hi, 0, 1, 2, 3, 4, 5, 6, 7);
}
template <int MODE> __device__ __forceinline__ bf16x8 cfrag(int d) {
    u32x4 w;
#pragma unroll
    for (int i = 0; i < 4; ++i) {
        const bool lo = MODE == 0 ? (2 * i <= d) : MODE == 1 ? (2 * i >= d) : MODE == 2 ? (2 * i == d) : true;
        const bool hi = MODE == 0 ? (2 * i + 1 <= d) : MODE == 1 ? (2 * i + 1 >= d) : MODE == 2 ? (2 * i + 1 == d) : true;
        w[i] = (lo ? 0x3F80u : 0u) | (hi ? 0x3F800000u : 0u);
    }
    return __builtin_bit_cast(bf16x8, w);
}
struct RawRegs { u32x4 lf[2], v[2], q[2]; };
template <int DIR, bool WITH_Q>
__device__ __forceinline__ void gla_load_raw(const Frame& F, const bf16_t* P, int row0, int head, RawRegs& R) {
    const bf16_t* rp = P + (size_t)(row0 + (F.tid >> 3)) * NIN + head * 128 + (F.tid & 7) * 16;
    R.lf[0] = *(const u32x4*)(rp + 512 + DIR * 512); R.lf[1] = *(const u32x4*)(rp + 512 + DIR * 512 + 8);
    R.v[0] = *(const u32x4*)(rp + 1536); R.v[1] = *(const u32x4*)(rp + 1536 + 8);
    if (WITH_Q) { R.q[0] = *(const u32x4*)rp; R.q[1] = *(const u32x4*)(rp + 8); }
}
template <bool WITH_Q>
__device__ __forceinline__ void gla_store_raw(const Frame& F, const RawRegs& R) {
    const int o = (F.tid >> 3) * 272 + (F.tid & 7) * 32;
    *(LAS u32x4*)(F.lds + G_LF + o) = R.lf[0]; *(LAS u32x4*)(F.lds + G_LF + o + 16) = R.lf[1];
    *(LAS u32x4*)(F.lds + G_V + o) = R.v[0]; *(LAS u32x4*)(F.lds + G_V + o + 16) = R.v[1];
    if (WITH_Q) { *(LAS u32x4*)(F.lds + G_QR + o) = R.q[0]; *(LAS u32x4*)(F.lds + G_QR + o + 16) = R.q[1]; }
}
template <int DIR, bool WITH_Q>
__device__ __forceinline__ void gla_stage1(const Frame& F, int trb, float (&eh)[16], float* tsum) {
    const int cb = F.wave >> 1, tb = F.wave & 1, l31 = F.lane & 31, lh = F.lane >> 5;
    f32x16 b, T;
#pragma unroll
    for (int r = 0; r < 16; ++r) { b[r] = 0.f; T[r] = 0.f; }
    const u32x4 ones4 = {0x3F803F80u, 0x3F803F80u, 0x3F803F80u, 0x3F803F80u};
#pragma unroll
    for (int ks = 0; ks < 4; ++ks) {
        const int dd = 32 * tb + l31 - 16 * ks - 8 * lh;
        const bf16x8 alf = tr_frag(F.lds + G_LF, trb, ks, cb);
        T = mfma32(alf, __builtin_bit_cast(bf16x8, ones4), T);
        if (DIR ? (tb == 0 || ks >= 2) : (tb == 1 || ks < 2)) b = mfma32(alf, cfrag<DIR>(dd), b);
    }
    const int wb = opq((32 * tb + l31) * 272 + (32 * cb + 4 * lh) * 2);
    typedef float f32x2 __attribute__((ext_vector_type(2)));
    u32x2 lfw[4], qw[4];
#pragma unroll
    for (int g = 0; g < 4; ++g) { lfw[g] = *(const LAS u32x2*)(F.lds + G_LF + wb + g * 16); if (WITH_Q) qw[g] = *(const LAS u32x2*)(F.lds + G_QR + wb + g * 16); }
#pragma unroll
    for (int g = 0; g < 4; ++g) {
        f32x2 k2[2], q2[2];
#pragma unroll
        for (int h = 0; h < 2; ++h) {
            const int r = 4 * g + 2 * h;
            const unsigned lw = h ? lfw[g].y : lfw[g].x;
            const f32x2 lf = {bflo(lw), bfhi(lw)}, Tv = {T[r], T[r + 1]}, bv = {b[r], b[r + 1]};
            const f32x2 mm = Tv * 0.5f, d = mm - bv;
            eh[r] = __builtin_amdgcn_exp2f(mm.x); eh[r + 1] = __builtin_amdgcn_exp2f(mm.y);
            if (tsum) { tsum[r] += Tv.x; tsum[r + 1] += Tv.y; }
            f32x2 ef, ek; ef.x = __builtin_amdgcn_exp2f(lf.x); ef.y = __builtin_amdgcn_exp2f(lf.y); ek.x = __builtin_amdgcn_exp2f(d.x); ek.y = __builtin_amdgcn_exp2f(d.y);
            k2[h] = (1.0f - ef) * ek;
            q2[h] = (f32x2){0.f, 0.f};
            if (WITH_Q) { const unsigned qq = h ? qw[g].y : qw[g].x; const f32x2 q = {bflo(qq), bfhi(qq)}, nd = bv - mm;
                f32x2 eq; eq.x = __builtin_amdgcn_exp2f(nd.x); eq.y = __builtin_amdgcn_exp2f(nd.y); q2[h] = q * eq; }
        }
        u32x2 w; w.x = cvt_pk_bf16(k2[0].x, k2[0].y); w.y = cvt_pk_bf16(k2[1].x, k2[1].y);
        *(LAS u32x2*)(F.lds + G_K2 + wb + g * 16) = w;
        if (WITH_Q) { w.x = cvt_pk_bf16(q2[0].x, q2[0].y); w.y = cvt_pk_bf16(q2[1].x, q2[1].y); *(LAS u32x2*)(F.lds + G_Q2 + wb + g * 16) = w; }
    }
}
__device__ __forceinline__ void gla_state_mma(const Frame& F, int trb, f32x16& s0, f32x16& s1) {
    const int kb = F.wave >> 1, vb = (F.wave & 1) * 2;
#pragma unroll
    for (int ks = 0; ks < 4; ++ks) {
        const bf16x8 a = tr_frag(F.lds + G_K2, trb, ks, kb);
        const bf16x8 b0 = tr_frag(F.lds + G_V, trb, ks, vb), b1 = tr_frag(F.lds + G_V, trb, ks, vb + 1);
        s0 = mfma32(a, b0, s0); s1 = mfma32(a, b1, s1);
    }
}

template <int DIR>
__device__ __forceinline__ void gla_passA_unit(const Frame& F, const bf16_t* P, int b, int h, int blk, bf16_t* dS, float* DD) {
    const int xb = DIR ? (16 - blk) : (blk - 1);
    const int rowb = (blk == 0) ? (M + b * CTXL) : (b * SEQ + xb * 256);
    const int l31 = F.lane & 31, lh = F.lane >> 5;
    const int trb = (8 * lh + ((F.lane & 15) >> 2)) * 272 + (16 * ((F.lane >> 4) & 1) + 4 * (F.lane & 3)) * 2;
    f32x16 s0, s1;
#pragma unroll
    for (int r = 0; r < 16; ++r) { s0[r] = 0.f; s1[r] = 0.f; }
    float tsum[16], eh[16];
#pragma unroll
    for (int i = 0; i < 16; ++i) tsum[i] = 0.f;
    RawRegs R;
    gla_load_raw<DIR, false>(F, P, rowb + (DIR ? 3 : 0) * 64, h, R);
#pragma unroll 1
    for (int ci = 0; ci < 4; ++ci) {
        LSYNC();
        gla_store_raw<false>(F, R);
        if (ci < 3) gla_load_raw<DIR, false>(F, P, rowb + (DIR ? (2 - ci) : (ci + 1)) * 64, h, R);
        LSYNC();
        gla_stage1<DIR, false>(F, trb, eh, tsum);
        LSYNC();
#pragma unroll
        for (int r = 0; r < 16; ++r) { s0[r] *= eh[r]; s1[r] *= eh[r]; }
        gla_state_mma(F, trb, s0, s1);
#pragma unroll
        for (int r = 0; r < 16; ++r) { s0[r] *= eh[r]; s1[r] *= eh[r]; }
    }
    const int kb = F.wave >> 1, vb = (F.wave & 1) * 2;
    const unsigned sb = opqu((unsigned)((32 * kb + 4 * lh) * 128 + 32 * vb + l31));
#pragma unroll
    for (int r = 0; r < 16; ++r) { dS[sb + crow0(r) * 128] = f2bf(s0[r]); dS[sb + 32 + crow0(r) * 128] = f2bf(s1[r]); }
    if ((F.wave & 1) == 0 && l31 == 0) {
#pragma unroll
        for (int r = 0; r < 16; ++r) DD[32 * kb + 4 * lh + crow0(r)] = __builtin_amdgcn_exp2f(tsum[r]);
    }
}

template <int W, class Get, class Emit> __device__ __forceinline__ void win_mean64(const Get& get, const Emit& emit) {
    float s = 0.f;
#pragma unroll
    for (int q = 0; q < W - W / 2; ++q) s += get(q);
#pragma unroll
    for (int r = 0; r < 64; ++r) {
        const int lo = (r - W / 2) < 0 ? 0 : (r - W / 2), hi = (r - W / 2 + W) > 64 ? 64 : (r - W / 2 + W);
        emit(r, s * (1.0f / (float)(hi - lo)));
        if (r + 1 < 64) { if (r + 1 - W / 2 + W <= 64) s += get(r - W / 2 + W); if (r + 1 - W / 2 > 0) s -= get(r - W / 2); }
    }
}
template <int W>
__device__ __forceinline__ void pool_unit(const Frame& F, const bf16_t* __restrict__ U, bf16_t* __restrict__ A2, int b, int slab) {
    LAS float* vm = (LAS float*)F.lds;
    const int ch = F.tid & 7, cc = F.tid >> 3;
    const bf16_t* Us = U + (size_t)(b * 64 + slab) * 4096 * 8;
    {
        unsigned short v[64];
        const unsigned pb = opqu((unsigned)(cc * 8 + ch));
#pragma unroll
        for (int r = 0; r < 64; ++r) v[r] = Us[pb + (unsigned)(r * 64 * 8)];
        const int vb = opq((cc * 8 + ch) * 4);
        win_mean64<W>([&](int q) { return bf2f(v[q]); }, [&](int r, float mean) { *(LAS float*)(F.lds + vb + r * 2080) = mean; });
    }
    __syncthreads();
    {
        const int rr = F.tid >> 3;
        unsigned short uu[64];
        const unsigned pb = opqu((unsigned)(rr * 64 * 8 + ch));
#pragma unroll
        for (int c = 0; c < 64; ++c) uu[c] = Us[pb + (unsigned)(c * 8)];
        const int vb = opq((rr * 520 + ch) * 4);
        const unsigned ab = opqu((unsigned)((b * SEQ + rr * 64) * D + 512 + slab * 8 + ch));
        win_mean64<W>([&](int q) { return *(const LAS float*)(F.lds + vb + q * 32); },
                      [&](int c, float mean) { A2[ab + (unsigned)(c * D)] = f2bf(mean - bf2f(uu[c])); });
    }
    __syncthreads();
}

__device__ __forceinline__ void p4_scan(const Frame& F) {
    bf16_t* ST = (bf16_t*)(F.ws + WS_ST); const float* DDp = (const float*)(F.ws + WS_DD);
    const int gt = F.bid * 512 + F.tid, NT = F.G * 512;
    for (int i = gt; i < 32 * 4096; i += NT) {
        const int seq = i >> 12, e4 = i & 4095, k = e4 >> 5;
        float S[4];
#pragma unroll
        for (int j = 0; j < 4; ++j) S[j] = 0.f;
        u32x2 d[NBLK]; float dec[NBLK];
#pragma unroll
        for (int blk = 0; blk < NBLK; ++blk) { d[blk] = *(const u32x2*)(ST + ((size_t)(seq * NBLK + blk) * 16384) + e4 * 4); dec[blk] = DDp[(seq * NBLK + blk) * 128 + k]; }
#pragma unroll
        for (int blk = 0; blk < NBLK; ++blk) {
            u32x2 o; o.x = cvt_pk_bf16(S[0], S[1]); o.y = cvt_pk_bf16(S[2], S[3]);
            *(u32x2*)(ST + ((size_t)(seq * NBLK + blk) * 16384) + e4 * 4) = o;
            S[0] = S[0] * dec[blk] + bflo(d[blk].x); S[1] = S[1] * dec[blk] + bfhi(d[blk].x); S[2] = S[2] * dec[blk] + bflo(d[blk].y); S[3] = S[3] * dec[blk] + bfhi(d[blk].y);
        }
    }
}

__device__ __forceinline__ float row16_sum(float x) {
    int v;
    v = __builtin_amdgcn_mov_dpp(__float_as_int(x), 0x128, 0xf, 0xf, false); x += __int_as_float(v);
    v = __builtin_amdgcn_mov_dpp(__float_as_int(x), 0x124, 0xf, 0xf, false); x += __int_as_float(v);
    v = __builtin_amdgcn_mov_dpp(__float_as_int(x), 0x122, 0xf, 0xf, false); x += __int_as_float(v);
    v = __builtin_amdgcn_mov_dpp(__float_as_int(x), 0x121, 0xf, 0xf, false); x += __int_as_float(v);
    return x;
}
template <int DIR>
__device__ __forceinline__ void gla_passC_dir(const Frame& F, const bf16_t* P, int b, int h, int xb, const bf16_t* ST, bf16_t* OF, bf16_t* A2, const float* gain) {
    const int blk = DIR ? (16 - xb) : (xb + 1);
    const int seq = b * 8 + h * 2 + DIR;
    const bf16_t* S0 = ST + (size_t)(seq * NBLK + blk) * 16384;
    const int kb = F.wave >> 1, vb = (F.wave & 1) * 2, l31 = F.lane & 31, lh = F.lane >> 5;
    const int trb = (8 * lh + ((F.lane & 15) >> 2)) * 272 + (16 * ((F.lane >> 4) & 1) + 4 * (F.lane & 3)) * 2;
    f32x16 s0, s1;
    const unsigned sb = opqu((unsigned)((32 * kb + 4 * lh) * 128 + 32 * vb + l31));
#pragma unroll
    for (int r = 0; r < 16; ++r) { s0[r] = bf2f(S0[sb + crow0(r) * 128]); s1[r] = bf2f(S0[sb + 32 + crow0(r) * 128]); }
    const int rowb = b * SEQ + xb * 256;
    const int omt = F.wave >> 2, ont = F.wave & 3;
    LAS float* red = (LAS float*)(F.lds + G_RED);
    RawRegs R;
    gla_load_raw<DIR, true>(F, P, rowb + (DIR ? 3 : 0) * 64, h, R);
    LSYNC();
    gla_store_raw<true>(F, R);
#pragma unroll 1
    for (int ci = 0; ci < 4; ++ci) {
        const int c = DIR ? (3 - ci) : ci;
        float eh[16];
        if (ci < 3) gla_load_raw<DIR, true>(F, P, rowb + (DIR ? (2 - ci) : (ci + 1)) * 64, h, R);
        f32x16 o;
        const unsigned trow = (unsigned)(rowb + c * 64 + 32 * omt + l31);
        const unsigned ob = opqu(trow * 512u + (unsigned)(h * 128 + 32 * ont + 4 * lh));
        u32x2 gg[4];
        if (DIR) {
            const unsigned pb = opqu(trow * (unsigned)NIN + (unsigned)(2048 + h * 128 + 32 * ont + 4 * lh));
#pragma unroll
            for (int g = 0; g < 4; ++g) { const u32x2 t4 = *(const u32x2*)(OF + ob + g * 8); o[4 * g] = bflo(t4.x); o[4 * g + 1] = bfhi(t4.x); o[4 * g + 2] = bflo(t4.y); o[4 * g + 3] = bfhi(t4.y); gg[g] = *(const u32x2*)(P + pb + g * 8); }
        } else {
#pragma unroll
            for (int r = 0; r < 16; ++r) o[r] = 0.f;
        }
        LSYNC();
        gla_stage1<DIR, true>(F, trb, eh, nullptr);
        LSYNC();
#pragma unroll
        for (int r = 0; r < 16; ++r) { s0[r] *= eh[r]; s1[r] *= eh[r]; }
        {
            const int stb = opq(G_ST + (32 * vb + l31) * 272 + (32 * kb + 4 * lh) * 2);
#pragma unroll
            for (int g = 0; g < 4; ++g) {
                u32x2 w; w.x = cvt_pk_bf16(s0[4 * g], s0[4 * g + 1]); w.y = cvt_pk_bf16(s0[4 * g + 2], s0[4 * g + 3]);
                *(LAS u32x2*)(F.lds + stb + g * 16) = w;
                w.x = cvt_pk_bf16(s1[4 * g], s1[4 * g + 1]); w.y = cvt_pk_bf16(s1[4 * g + 2], s1[4 * g + 3]);
                *(LAS u32x2*)(F.lds + stb + 32 * 272 + g * 16) = w;
            }
        }
        if (F.wave < 4) {
            const int asb = F.wave >> 1, atb = F.wave & 1;
            f32x16 at, at2;
#pragma unroll
            for (int r = 0; r < 16; ++r) { at[r] = 0.f; at2[r] = 0.f; }
            const int ka = opq(G_K2 + (32 * asb + l31) * 272 + 16 * lh), qa = opq(G_Q2 + (32 * atb + l31) * 272 + 16 * lh);
#pragma unroll
            for (int ks = 0; ks < 8; ks += 2) {
                const bf16x8 a = *(const LAS bf16x8*)(F.lds + ka + ks * 32), a2 = *(const LAS bf16x8*)(F.lds + ka + ks * 32 + 32);
                const bf16x8 bb = *(const LAS bf16x8*)(F.lds + qa + ks * 32), bb2 = *(const LAS bf16x8*)(F.lds + qa + ks * 32 + 32);
                at = mfma32(a, bb, at); at2 = mfma32(a2, bb2, at2);
            }
#pragma unroll
            for (int r = 0; r < 16; ++r) at[r] += at2[r];
            const int dts = opq((32 * atb + l31) - (32 * asb + 4 * lh));
            float am[16];
#pragma unroll
            for (int r = 0; r < 16; ++r) { const bool keep = DIR ? (crow0(r) >= dts) : (crow0(r) <= dts); am[r] = keep ? at[r] : 0.f; }
            const int ab = opq(G_ATT + (32 * atb + l31) * 144 + (32 * asb + 4 * lh) * 2);
#pragma unroll
            for (int g = 0; g < 4; ++g) { u32x2 w; w.x = cvt_pk_bf16(am[4 * g], am[4 * g + 1]); w.y = cvt_pk_bf16(am[4 * g + 2], am[4 * g + 3]); *(LAS u32x2*)(F.lds + ab + g * 16) = w; }
        }
        LSYNC();
        {
            const int qa = opq(G_Q2 + (32 * omt + l31) * 272 + 16 * lh), sa = opq(G_ST + (32 * ont + l31) * 272 + 16 * lh), aa = opq(G_ATT + (32 * omt + l31) * 144 + 16 * lh);
            f32x16 o2;
#pragma unroll
            for (int r = 0; r < 16; ++r) o2[r] = 0.f;
#pragma unroll
            for (int ks = 0; ks < 8; ++ks) {
                const bf16x8 a = *(const LAS bf16x8*)(F.lds + sa + ks * 32);
                const bf16x8 bb = *(const LAS bf16x8*)(F.lds + qa + ks * 32);
                if (ks & 1) o2 = mfma32(a, bb, o2); else o = mfma32(a, bb, o);
            }
#pragma unroll
            for (int ks = 0; ks < 4; ++ks) {
                const bf16x8 a = tr_frag(F.lds + G_V, trb, ks, ont);
                const bf16x8 bb = *(const LAS bf16x8*)(F.lds + aa + ks * 32);
                if (ks & 1) o2 = mfma32(a, bb, o2); else o = mfma32(a, bb, o);
            }
#pragma unroll
            for (int r = 0; r < 16; ++r) o[r] += o2[r];
        }
        gla_state_mma(F, trb, s0, s1);
#pragma unroll
        for (int r = 0; r < 16; ++r) { s0[r] *= eh[r]; s1[r] *= eh[r]; }
        if (DIR == 0) {
#pragma unroll
            for (int g = 0; g < 4; ++g) { u32x2 w; w.x = cvt_pk_bf16(o[4 * g], o[4 * g + 1]); w.y = cvt_pk_bf16(o[4 * g + 2], o[4 * g + 3]); *(u32x2*)(OF + ob + g * 8) = w; }
        } else {
            float sq = 0.f;
#pragma unroll
            for (int r = 0; r < 16; ++r) sq += o[r] * o[r];
            sq += __shfl_xor(sq, 32);
            if (lh == 0) red[(32 * omt + l31) * 4 + ont] = sq;
            LSYNC();
            const f32x4 q4 = *(const LAS f32x4*)(red + (32 * omt + l31) * 4);
            const float rstd = rsqrtf(((q4.x + q4.y) + (q4.z + q4.w)) * (1.0f / 128.0f) + EPS);
            const unsigned a2b = opqu(trow * (unsigned)D + (unsigned)(h * 128 + 32 * ont + 4 * lh));
#pragma unroll
            for (int g = 0; g < 4; ++g) {
                u32x2 w; w.x = cvt_pk_bf16(o[4 * g] * rstd * bflo(gg[g].x), o[4 * g + 1] * rstd * bfhi(gg[g].x));
                w.y = cvt_pk_bf16(o[4 * g + 2] * rstd * bflo(gg[g].y), o[4 * g + 3] * rstd * bfhi(gg[g].y));
                *(u32x2*)(A2 + a2b + g * 8) = w; }
        }
        if (ci < 3) { LSYNC();
            gla_store_raw<true>(F, R); }
    }
}
__device__ __forceinline__ void gla_passC_unit(const Frame& F, const Args& a, int b, int h, int xb) {
    const bf16_t* P = (const bf16_t*)(F.ws + WS_P); const bf16_t* ST = (const bf16_t*)(F.ws + WS_ST); bf16_t* A2 = (bf16_t*)(F.ws + WS_A2);
    bf16_t* OF = (bf16_t*)(F.ws + WS_YX);
    gla_passC_dir<0>(F, P, b, h, xb, ST, OF, A2, a.in[13]);
    gla_passC_dir<1>(F, P, b, h, xb, ST, OF, A2, a.in[13]);
}

__device__ __forceinline__ void p7_rows(const Frame& F, const Args& a, const XcdBarrier& bar, bool pending) {
    const float* x = a.in[0]; const float* gpm = a.in[7]; const float* gpf = a.in[8]; const float* b_router = a.in[17];
    const float* mod = (const float*)(F.ws + WS_MOD); const bf16_t* YX = (const bf16_t*)(F.ws + WS_YXB);
    const bf16_t* WRH = (const bf16_t*)(F.ws + WS_WRH); const bf16_t* WRL = (const bf16_t*)(F.ws + WS_WRL);
    bf16_t* X1B = (bf16_t*)(F.ws + WS_X1B); unsigned char* HX2F = F.ws + WS_HX2F; int* PE = (int*)(F.ws + WS_PE); int* PSLOT = (int*)(F.ws + WS_PSLOT); float* PW = (float*)(F.ws + WS_PW);
    int* RTOK = (int*)(F.ws + WS_RTOK); unsigned* cnt = F.ctl + CW_CNT;
    LAS float* part = (LAS float*)F.lds;
    LAS float* logit = (LAS float*)(F.lds + 65536);
    LAS int* lcnt = (LAS int*)(F.lds + LDS_TAB);
    const int l31 = F.lane & 31, lh = F.lane >> 5;
    for (int g = F.bid; g < M / 64; g += F.G) {
        const int base = (F.G == 256) ? ((8 * (g & 7) + (g >> 5)) * 256 + ((g >> 3) & 3) * 64) : g * 64;
        if (F.tid < 64) lcnt[F.tid] = 0;
        f32x4 cgt[4], e2[4], f2[4];
        { const float* mrow = mod + (base >> 12) * 6144;
#pragma unroll
          for (int j = 0; j < 4; ++j) { const int col = F.lane * 4 + 256 * j; cgt[j] = *(const f32x4*)(mrow + 2048 + col) * *(const f32x4*)(gpm + col);
              e2[j] = *(const f32x4*)(gpf + col) * (1.0f + *(const f32x4*)(mrow + 4096 + col)); f2[j] = *(const f32x4*)(mrow + 3072 + col); } }
        u32x2 yw[4]; f32x4 xx[4];
        { const int m0 = base + F.wave * 8;
#pragma unroll
          for (int j = 0; j < 4; ++j) { const int col = F.lane * 4 + 256 * j; xx[j] = __builtin_nontemporal_load((const f32x4*)(x + (size_t)m0 * D + col)); }
          if (pending && g == F.bid) xcd_wait(bar);
#pragma unroll
          for (int j = 0; j < 4; ++j) { const int col = F.lane * 4 + 256 * j; yw[j] = __builtin_nontemporal_load((const u32x2*)(YX + (size_t)m0 * D + col)); } }
#pragma unroll 1
        for (int r = 0; r < 8; ++r) {
            const int m = base + F.wave * 8 + r, mn = base + F.wave * 8 + (r < 7 ? r + 1 : r);
            u32x2 ywn[4]; f32x4 xn[4];
#pragma unroll
            for (int j = 0; j < 4; ++j) { const int col = F.lane * 4 + 256 * j; ywn[j] = __builtin_nontemporal_load((const u32x2*)(YX + (size_t)mn * D + col)); xn[j] = __builtin_nontemporal_load((const f32x4*)(x + (size_t)mn * D + col)); }
            f32x4 y[4]; float s = 0.f;
#pragma unroll
            for (int j = 0; j < 4; ++j) { y[j] = (f32x4){bflo(yw[j].x), bfhi(yw[j].x), bflo(yw[j].y), bfhi(yw[j].y)};
                s += (y[j].x * y[j].x + y[j].y * y[j].y) + (y[j].z * y[j].z + y[j].w * y[j].w); }
            const float rstd = rsqrtf(wave_sum(s) * (1.f / D) + EPS);
            float s2 = 0.f;
#pragma unroll
            for (int j = 0; j < 4; ++j) { const int col = F.lane * 4 + 256 * j;
                xx[j] = xx[j] + cgt[j] * (y[j] * rstd);
                { u32x2 w1; w1.x = cvt_pk_bf16(xx[j].x, xx[j].y); w1.y = cvt_pk_bf16(xx[j].z, xx[j].w); __builtin_nontemporal_store(w1, (u32x2*)(X1B + (size_t)m * D + col)); }
                s2 += (xx[j].x * xx[j].x + xx[j].y * xx[j].y) + (xx[j].z * xx[j].z + xx[j].w * xx[j].w); }
            const float rstd2 = rsqrtf(wave_sum(s2) * (1.f / D) + EPS);
#pragma unroll
            for (int j = 0; j < 4; ++j) { const int col = F.lane * 4 + 256 * j;
                const f32x4 hh = xx[j] * rstd2 * e2[j] + f2[j];
                u32x2 w; w.x = cvt_pk_bf16(hh.x, hh.y); w.y = cvt_pk_bf16(hh.z, hh.w);
                const int lr = F.wave * 8 + r;
                *(LAS u32x2*)(F.lds + lr * 2048 + ((((F.lane >> 1) + 32 * j) ^ (lr & 15)) * 16) + (F.lane & 1) * 8) = w;
                *(unsigned*)(HX2F + (size_t)m * D + col) = pk4_fp8(hh.x, hh.y, hh.z, hh.w); }
#pragma unroll
            for (int j = 0; j < 4; ++j) { yw[j] = ywn[j]; xx[j] = xn[j]; }
        }
        bf16x8 bh[8], bl[8];
#pragma unroll
        for (int ks = 0; ks < 8; ++ks) { const int k0 = 128 * F.wave + 16 * ks + 8 * lh; bh[ks] = *(const bf16x8*)(WRH + l31 * 1024 + k0); bl[ks] = *(const bf16x8*)(WRL + l31 * 1024 + k0); }
        __syncthreads();
        {
            f32x16 acc0, acc1;
#pragma unroll
            for (int r = 0; r < 16; ++r) { acc0[r] = 0.f; acc1[r] = 0.f; }
#pragma unroll
            for (int ks = 0; ks < 8; ++ks) {
                const int ch = ((16 * F.wave + 2 * ks + lh) ^ (l31 & 15)) * 16;
                const bf16x8 a0 = *(const LAS bf16x8*)(F.lds + l31 * 2048 + ch), a1 = *(const LAS bf16x8*)(F.lds + (32 + l31) * 2048 + ch);
                acc0 = mfma32(a0, bh[ks], acc0); acc0 = mfma32(a0, bl[ks], acc0); acc1 = mfma32(a1, bh[ks], acc1); acc1 = mfma32(a1, bl[ks], acc1);
            }
            const int pb = opq((F.wave * 64 + 4 * lh) * 32 + l31);
            __syncthreads();
#pragma unroll
            for (int r = 0; r < 16; ++r) { part[pb + crow0(r) * 32] = acc0[r]; part[pb + (32 + crow0(r)) * 32] = acc1[r]; }
        }
        __syncthreads();
        { f32x4 t = *(const f32x4*)(b_router + ((F.tid * 4) & 31));
#pragma unroll
          for (int w = 0; w < 8; ++w) t += *(const LAS f32x4*)(part + w * 2048 + F.tid * 4);
          *(LAS f32x4*)(logit + F.tid * 4) = t; }
        __syncthreads();
#pragma unroll 1
        for (int r = 0; r < 8; ++r) {
            const int m = base + F.wave * 8 + r;
            float v = (F.lane < 32) ? logit[(F.wave * 8 + r) * 32 + l31] : -3.0e38f; float tv[4]; int ti[4];
#pragma unroll
            for (int k = 0; k < 4; ++k) {
                float mx = v;
#pragma unroll
                for (int o = 1; o < 64; o <<= 1) mx = fmaxf(mx, __shfl_xor(mx, o));
                const unsigned long long bal = __ballot(v == mx);
                int idx = __ffsll((long long)bal) - 1; idx = idx < 0 ? 0 : (idx > 31 ? 31 : idx);
                tv[k] = mx; ti[k] = idx;
                if (F.lane == idx) v = -3.0e38f;
            }
            const float e1 = __expf(tv[1] - tv[0]), e2 = __expf(tv[2] - tv[0]), e3 = __expf(tv[3] - tv[0]);
            const float inv = 1.0f / (1.0f + e1 + e2 + e3);
            if (F.lane < 4) {
                const int e = F.lane == 0 ? ti[0] : F.lane == 1 ? ti[1] : F.lane == 2 ? ti[2] : ti[3];
                const float w = (F.lane == 0 ? 1.0f : F.lane == 1 ? e1 : F.lane == 2 ? e2 : e3) * inv;
                const int lrank = __hip_atomic_fetch_add(lcnt + e, 1, __ATOMIC_RELAXED, __HIP_MEMORY_SCOPE_WORKGROUP);
                PE[m * 4 + F.lane] = e; PSLOT[m * 4 + F.lane] = lrank; PW[m * 4 + F.lane] = w;
            }
        }
        __syncthreads();
        if (F.tid < 32) { const int c = lcnt[F.tid]; lcnt[32 + F.tid] = c ? (int)__hip_atomic_fetch_add(cnt + 64 * F.tid, (unsigned)c, __ATOMIC_RELAXED, __HIP_MEMORY_SCOPE_AGENT) : 0; }
        __syncthreads();
        if (F.tid < 256) { const int m = base + (F.tid >> 2), k = F.tid & 3; const int e = PE[m * 4 + k]; const int slot = lcnt[32 + e] + PSLOT[m * 4 + k];
            PSLOT[m * 4 + k] = slot; RTOK[e * ECAP + slot] = m * 1024; }
        __syncthreads();
    }
}

__device__ __forceinline__ void moe_tables(const Frame& F) {
    LAS int* tab = (LAS int*)(F.lds + LDS_TAB);
    __syncthreads();
    if (F.tid < 64) {
        const int c = (F.lane < 32) ? (int)__hip_atomic_load(F.ctl + CW_CNT + 64 * (F.lane & 31), __ATOMIC_RELAXED, __HIP_MEMORY_SCOPE_AGENT) : 0;
        const int padded = ((c + 255) >> 8) * 256;
        int incl = padded;
#pragma unroll
        for (int o = 1; o < 32; o <<= 1) { const int t = __shfl_up(incl, o); if (F.lane >= o) incl += t; }
        if (F.lane < 32) { tab[F.lane] = c; tab[32 + F.lane] = incl - padded; }
        if (F.lane == 31) tab[64] = incl >> 8;
    }
    __syncthreads();
}

__device__ __forceinline__ void p10_final(const Frame& F, const Args& a, const XcdBarrier& bar, bool pending) {
    const float* gpo = a.in[9]; const float* mod = (const float*)(F.ws + WS_MOD);
    const unsigned char* YB = F.ws + WS_YB; const bf16_t* X1B = (const bf16_t*)(F.ws + WS_X1B); const int* PE = (const int*)(F.ws + WS_PE); const int* PSLOT = (const int*)(F.ws + WS_PSLOT); const float* PW = (const float*)(F.ws + WS_PW);
    const LAS int* tab = (const LAS int*)(F.lds + LDS_TAB);
    const int gw = F.bid * 8 + F.wave;
    struct Rec { int e[4], s[4]; float w[4]; };
    auto ld_rec = [&](int m, Rec& r) {
#pragma unroll
        for (int k = 0; k < 4; ++k) { r.e[k] = PE[m * 4 + k]; r.s[k] = PSLOT[m * 4 + k]; r.w[k] = PW[m * 4 + k]; } };
    auto ld_x = [&](int m, u32x2 (&xw)[4]) {
#pragma unroll
        for (int j = 0; j < 4; ++j) xw[j] = __builtin_nontemporal_load((const u32x2*)(X1B + (size_t)m * D + F.lane * 4 + 256 * j)); };
    auto ld_y = [&](const Rec& r, int (&yv)[16]) {
#pragma unroll
        for (int k = 0; k < 4; ++k) { const unsigned char* yr = YB + (size_t)(tab[32 + r.e[k]] + r.s[k]) * D + F.lane * 4;
#pragma unroll
            for (int j = 0; j < 4; ++j) yv[k * 4 + j] = __builtin_nontemporal_load((const int*)(yr + 256 * j)); } };
    auto ld_row = [&](int m, const Rec& r, int (&yv)[16], u32x2 (&xw)[4]) { ld_y(r, yv); ld_x(m, xw); };
#pragma unroll 1
    for (int g8 = gw; g8 < M / 8; g8 += F.G * 8) {
    const int mbeg = g8 * 8, mend = mbeg + 7;
    int m = mbeg;
    Rec r0, r1; int yv[16]; u32x2 xw[4];
    f32x4 ggt[4];
    { const float* mrow = mod + (mbeg >> 12) * 6144;
#pragma unroll
      for (int j = 0; j < 4; ++j) { const int col = F.lane * 4 + 256 * j; ggt[j] = *(const f32x4*)(gpo + col) * *(const f32x4*)(mrow + 5120 + col); } }
    ld_rec(m, r0);
    ld_rec(m + 1, r1);
    ld_x(m, xw);
    if (pending && g8 == gw) xcd_wait(bar);
    ld_y(r0, yv);
#pragma unroll 1
    for (; m <= mend; ++m) {
        const int m1 = m + 1 <= mend ? m + 1 : m, m2 = m1 + 1 <= mend ? m1 + 1 : m1;
        Rec r2; ld_rec(m2, r2);
        int yn[16]; u32x2 xn[4];
        ld_row(m1, r1, yn, xn);
        f32x4 y[4];
#pragma unroll
        for (int j = 0; j < 4; ++j) y[j] = (f32x4){0.f, 0.f, 0.f, 0.f};
#pragma unroll
        for (int k = 0; k < 4; ++k) { const float w = r0.w[k];
#pragma unroll
            for (int j = 0; j < 4; ++j) { const int v = yv[k * 4 + j];
                const auto lo = __builtin_amdgcn_cvt_pk_f32_fp8(v, false), hi = __builtin_amdgcn_cvt_pk_f32_fp8(v, true);
                y[j].x += w * lo[0]; y[j].y += w * lo[1]; y[j].z += w * hi[0]; y[j].w += w * hi[1]; } }
        float s = 0.f;
#pragma unroll
        for (int j = 0; j < 4; ++j) s += (y[j].x * y[j].x + y[j].y * y[j].y) + (y[j].z * y[j].z + y[j].w * y[j].w);
        const float rstd = rsqrtf(wave_sum(s) * (1.f / D) + EPS);
#pragma unroll
        for (int j = 0; j < 4; ++j) { const int col = F.lane * 4 + 256 * j;
            float* op = a.out + (size_t)m * D + col; const f32x4 x1 = {bflo(xw[j].x), bfhi(xw[j].x), bflo(xw[j].y), bfhi(xw[j].y)};
            __builtin_nontemporal_store(x1 + ggt[j] * (y[j] * rstd), (f32x4*)op); }
        r0 = r1; r1 = r2;
#pragma unroll
        for (int i = 0; i < 16; ++i) yv[i] = yn[i];
#pragma unroll
        for (int j = 0; j < 4; ++j) xw[j] = xn[j];
    }
    }
}

constexpr int NPHASE = 11;
__global__ void __launch_bounds__(512, 2) mk_fwd(Args args) {
    extern __shared__ __attribute__((aligned(16))) unsigned char lds_raw[];
    Frame F;
    F.lds = (LAS unsigned char*)lds_raw; F.ws = args.ws; F.ctl = (unsigned*)(args.ws + WS_CTL);
    F.tid = threadIdx.x; F.lane = F.tid & 63; F.wave = __builtin_amdgcn_readfirstlane(F.tid >> 6); F.G = gridDim.x; F.bid = blockIdx.x;
    volatile LAS unsigned* MISC = (volatile LAS unsigned*)(F.lds + LDS_MISC);
    if (F.tid < 32) MISC[F.tid] = 0u;
    __syncthreads();
    XcdBarrier bar = xcd_barrier_post(F.ctl + CW_BAR + args.li * XCD_BAR_WORDS, MISC + 8);
    const int lo = args.ph_lo, hi = args.ph_hi;
#ifndef PHMASK
#define PHMASK 0x7ff
#endif
#define IN(k) (((PHMASK >> (k)) & 1) && lo <= (k) && (k) < hi)
#define SEAM(k) do { if (IN(k) && IN((k) + 1)) xcd_barrier(bar); } while (0)

    if (IN(0)) { p0_prologue(F, args); }
    if (IN(1)) for (int rep = 0; rep <= ((REPMASK >> 1) & 1); ++rep) { if (rep) xcd_barrier(bar); p1_normmod(F, args, 192u); }
    if (IN(1) && IN(2)) xcd_arrive(bar);
    if (IN(2)) for (int rep = 0; rep <= ((REPMASK >> 2) & 1); ++rep) { if (rep) xcd_barrier(bar);
        pg8::StaticOrder S; S.init(F.ws + WS_HX, F.ws + WS_WIN, M, NIN, D, F.G, F.bid);
        EpiInProj E{(bf16_t*)(F.ws + WS_P), args.in[12], (bf16_t*)(F.ws + WS_U), args.in[13]};
        const int nctx = 24;
        const bool tfirst = (F.bid >= nctx) && (((F.bid >> 3) & 1) != 0);
        const int nbefore = tfirst ? 11 : 2;
        if (F.bid >= nctx) { transpose_items_fp8(F, args, (F.bid - nctx) * 8 + F.wave, (F.G - nctx) * 8, 0, nbefore); __syncthreads(); }
        if (IN(1) && rep == 0) xcd_wait(bar);
        {
            pg8::P2Order O; O.S = S; O.ctx = (F.bid < nctx);
            O.cu.pm = 64 + F.bid / 6; O.cu.pn = 2 + F.bid % 6; O.cu.A = (const char*)(F.ws + WS_HX) + (size_t)O.cu.pm * 256 * D * 2; O.cu.B = (const char*)(F.ws + WS_WIN) + (size_t)O.cu.pn * 256 * D * 2;
            pg8::gemm_phase<EpiInProj, pg8::P2Order, false, true, true>(F.lds, D, O, E);
        }
        const bool lastrep = rep == ((REPMASK >> 2) & 1);
        if (F.bid >= nctx) {
            if (IN(3) && lastrep) xcd_arrive(bar);
            transpose_items_fp8(F, args, (F.bid - nctx) * 8 + F.wave, (F.G - nctx) * 8, nbefore, 1 << 20); __syncthreads();
        }
        if (F.bid < nctx) {
            asm volatile("s_waitcnt vmcnt(0)" ::: "memory");
            __syncthreads();
            if (F.tid == 0) { __builtin_amdgcn_fence(__ATOMIC_RELEASE, "agent"); asm volatile("s_waitcnt vmcnt(0)" ::: "memory");
                __hip_atomic_fetch_add(F.ctl + CW_CTX + 64 * (F.bid / 6), 1u, __ATOMIC_RELAXED, __HIP_MEMORY_SCOPE_AGENT); }
            if (IN(3) && lastrep) xcd_arrive(bar);
            const bf16_t* P = (const bf16_t*)(F.ws + WS_P); bf16_t* ST = (bf16_t*)(F.ws + WS_ST); float* DDp = (float*)(F.ws + WS_DD);
            for (int u = F.bid; u < 32; u += nctx) {
                const int b = u >> 3, h = (u >> 1) & 3;
                if (F.tid == 0) { unsigned sp = 0;
                    while (__hip_atomic_load(F.ctl + CW_CTX + 64 * b, __ATOMIC_RELAXED, __HIP_MEMORY_SCOPE_AGENT) < 6u * (unsigned)(rep + 1)) { __builtin_amdgcn_s_sleep(2); if (++sp > (1u << 22)) break; }
                    __builtin_amdgcn_fence(__ATOMIC_ACQUIRE, "agent"); asm volatile("s_waitcnt vmcnt(0)" ::: "memory"); }
                __syncthreads();
                if (u & 1) gla_passA_unit<1>(F, P, b, h, 0, ST + (size_t)(u * NBLK) * 16384, DDp + (u * NBLK) * 128);
                else gla_passA_unit<0>(F, P, b, h, 0, ST + (size_t)(u * NBLK) * 16384, DDp + (u * NBLK) * 128);
                __syncthreads();
            }
        }
    }
    if (IN(2) && IN(3)) xcd_wait(bar);
    if (IN(3)) for (int rep = 0; rep <= ((REPMASK >> 3) & 1); ++rep) { if (rep) xcd_barrier(bar);
        const bf16_t* P = (const bf16_t*)(F.ws + WS_P); bf16_t* A2 = (bf16_t*)(F.ws + WS_A2);
        const bf16_t* Up = (const bf16_t*)(F.ws + WS_U);
        bf16_t* ST = (bf16_t*)(F.ws + WS_ST); float* DDp = (float*)(F.ws + WS_DD);
        for (int uu = F.bid; uu < 32 * 16; uu += F.G) { const int seq = uu >> 4, blk = 1 + (uu & 15), b = seq >> 3, h = (seq >> 1) & 3, dir = seq & 1, u = seq * NBLK + blk;
            if (dir == 0) gla_passA_unit<0>(F, P, b, h, blk, ST + (size_t)u * 16384, DDp + u * 128);
            else gla_passA_unit<1>(F, P, b, h, blk, ST + (size_t)u * 16384, DDp + u * 128); }
    }
    if (IN(3) && IN(4)) xcd_arrive(bar);
    if (IN(3)) {
        bf16_t* A2 = (bf16_t*)(F.ws + WS_A2); const bf16_t* Up = (const bf16_t*)(F.ws + WS_U);
        for (int w = F.bid; w < 256; w += F.G) {
            const int grp = (w & 7) * 4 + ((w >> 3) >> 3), mem = (w >> 3) & 7, b = grp >> 3, slab = (grp & 7) * 8 + mem, gi = slab >> 4;
            if (gi == 0) pool_unit<2>(F, Up, A2, b, slab); else if (gi == 1) pool_unit<4>(F, Up, A2, b, slab); else if (gi == 2) pool_unit<8>(F, Up, A2, b, slab); else pool_unit<16>(F, Up, A2, b, slab); }
    }
    if (IN(3) && IN(4)) xcd_wait(bar);
    if (IN(4)) { p4_scan(F); }
    if (IN(4) && IN(5)) xcd_arrive(bar);
    if (IN(4)) p0_late(F, args);
    if (IN(4) && IN(5)) xcd_wait(bar);
    if (IN(5)) for (int rep = 0; rep <= ((REPMASK >> 5) & 1); ++rep) { if (rep) xcd_barrier(bar); for (int u = F.bid; u < 256; u += F.G) {
            const int x = u & 7, slot = u >> 3;
            gla_passC_unit(F, args, x >> 1, slot >> 3, (x & 1) * 8 + (slot & 7)); } }
    SEAM(5);
    if (IN(6)) for (int rep = 0; rep <= ((REPMASK >> 6) & 1); ++rep) { if (rep) xcd_barrier(bar);
        pg8::StaticOrder S; S.init(F.ws + WS_A2, F.ws + WS_WOUT, M, D, D, F.G, F.bid);
        EpiBf16Out E{(bf16_t*)(F.ws + WS_YXB), D};
        pg8::gemm_phase<EpiBf16Out, pg8::StaticOrder, false, false, true>(F.lds, D, S, E);
    }
    if (IN(6) && IN(7)) xcd_arrive(bar);
    if (IN(7)) { p7_rows(F, args, bar, IN(6) && IN(7)); }
    SEAM(7);
    if (IN(8)) for (int rep = 0; rep <= ((REPMASK >> 8) & 1); ++rep) { if (rep) xcd_barrier(bar);
        moe_tables(F);
        MoeOrder<8, true> S; S.tab = (const LAS int*)(F.lds + LDS_TAB); S.Abase = (const char*)(F.ws + WS_HX2F); S.Wbase = (const char*)(F.ws + WS_WGU); S.rtok = (const int*)(F.ws + WS_RTOK);
        S.cls = 0; S.rank = (F.bid & 7) * (F.G >> 3) + (F.bid >> 3); S.nrank = F.G; S.mtc = F.ctl + CW_MT;
        EpiGateUp E{F.ws + WS_H, args.in[19], args.in[21]};
        pg8::gemm_phase<EpiGateUp, MoeOrder<8, true>, true, true, true, true>(F.lds, 512, S, E);
    }
    if (IN(9)) for (int rep = 0; rep <= ((REPMASK >> 9) & 1); ++rep) { if (rep) xcd_barrier(bar);
        if (!IN(8) || rep) moe_tables(F);
        MoeOrder<4, false> S; S.tab = (const LAS int*)(F.lds + LDS_TAB); S.Abase = (const char*)(F.ws + WS_H); S.Wbase = (const char*)(F.ws + WS_WDN); S.rtok = nullptr;
        S.cls = 0; S.rank = F.G - 1 - ((F.bid & 7) * (F.G >> 3) + (F.bid >> 3)); S.nrank = F.G; S.mtc = F.ctl + CW_MT;
        EpiDown E{F.ws + WS_YB, args.in[23]};
        pg8::gemm_phase<EpiDown, MoeOrder<4, false>, false, true, true, true>(F.lds, 512, S, E);
    }
    if (IN(9) && IN(10)) xcd_arrive(bar);
    if (IN(10)) { if (!IN(9)) moe_tables(F);
        p10_final(F, args, bar, IN(9) && IN(10)); }
#undef IN
#undef SEAM
}

extern "C" void kernel_launch(void* const* d_in, const int* in_sizes, int n_in, void* d_out, int out_size, void* d_ws, size_t ws_size, hipStream_t stream) {
    static int grid = 0;
    if (grid == 0) {
        if (n_in != 24 || out_size != M * D || ws_size < WS_END) { fprintf(stderr, "kernel_launch: unexpected shapes (n_in %d out %d ws %zu)\n", n_in, out_size, ws_size); grid = -1; return; }
        int dev = 0, cus = 0, per_cu = 0;
        if (hipGetDevice(&dev) != hipSuccess || hipDeviceGetAttribute(&cus, hipDeviceAttributeMultiprocessorCount, dev) != hipSuccess) { grid = -1; return; }
        if (hipFuncSetAttribute((const void*)mk_fwd, hipFuncAttributeMaxDynamicSharedMemorySize, LDS_BYTES) != hipSuccess) { fprintf(stderr, "kernel_launch: hipFuncSetAttribute failed\n"); grid = -1; return; }
        if (hipOccupancyMaxActiveBlocksPerMultiprocessor(&per_cu, (const void*)mk_fwd, 512, LDS_BYTES) != hipSuccess || per_cu < 1) { fprintf(stderr, "kernel_launch: occupancy query says %d\n", per_cu); }
        (void)hipGetLastError();
        grid = cus;
        if (grid % 8 != 0 || M % grid != 0 || (M / grid) % 64 != 0) { fprintf(stderr, "kernel_launch: unsupported CU count %d\n", cus); grid = -1; return; }
    }
    if (grid < 0) return;
    if (hipMemsetAsync((char*)d_ws + WS_CTL, 0, CTL_ZERO_BYTES, stream) != hipSuccess) return;
    Args a{};
    for (int i = 0; i < 24; ++i) a.in[i] = (const float*)d_in[i];
    a.out = (float*)d_out; a.ws = (unsigned char*)d_ws; a.pad = 0;
    constexpr int NL = MK_N_LAUNCHES;
    for (int li = 0; li < NL; ++li) {
        a.ph_lo = (NL == 1) ? 0 : li; a.ph_hi = (NL == 1) ? NPHASE : li + 1; a.li = (NL == 1) ? 0 : 0;
        hipLaunchKernelGGL(mk_fwd, dim3(grid), dim3(512), LDS_BYTES, stream, a);
    }
}
```

```cpp
#include <hip/hip_runtime.h>
#include <cstdio>
#include <cstdint>

#define LAS __attribute__((address_space(3)))
typedef unsigned short bf16_t;
typedef short bf16x8 __attribute__((ext_vector_type(8)));
typedef float f32x4 __attribute__((ext_vector_type(4)));
typedef float f32x16 __attribute__((ext_vector_type(16)));
typedef unsigned u32x4 __attribute__((ext_vector_type(4)));
typedef unsigned u32x2 __attribute__((ext_vector_type(2)));

#ifndef MK_N_LAUNCHES
#define MK_N_LAUNCHES 1
#endif
#ifndef REPMASK
#define REPMASK 0x000
#endif

constexpr int D = 1024, NB = 4, SEQ = 4096, M = NB * SEQ, CTXL = 256, MC = NB * CTXL, MTOT = M + MC;
constexpr int NIN = 3072, NE = 32, TOPK = 4, FF = 1024;
constexpr int NHEAD = 4, HD = 128;
constexpr int NBLK = 17;
constexpr int ECAP = 16384;
constexpr int HROWS = 65536 + NE * 256;
constexpr float EPS = 1e-6f;

constexpr size_t MiB = 1u << 20;
constexpr size_t WS_CTL = 0, CTL_ZERO_BYTES = 1 * MiB;
constexpr size_t WS_MOD = 1 * MiB;
constexpr size_t WS_WRH = 1 * MiB + 128 * 1024;
constexpr size_t WS_WRL = 1 * MiB + 192 * 1024;
constexpr size_t WS_PE = 1 * MiB + 256 * 1024;
constexpr size_t WS_PSLOT = WS_PE + 256 * 1024;
constexpr size_t WS_PW = WS_PSLOT + 256 * 1024;
constexpr size_t WS_WIN = 2 * MiB;
constexpr size_t WS_WOUT = 8 * MiB;
constexpr size_t WS_WGU = 10 * MiB;
constexpr size_t WS_WDN = 74 * MiB;
constexpr size_t WS_HX2 = 106 * MiB;
constexpr size_t WS_HX2F = 138 * MiB;
constexpr size_t WS_U = 138 * MiB;
constexpr size_t WS_YB = 154 * MiB;
constexpr size_t WS_P = 234 * MiB;
constexpr size_t WS_X1B = 234 * MiB;
constexpr size_t WS_H = 298 * MiB;
constexpr size_t WS_HX = 336 * MiB;
constexpr size_t WS_ST = 370 * MiB;
constexpr size_t WS_DD = 405 * MiB;
constexpr size_t WS_A2 = 406 * MiB;
constexpr size_t WS_YX = 438 * MiB;
constexpr size_t WS_YXB = 470 * MiB;
constexpr size_t WS_RTOK = 502 * MiB;
constexpr size_t WS_END = 504 * MiB;
static_assert(WS_YB + (size_t)HROWS * 1024 * 2 <= WS_H && WS_H + (size_t)HROWS * 1024 <= WS_ST, "MoE buffers");
static_assert(WS_P + (size_t)MTOT * NIN * 2 <= WS_HX && WS_HX + (size_t)MTOT * D * 2 <= WS_ST && WS_ST + (size_t)32 * NBLK * 16384 * 4 <= WS_DD, "ws map");
constexpr float WSCALE = 256.0f, WSCALE_INV = 1.0f / 256.0f;

constexpr int CW_BAR = 4096;
constexpr int CW_CNT = 8192;
constexpr int CW_MT = 32768;
constexpr int CW_MOD = 12800;
constexpr int CW_CTX = 12288;

constexpr int RING_BYTES = 131072;
constexpr int LDS_TAB = RING_BYTES;
constexpr int LDS_MISC = RING_BYTES + 4096;
constexpr int LDS_BIAS = RING_BYTES + 1024;
constexpr int LDS_GOFF = RING_BYTES + 6144;
constexpr int LDS_BYTES = 155648;
static_assert(LDS_GOFF + 2 * 512 * 16 <= LDS_BYTES, "LDS map");
static_assert(8 * 16384 <= RING_BYTES, "per-wave scratch stays below the LDS tables / control words");

typedef float f32x2_ __attribute__((ext_vector_type(2)));
typedef __bf16 bf16x2_ __attribute__((ext_vector_type(2)));
__device__ __forceinline__ unsigned cvt_pk_bf16(float lo, float hi) { const bf16x2_ r = __builtin_convertvector((f32x2_){lo, hi}, bf16x2_); return __builtin_bit_cast(unsigned, r); }
__device__ __forceinline__ float bf2f(unsigned short b) { return __uint_as_float(((unsigned)b) << 16); }
__device__ __forceinline__ float bflo(unsigned w) { return __uint_as_float(w << 16); }
__device__ __forceinline__ float bfhi(unsigned w) { return __uint_as_float(w & 0xffff0000u); }
__device__ __forceinline__ unsigned short f2bf(float f) { return (unsigned short)(cvt_pk_bf16(f, 0.f) & 0xffffu); }
__device__ __forceinline__ unsigned pk4_fp8(float a, float b, float c, float d) { int w = __builtin_amdgcn_cvt_pk_fp8_f32(a, b, 0, false); w = __builtin_amdgcn_cvt_pk_fp8_f32(c, d, w, true); return (unsigned)w; }
__device__ __forceinline__ float sigmoidf_(float x) { return __builtin_amdgcn_rcpf(1.0f + __builtin_amdgcn_exp2f(-1.44269504089f * x)); }
__device__ __forceinline__ float wave_sum(float v) {
#pragma unroll
    for (int o = 1; o < 64; o <<= 1) v += __shfl_xor(v, o);
    return v;
}
#define TOUCH4(v) asm volatile("" : "+v"((v).x), "+v"((v).y), "+v"((v).z), "+v"((v).w))
#define TOUCH2(v) asm volatile("" : "+v"((v).x), "+v"((v).y))
#define LDS_WAIT() asm volatile("s_waitcnt lgkmcnt(0)" ::: "memory")
#define VM_WAIT() asm volatile("s_waitcnt vmcnt(0)" ::: "memory")
#define LSYNC() do { asm volatile("s_waitcnt lgkmcnt(0)" ::: "memory"); __builtin_amdgcn_s_barrier(); asm volatile("" ::: "memory"); } while (0)

#define XB_TMO      128
#define XB_XCNT(j)  (256  + 64 * (j))
#define XB_XSUB(j)  (1280 + 64 * (j))
#define XB_XGEN(j)  (2304 + 64 * (j))
#define XB_TOP      3328
#define XB_TOPGEN   3392
#define XCD_BAR_WORDS 3456
#define XB_SPIN_CAP (1u << 18)
__device__ __forceinline__ unsigned xb_ld(unsigned* p)              { return __hip_atomic_load(p, __ATOMIC_RELAXED, __HIP_MEMORY_SCOPE_AGENT); }
__device__ __forceinline__ unsigned xb_add(unsigned* p, unsigned v) { return __hip_atomic_fetch_add(p, v, __ATOMIC_RELAXED, __HIP_MEMORY_SCOPE_AGENT); }
__device__ __forceinline__ unsigned xb_xcc_id() { return (unsigned)__builtin_amdgcn_s_getreg((3 << 11) | 20) & 0xFu; }
#define XB_SPIN(cond, bar) do { unsigned _sp = 0; while (cond) { __builtin_amdgcn_s_sleep(1); \
    if ((++_sp & 255u) == 0u) { if (xb_ld(&(bar)[XB_TMO])) break; if (_sp > XB_SPIN_CAP) { atomicAdd(&(bar)[XB_TMO], 1u); break; } } } } while (0)
struct XcdBarrier { unsigned* bar; unsigned x; volatile LAS unsigned* st; };
__device__ __forceinline__ XcdBarrier xcd_barrier_post(unsigned* bar, volatile LAS unsigned* st) {
    XcdBarrier b; b.bar = bar; b.x = xb_xcc_id(); b.st = st;
    if (threadIdx.x == 0) (void)xb_add(&bar[XB_XCNT(b.x)], 1u);
    return b;
}
__device__ __forceinline__ void xcd_barrier_complete(unsigned* bar, unsigned x, unsigned& nloc, unsigned& nx) {
    const unsigned G = gridDim.x * gridDim.y * gridDim.z;
    unsigned sum, cnt, mine, sp = 0u;
    for (;;) {
        sum = 0u; cnt = 0u; mine = 0u;
#pragma unroll
        for (unsigned j = 0; j < 16; ++j) { const unsigned c = xb_ld(&bar[XB_XCNT(j)]); sum += c; cnt += (c > 0u) ? 1u : 0u; mine = (j == x) ? c : mine; }
        if (sum == G) break;
        __builtin_amdgcn_s_sleep(1);
        if ((++sp & 255u) == 0u) { if (xb_ld(&bar[XB_TMO])) break; if (sp > XB_SPIN_CAP) { atomicAdd(&bar[XB_TMO], 1u); break; } }
    }
    nloc = mine > 0u ? mine : 1u; nx = cnt > 0u ? cnt : 1u;
}
__device__ __forceinline__ void xcd_arrive(const XcdBarrier& b) {
    asm volatile("s_waitcnt vmcnt(0)" ::: "memory");
    __syncthreads();
    if (threadIdx.x == 0) {
        unsigned* bar = b.bar;
        __builtin_amdgcn_s_waitcnt(0);
        unsigned nloc = b.st[0], nx = b.st[1];
        if (nloc == 0u) { xcd_barrier_complete(bar, b.x, nloc, nx); b.st[0] = nloc; b.st[1] = nx; }
        const unsigned old = xb_add(&bar[XB_XSUB(b.x)], 1u);
        const unsigned gen = old / nloc;
        if (old + 1u == (gen + 1u) * nloc) {
            __builtin_amdgcn_fence(__ATOMIC_RELEASE, "agent");
            asm volatile("s_waitcnt vmcnt(0)" ::: "memory");
#pragma unroll
            for (unsigned j = 0; j < 16; ++j) (void)xb_add(&bar[XB_XGEN(j)], 1u);
        }
        b.st[2] = nx * (gen + 1u);
    }
}
__device__ __forceinline__ void xcd_wait(const XcdBarrier& b) {
    if (threadIdx.x == 0) {
        unsigned* bar = b.bar;
        const unsigned need = b.st[2];
        XB_SPIN((int)(xb_ld(&bar[XB_XGEN(b.x)]) - need) < 0, bar);
        __builtin_amdgcn_fence(__ATOMIC_ACQUIRE, "agent");
        asm volatile("s_waitcnt vmcnt(0)" ::: "memory");
    }
    __syncthreads();
}
__device__ __forceinline__ void xcd_barrier(const XcdBarrier& b) { xcd_arrive(b); xcd_wait(b); }

namespace pg8 {
constexpr int BM = 256, BK = 64, HALF = 128, HTB = HALF * BK * 2, STAGE_BYTES = 8 * HTB, NXCD = 8, WGM = 8;
__host__ __device__ __forceinline__ int lds_byte(int r, int c) { const int st = (r >> 4) * 2 + (c >> 5), rr = r & 15, cc = c & 31, ob = rr * 64 + cc * 2; return st * 1024 + (ob ^ (((ob >> 9) & 1) << 5)); }
__host__ __device__ __forceinline__ void stage_rc(int b, int& R, int& C) { const int st = b / 1024, sb = b % 1024, swz = sb ^ (((sb >> 9) & 1) << 5); R = (st >> 1) * 16 + swz / 64; C = (st & 1) * 32 + (swz % 64) / 2; }
__host__ __device__ __forceinline__ int perm32(int rho) { const int n = rho >> 4, i = rho & 15; return 8 * (i >> 2) + 4 * n + (i & 3); }

struct UnitS { const char* A; const char* B; int pm, pn; };
struct StaticOrder {
    typedef UnitS Unit;
    const char* Abase; const char* Bbase; size_t tstep;
    int nM, nN, nwg, G, c;
    __device__ void init(const void* A, const void* Bt, int M_, int N_, int K_, int G_, int c_) { Abase = (const char*)A; Bbase = (const char*)Bt; tstep = (size_t)BM * K_ * 2; nM = M_ / BM; nN = N_ / BM; nwg = nM * nN; G = G_; c = c_; }
    __device__ bool next(int i, Unit& u) const {
        const long L = (long)i * G + c; if (L >= nwg) return false;
        int wgid = (int)L; { const int q = nwg / NXCD, r = nwg % NXCD, xcd = wgid % NXCD, off = wgid / NXCD; wgid = (xcd < r ? xcd * (q + 1) : r * (q + 1) + (xcd - r) * q) + off; }
        const int nig = WGM * nN, gid = wgid / nig, fm = gid * WGM, gsz = (nM - fm) < WGM ? (nM - fm) : WGM;
        u.pm = fm + ((wgid % nig) % gsz); u.pn = (wgid % nig) / gsz;
        u.A = Abase + (size_t)u.pm * tstep; u.B = Bbase + (size_t)u.pn * tstep; return true;
    }
    static constexpr bool PUBLISH = false;
    __device__ __forceinline__ const int* row_src(const Unit&, int) const { return nullptr; }
    __device__ __forceinline__ unsigned row_tok(const Unit&, int) const { return 0u; }
    __device__ __forceinline__ void a_ready(const Unit&, int) const {}
    __device__ __forceinline__ int key(const Unit&) const { return 0; }
    __device__ __forceinline__ void publish(int) const {}
};

struct OneUnit { typedef UnitS Unit; UnitS u; static constexpr bool PUBLISH = false;
    __device__ bool next(int i, Unit& o) const { if (i) return false; o = u; return true; }
    __device__ __forceinline__ const int* row_src(const Unit&, int) const { return nullptr; } __device__ __forceinline__ unsigned row_tok(const Unit&, int) const { return 0u; }
    __device__ __forceinline__ void a_ready(const Unit&, int) const {} __device__ __forceinline__ int key(const Unit&) const { return 0; } __device__ __forceinline__ void publish(int) const {} };
struct P2Order { typedef UnitS Unit; StaticOrder S; UnitS cu; bool ctx; static constexpr bool PUBLISH = false;
    __device__ bool next(int i, Unit& o) const { if (i < 3) return S.next(i, o); if (i == 3 && ctx) { o = cu; return true; } return false; }
    __device__ __forceinline__ const int* row_src(const Unit&, int) const { return nullptr; } __device__ __forceinline__ unsigned row_tok(const Unit&, int) const { return 0u; }
    __device__ __forceinline__ void a_ready(const Unit&, int) const {} __device__ __forceinline__ int key(const Unit&) const { return 0; } __device__ __forceinline__ void publish(int) const {} };
typedef int i32x4 __attribute__((ext_vector_type(4)));
typedef int i32x8 __attribute__((ext_vector_type(8)));
template <class Epi, class Sched, bool GATHER, bool ALIGN_EPI, bool SP2, bool FP8 = false>
__device__ __forceinline__ void gemm_phase(LAS unsigned char* lds, const int K, const Sched& S, const Epi& E) {
    typedef typename Sched::Unit Unit;
    const int tid = threadIdx.x, wid = __builtin_amdgcn_readfirstlane(tid >> 6), lane = tid & 63, wr = wid >> 2, wc = wid & 3, fr = lane & 15, fq = lane >> 4;
    const int nt = K / BK;
    const size_t kstep = (size_t)(BK * 2);
    const size_t kstepB = FP8 ? (size_t)4096 : kstep;
    const size_t hstep = (size_t)HALF * K * 2;
    unsigned voffB[2], cA0[2], cA1[2];
#pragma unroll
    for (int i = 0; i < 2; ++i) { int R, C; stage_rc(tid * 16 + i * 8192, R, C); const int Rb = Epi::PERM ? ((R & ~31) + perm32(R & 31)) : R;
        voffB[i] = FP8 ? (unsigned)((Rb >> 5) * 32768 + (Rb & 31) * 128 + C * 2) : (unsigned)(Rb * K + C) * 2u; cA0[i] = (unsigned)(R * K + C) * 2u; cA1[i] = cA0[i] + (unsigned)hstep; }
#define gro(p, v) ((LAS unsigned*)(lds + LDS_GOFF + (p) * 8192 + (v) * 2048 + tid * 4))
    int gp = 0;
    unsigned gcc[2] = {0u, 0u};
    if constexpr (GATHER) { int R, C; stage_rc(tid * 16, R, C); gcc[0] = (unsigned)C * 2u; stage_rc(tid * 16 + 8192, R, C); gcc[1] = (unsigned)C * 2u; }
    const unsigned ldsw = (unsigned)wid * 1024u;
    const int aoff = lds_byte(wr * 64 + fr, fq * 8), boff = lds_byte(wc * 32 + fr, fq * 8);
#define PG8_SA(b, h) (((b) * 2 + (h)) * HTB)
#define PG8_SB(b, h) ((4 + (b) * 2 + (h)) * HTB)
#define PG8_STAGE(bufoff, gbase, voff) do { _Pragma("unroll") for (int _i = 0; _i < 2; ++_i) \
        __builtin_amdgcn_global_load_lds((const unsigned*)((const char*)(gbase) + (voff)[_i]), (LAS unsigned*)(lds + (bufoff) + ldsw + _i * 8192), 16, 0, 0); } while (0)
#define PG8_LDA(dst, b, h) do { _Pragma("unroll") for (int m = 0; m < 4; ++m) { const i32x4 _p0 = *(const LAS i32x4*)(lds + PG8_SA(b, h) + aoff + m * 2048), _p1 = *(const LAS i32x4*)(lds + PG8_SA(b, h) + aoff + m * 2048 + 1024); \
        dst[m] = __builtin_shufflevector(_p0, _p1, 0, 1, 2, 3, 4, 5, 6, 7); } } while (0)
#define PG8_LDB(dst, b, h) do { _Pragma("unroll") for (int n = 0; n < 2; ++n) { const i32x4 _p0 = *(const LAS i32x4*)(lds + PG8_SB(b, h) + boff + n * 2048), _p1 = *(const LAS i32x4*)(lds + PG8_SB(b, h) + boff + n * 2048 + 1024); \
        dst[n] = __builtin_shufflevector(_p0, _p1, 0, 1, 2, 3, 4, 5, 6, 7); } } while (0)
#define PG8_ACC(ai, bj, m, n) ((n) ? __builtin_shufflevector(acc[ai][bj][m], acc[ai][bj][m], 4, 5, 6, 7) : __builtin_shufflevector(acc[ai][bj][m], acc[ai][bj][m], 0, 1, 2, 3))
#define PG8_SETACC(ai, bj, m, n, v) do { const f32x4 _v = (v); if (n) acc[ai][bj][m] = __builtin_shufflevector(acc[ai][bj][m], __builtin_shufflevector(_v, _v, 0, 1, 2, 3, 0, 1, 2, 3), 0, 1, 2, 3, 12, 13, 14, 15); \
        else acc[ai][bj][m] = __builtin_shufflevector(acc[ai][bj][m], __builtin_shufflevector(_v, _v, 0, 1, 2, 3, 0, 1, 2, 3), 8, 9, 10, 11, 4, 5, 6, 7); } while (0)
#define PG8_MMA(ai, bj, At, Bt) do { __builtin_amdgcn_s_setprio(1); _Pragma("unroll") for (int m = 0; m < 4; ++m) _Pragma("unroll") for (int n = 0; n < 2; ++n) { \
        if constexpr (FP8) { PG8_SETACC(ai, bj, m, n, __builtin_amdgcn_mfma_scale_f32_16x16x128_f8f6f4(Bt[n], At[m], PG8_ACC(ai, bj, m, n), 0, 0, 0, 127, 0, 127)); } \
        else { f32x4 _c = __builtin_amdgcn_mfma_f32_16x16x32_bf16(__builtin_bit_cast(bf16x8, __builtin_shufflevector(Bt[n], Bt[n], 0, 1, 2, 3)), __builtin_bit_cast(bf16x8, __builtin_shufflevector(At[m], At[m], 0, 1, 2, 3)), PG8_ACC(ai, bj, m, n), 0, 0, 0); \
               PG8_SETACC(ai, bj, m, n, __builtin_amdgcn_mfma_f32_16x16x32_bf16(__builtin_bit_cast(bf16x8, __builtin_shufflevector(Bt[n], Bt[n], 4, 5, 6, 7)), __builtin_bit_cast(bf16x8, __builtin_shufflevector(At[m], At[m], 4, 5, 6, 7)), _c, 0, 0, 0)); } } \
        __builtin_amdgcn_s_setprio(0); } while (0)
#define PG8_WAIT_V(n) asm volatile("s_waitcnt vmcnt(" #n ")" ::: "memory")
#define PG8_WAIT_L(n) asm volatile("s_waitcnt lgkmcnt(" #n ")" ::: "memory")
#define PG8_BAR __builtin_amdgcn_s_barrier()
#define PG8_SCHED __builtin_amdgcn_sched_barrier(0)
    Unit cur, nxt; int ui = 0; int pkey = 0;
    if (!S.next(0, cur)) return;
    S.a_ready(cur, wid);
    if constexpr (GATHER) {
#pragma unroll
        for (int i = 0; i < 2; ++i) { int R, C; int t2 = tid; asm volatile("" : "+v"(t2)); stage_rc(t2 * 16 + i * 8192, R, C);
            const unsigned r0 = S.row_tok(cur, R), r1 = S.row_tok(cur, HALF + R); *gro(0, i) = r0; *gro(0, 2 + i) = r1;
            cA0[i] = r0 + (unsigned)C * 2u; cA1[i] = r1 + (unsigned)C * 2u; }
    }
    typedef float f32x8_ __attribute__((ext_vector_type(8)));
    f32x8_ acc[2][2][4];
    float zero_; asm volatile("v_mov_b32 %0, 0" : "=v"(zero_));
#pragma unroll
    for (int a = 0; a < 2; ++a)
#pragma unroll
        for (int b = 0; b < 2; ++b)
#pragma unroll
            for (int m = 0; m < 4; ++m) acc[a][b][m] = (f32x8_){zero_, zero_, zero_, zero_, zero_, zero_, zero_, zero_};
    i32x8 At[4], B0[2], B1[2];
    const char* cA = cur.A; const char* cB = cur.B;
    if constexpr (Epi::LDS_BIAS) E.stage_bias(cur, lds + LDS_BIAS, wid, lane);
    if constexpr (SP2) {
        PG8_STAGE(PG8_SB(0, 0), cB, voffB); PG8_STAGE(PG8_SB(0, 1), cB + hstep, voffB); PG8_STAGE(PG8_SA(0, 0), cA, cA0); PG8_STAGE(PG8_SA(0, 1), cA, cA1);
        if (wr == 1) PG8_BAR;
        PG8_WAIT_V(2); PG8_BAR;
        PG8_STAGE(PG8_SB(1, 0), cB + kstepB, voffB); PG8_STAGE(PG8_SA(1, 0), cA + kstep, cA0); PG8_STAGE(PG8_SB(1, 1), cB + hstep + kstepB, voffB);
        PG8_WAIT_V(6); PG8_BAR;
    } else {
        PG8_STAGE(PG8_SB(0, 0), cB, voffB); PG8_STAGE(PG8_SA(0, 0), cA, cA0); PG8_STAGE(PG8_SB(0, 1), cB + hstep, voffB); PG8_STAGE(PG8_SA(0, 1), cA, cA1);
        if (wr == 1) PG8_BAR;
        PG8_WAIT_V(4); PG8_BAR;
        PG8_STAGE(PG8_SB(1, 0), cB + kstepB, voffB); PG8_STAGE(PG8_SA(1, 0), cA + kstep, cA0); PG8_STAGE(PG8_SB(1, 1), cB + hstep + kstepB, voffB);
        PG8_WAIT_V(6); PG8_BAR;
    }
    for (;;) {
        const bool has_next = S.next(ui + 1, nxt);
        const char* nA = has_next ? nxt.A : cA; const char* nB = has_next ? nxt.B : cB;
        if constexpr (GATHER) {
            if (has_next) {
                int R0, C0, R1, C1; int t2 = tid; asm volatile("" : "+v"(t2)); stage_rc(t2 * 16, R0, C0); stage_rc(t2 * 16 + 8192, R1, C1);
                LAS unsigned char* gb = lds + LDS_GOFF + (gp ^ 1) * 8192 + wid * 256;
                __builtin_amdgcn_global_load_lds((const unsigned*)S.row_src(nxt, R0), (LAS unsigned*)(gb), 4, 0, 0);
                __builtin_amdgcn_global_load_lds((const unsigned*)S.row_src(nxt, R1), (LAS unsigned*)(gb + 2048), 4, 0, 0);
                __builtin_amdgcn_global_load_lds((const unsigned*)S.row_src(nxt, HALF + R0), (LAS unsigned*)(gb + 4096), 4, 0, 0);
                __builtin_amdgcn_global_load_lds((const unsigned*)S.row_src(nxt, HALF + R1), (LAS unsigned*)(gb + 6144), 4, 0, 0);
            }
        }
#pragma unroll 1
        for (int t = 0; t < nt; t += 2) {
            const bool last = (t == nt - 2);
            if (last && has_next) S.a_ready(nxt, wid);
            const char* a1 = cA + (size_t)(t + 1) * kstep;
            const char* a2 = last ? nA : cA + (size_t)(t + 2) * kstep; const char* b2 = last ? nB : cB + (size_t)(t + 2) * kstepB;
            const char* a3 = a2 + kstep; const char* b3 = b2 + kstepB;
            const int gq = (last && has_next) ? (gp ^ 1) : gp;
#define PG8_GO(p, v, dst) unsigned dst[2]; if constexpr (GATHER) { dst[0] = *gro(p, v) + gcc[0]; dst[1] = *gro(p, (v) + 1) + gcc[1]; } else { dst[0] = ((v) ? cA1 : cA0)[0]; dst[1] = ((v) ? cA1 : cA0)[1]; }
            if constexpr (SP2) {
            { PG8_GO(gp, 2, y1); PG8_LDB(B0, 0, 0); PG8_LDB(B1, 0, 1); PG8_SCHED; PG8_LDA(At, 0, 0); PG8_STAGE(PG8_SA(1, 1), a1, y1); }
            PG8_WAIT_V(8); PG8_WAIT_L(0); PG8_BAR; PG8_MMA(0, 0, At, B0); PG8_MMA(0, 1, At, B1); PG8_BAR; PG8_SCHED;
            { PG8_GO(gq, 0, x0); PG8_LDA(At, 0, 1); PG8_STAGE(PG8_SB(0, 0), b2, voffB); PG8_STAGE(PG8_SB(0, 1), b2 + hstep, voffB); PG8_STAGE(PG8_SA(0, 0), a2, x0); }
            PG8_WAIT_V(8); PG8_WAIT_L(0); PG8_BAR; PG8_MMA(1, 0, At, B0); PG8_MMA(1, 1, At, B1); PG8_BAR; PG8_SCHED;
            { PG8_GO(gq, 2, x1); PG8_LDB(B0, 1, 0); PG8_LDB(B1, 1, 1); PG8_SCHED; PG8_LDA(At, 1, 0); PG8_STAGE(PG8_SA(0, 1), a2, x1); }
            PG8_WAIT_V(8); PG8_WAIT_L(0); PG8_BAR; PG8_MMA(0, 0, At, B0); PG8_MMA(0, 1, At, B1); PG8_BAR; PG8_SCHED;
            { PG8_GO(gq, 0, x0); PG8_LDA(At, 1, 1); PG8_STAGE(PG8_SB(1, 0), b3, voffB); PG8_STAGE(PG8_SB(1, 1), b3 + hstep, voffB); PG8_STAGE(PG8_SA(1, 0), a3, x0); }
            PG8_WAIT_V(8); PG8_WAIT_L(0); PG8_BAR; PG8_MMA(1, 0, At, B0); PG8_MMA(1, 1, At, B1); PG8_BAR; PG8_SCHED;
            } else {
            PG8_GO(gp, 2, y1); PG8_GO(gq, 0, x0); PG8_GO(gq, 2, x1);
            PG8_LDB(B0, 0, 0); PG8_SCHED; PG8_LDA(At, 0, 0); PG8_STAGE(PG8_SA(1, 1), a1, y1);
            PG8_WAIT_L(8); PG8_BAR; PG8_WAIT_L(0); PG8_MMA(0, 0, At, B0); PG8_BAR; PG8_SCHED;
            PG8_LDB(B1, 0, 1); PG8_STAGE(PG8_SB(0, 0), b2, voffB);
            PG8_BAR; PG8_WAIT_L(0); PG8_MMA(0, 1, At, B1); PG8_BAR;
            PG8_LDA(At, 0, 1); PG8_STAGE(PG8_SA(0, 0), a2, x0);
            PG8_BAR; PG8_WAIT_L(0); PG8_MMA(1, 0, At, B0); PG8_BAR; PG8_SCHED;
            PG8_STAGE(PG8_SB(0, 1), b2 + hstep, voffB);
            PG8_WAIT_V(6); PG8_BAR; PG8_MMA(1, 1, At, B1); PG8_BAR;
            PG8_LDB(B0, 1, 0); PG8_SCHED; PG8_LDA(At, 1, 0); PG8_STAGE(PG8_SA(0, 1), a2, x1);
            PG8_WAIT_L(8); PG8_BAR; PG8_WAIT_L(0); PG8_MMA(0, 0, At, B0); PG8_BAR; PG8_SCHED;
            PG8_LDB(B1, 1, 1); PG8_STAGE(PG8_SB(1, 0), b3, voffB);
            PG8_BAR; PG8_WAIT_L(0); PG8_MMA(0, 1, At, B1); PG8_BAR;
            PG8_LDA(At, 1, 1); PG8_STAGE(PG8_SA(1, 0), a3, x0);
            PG8_BAR; PG8_WAIT_L(0); PG8_MMA(1, 0, At, B0); PG8_BAR; PG8_SCHED;
            PG8_STAGE(PG8_SB(1, 1), b3 + hstep, voffB);
            PG8_WAIT_V(6); PG8_BAR; PG8_MMA(1, 1, At, B1); PG8_BAR;
            }
        }
        if constexpr (ALIGN_EPI) { if (wr == 0) PG8_BAR; }
        asm volatile("" ::: "memory");
        if constexpr (Sched::PUBLISH) { if (ui > 0) S.publish(pkey); }
        { f32x4 av[2][2][4][2];
#pragma unroll
          for (int a = 0; a < 2; ++a)
#pragma unroll
              for (int b = 0; b < 2; ++b)
#pragma unroll
                  for (int m = 0; m < 4; ++m) { av[a][b][m][0] = PG8_ACC(a, b, m, 0); av[a][b][m][1] = PG8_ACC(a, b, m, 1); }
          int t3 = tid; asm volatile("" : "+v"(t3)); const int fr3 = t3 & 15, fq3 = (t3 & 63) >> 4;
          if constexpr (Epi::LDS_BIAS) E(av, cur, wr, wc, fr3, fq3, lds + LDS_BIAS + (ui & 1) * 1024); else E(av, cur, wr, wc, fr3, fq3); }
        if constexpr (Sched::PUBLISH) { pkey = S.key(cur); if (!has_next) S.publish(pkey); }
        if (!has_next) break;
#pragma unroll
        for (int a = 0; a < 2; ++a)
#pragma unroll
            for (int b = 0; b < 2; ++b)
#pragma unroll
                for (int m = 0; m < 4; ++m) acc[a][b][m] = (f32x8_){zero_, zero_, zero_, zero_, zero_, zero_, zero_, zero_};
        cur = nxt; cA = nA; cB = nB; ++ui;
        if constexpr (Epi::LDS_BIAS) E.stage_bias(cur, lds + LDS_BIAS + (ui & 1) * 1024, wid, lane);
        if constexpr (GATHER) gp ^= 1;
        if constexpr (ALIGN_EPI) { if (wr == 1) PG8_BAR; }
    }
    PG8_WAIT_V(0);
    if constexpr (!ALIGN_EPI) { if (wr == 0) PG8_BAR; }
    PG8_BAR;
#undef PG8_SA
#undef PG8_SB
#undef PG8_STAGE
#undef PG8_LDA
#undef PG8_LDB
#undef PG8_MMA
#undef gro
#undef PG8_GO
#undef PG8_ACC
#undef PG8_SETACC
#undef PG8_WAIT_V
#undef PG8_WAIT_L
#undef PG8_BAR
#undef PG8_SCHED
}
}

struct EpiInProj {
    static constexpr bool PERM = true, LDS_BIAS = false;
    bf16_t* P; const float* lbl; bf16_t* U; const float* gain;
    __device__ __forceinline__ void operator()(const f32x4 (&acc)[2][2][4][2], const pg8::UnitS& u, int wr, int wc, int fr, int fq) const {
        typedef float f32x2 __attribute__((ext_vector_type(2)));
        const int row0 = u.pm * 256 + wr * 64 + fr, col0 = u.pn * 256 + wc * 32 + 8 * fq, type = u.pn >> 1;
        f32x2 lbv[2][4], olb[2][4];
#pragma unroll
        for (int bj = 0; bj < 2; ++bj)
#pragma unroll
            for (int p = 0; p < 4; ++p) { lbv[bj][p] = (f32x2){0.f, 0.f}; olb[bj][p] = (f32x2){1.f, 1.f}; }
        if (type == 4) {
#pragma unroll
            for (int bj = 0; bj < 2; ++bj) { const int ch = col0 + bj * 128 - 2048;
#pragma unroll
                for (int p = 0; p < 4; ++p) { lbv[bj][p].x = gain[ch + 2 * p]; lbv[bj][p].y = gain[ch + 2 * p + 1]; } }
#pragma unroll
            for (int bj = 0; bj < 2; ++bj)
#pragma unroll
                for (int p = 0; p < 4; ++p) TOUCH2(lbv[bj][p]);
        }
        if (type == 1 || type == 2) {
#pragma unroll
            for (int bj = 0; bj < 2; ++bj) { const int ch = col0 + bj * 128 - 512;
#pragma unroll
                for (int p = 0; p < 4; ++p) { lbv[bj][p].x = sigmoidf_(lbl[ch + 2 * p] - lbl[1024 + ch + 2 * p]); lbv[bj][p].y = sigmoidf_(lbl[ch + 2 * p + 1] - lbl[1024 + ch + 2 * p + 1]); olb[bj][p] = 1.0f - lbv[bj][p]; } }
        }
#pragma unroll
        for (int ai = 0; ai < 2; ++ai)
#pragma unroll
            for (int m = 0; m < 4; ++m) { bf16_t* rowp = P + (size_t)(row0 + ai * 128 + m * 16) * NIN + col0;
#pragma unroll
                for (int bj = 0; bj < 2; ++bj) { f32x2 v[4];
#pragma unroll
                    for (int p = 0; p < 4; ++p) { const f32x4 a = acc[ai][bj][m][p >> 1]; v[p] = (p & 1) ? (f32x2){a.z, a.w} : (f32x2){a.x, a.y}; }
                    if (type == 0 || type == 1 || type == 2 || type == 4) {
#pragma unroll
                        for (int p = 0; p < 4; ++p) { const f32x2 ea = v[p] * (-1.44269504089f);
                            f32x2 t; t.x = __builtin_amdgcn_exp2f(ea.x); t.y = __builtin_amdgcn_exp2f(ea.y); t = t + 1.0f;
                            f32x2 sg; sg.x = __builtin_amdgcn_rcpf(t.x); sg.y = __builtin_amdgcn_rcpf(t.y);
                            if (type == 0) v[p] = v[p] * sg;
                            else if (type == 4) v[p] = sg * lbv[bj][p];
                            else { const f32x2 f = sg * olb[bj][p] + lbv[bj][p]; f32x2 lg; lg.x = __builtin_amdgcn_logf(f.x); lg.y = __builtin_amdgcn_logf(f.y); v[p] = lg; } }
                    }
                    u32x4 w; w.x = cvt_pk_bf16(v[0].x, v[0].y); w.y = cvt_pk_bf16(v[1].x, v[1].y); w.z = cvt_pk_bf16(v[2].x, v[2].y); w.w = cvt_pk_bf16(v[3].x, v[3].y);
                    if (type == 5) { const int row = row0 + ai * 128 + m * 16, slab = (col0 + bj * 128 - 2560) >> 3;
                        *(u32x4*)(U + ((size_t)((row >> 12) * 64 + slab) * 4096 + (row & 4095)) * 8) = w; }
                    else *(u32x4*)(rowp + bj * 128) = w; } }
    }
};
struct EpiBf16Out {
    static constexpr bool PERM = true, LDS_BIAS = false;
    bf16_t* C; int ldc;
    __device__ __forceinline__ void operator()(const f32x4 (&acc)[2][2][4][2], const pg8::UnitS& u, int wr, int wc, int fr, int fq) const {
        const int row0 = u.pm * 256 + wr * 64 + fr, col0 = u.pn * 256 + wc * 32 + 8 * fq;
#pragma unroll
        for (int ai = 0; ai < 2; ++ai)
#pragma unroll
            for (int m = 0; m < 4; ++m) { bf16_t* rowp = C + (size_t)(row0 + ai * 128 + m * 16) * ldc + col0;
#pragma unroll
                for (int bj = 0; bj < 2; ++bj) { const f32x4 v0 = acc[ai][bj][m][0], v1 = acc[ai][bj][m][1];
                    u32x4 w; w.x = cvt_pk_bf16(v0[0], v0[1]); w.y = cvt_pk_bf16(v0[2], v0[3]); w.z = cvt_pk_bf16(v1[0], v1[1]); w.w = cvt_pk_bf16(v1[2], v1[3]);
                    *(u32x4*)(rowp + bj * 128) = w; } }
    }
};

struct UnitM { const char* A; const char* B; int e, mt, pn, row0, cnt; };
typedef int i32x4_ __attribute__((ext_vector_type(4)));
template <int NT_, bool GATHER_>
struct MoeOrder {
    typedef UnitM Unit;
    static constexpr int pitch = 1024; static constexpr size_t wstride = (size_t)NT_ * 256 * 1024;
    const LAS int* tab;
    const char* Abase; const char* Wbase; const int* rtok;
    unsigned* mtc;
    int cls, rank, nrank;
    static constexpr bool PUBLISH = GATHER_;
    __device__ __forceinline__ int key(const Unit& u) const { return u.row0 >> 8; }
    __device__ __forceinline__ void publish(int k) const {
        asm volatile("s_waitcnt vmcnt(0)" ::: "memory");
        if ((threadIdx.x & 63) == 0) __hip_atomic_fetch_add(mtc + 64 * k, 1u, __ATOMIC_RELAXED, __HIP_MEMORY_SCOPE_AGENT);
    }
    __device__ __forceinline__ void a_ready(const Unit& u, int wid) const {
        if constexpr (!GATHER_) {
            if (wid == 0) { unsigned sp = 0;
                while ((unsigned)__builtin_amdgcn_readfirstlane(__hip_atomic_load(mtc + 64 * (u.row0 >> 8), __ATOMIC_RELAXED, __HIP_MEMORY_SCOPE_AGENT)) < 64u) { __builtin_amdgcn_s_sleep(2); if (++sp > (1u << 22)) break; }
                __builtin_amdgcn_fence(__ATOMIC_ACQUIRE, "agent");
                asm volatile("s_waitcnt vmcnt(0)" ::: "memory"); }
            asm volatile("" ::: "memory"); __builtin_amdgcn_s_barrier(); asm volatile("" ::: "memory");
        }
    }
    __device__ bool next(int i, Unit& u) const {
        const int L = i * nrank + rank; const int mtg = L / NT_; u.pn = L - mtg * NT_;
        if (mtg >= __builtin_amdgcn_readfirstlane(tab[64])) return false;
        int ecount = 0;
#pragma unroll
        for (int q = 0; q < 8; ++q) { const i32x4_ p4 = *(const LAS i32x4_*)(tab + 32 + 4 * q); const int row = mtg * 256;
            ecount += (p4.x <= row) + (p4.y <= row) + (p4.z <= row) + (p4.w <= row); }
        const int e = __builtin_amdgcn_readfirstlane(ecount) - 1;
        const int pb = __builtin_amdgcn_readfirstlane(tab[32 + e]);
        u.e = e; u.mt = mtg - (pb >> 8); u.cnt = __builtin_amdgcn_readfirstlane(tab[e]); u.row0 = mtg * 256;
        u.B = Wbase + (size_t)e * wstride + (size_t)u.pn * 256 * pitch;
        u.A = GATHER_ ? Abase : Abase + (size_t)u.row0 * pitch;
        return true;
    }
    __device__ __forceinline__ const int* row_src(const Unit& u, int r) const { const int slot = u.mt * 256 + r; return rtok + u.e * ECAP + (slot < u.cnt ? slot : 0); }
    __device__ __forceinline__ unsigned row_tok(const Unit& u, int r) const { return (unsigned)*row_src(u, r); }
};
struct EpiGateUp {
    static constexpr bool PERM = true, LDS_BIAS = true;
    unsigned char* H; const float* bg; const float* bu;
    __device__ __forceinline__ void stage_bias(const UnitM& u, LAS unsigned char* dst, int wid, int lane) const {
        if (wid < 4) { const float* src = ((wid & 2) ? bu : bg) + u.e * FF + u.pn * 128 + (wid & 1) * 64 + lane;
            __builtin_amdgcn_global_load_lds((const unsigned*)src, (LAS unsigned*)(dst + wid * 256), 4, 0, 0); }
    }
    __device__ __forceinline__ void operator()(const f32x4 (&acc)[2][2][4][2], const UnitM& u, int wr, int wc, int fr, int fq, const LAS unsigned char* lb) const {
        typedef float f32x2 __attribute__((ext_vector_type(2)));
        const int row0 = u.row0 + wr * 64 + fr, col0 = u.pn * 128 + wc * 32 + 8 * fq;
        const f32x4 g0 = *(const LAS f32x4*)(lb + (wc * 32 + 8 * fq) * 4), g1 = *(const LAS f32x4*)(lb + (wc * 32 + 8 * fq + 4) * 4);
        const f32x4 u0 = *(const LAS f32x4*)(lb + 512 + (wc * 32 + 8 * fq) * 4), u1 = *(const LAS f32x4*)(lb + 512 + (wc * 32 + 8 * fq + 4) * 4);
        const f32x2 gb[4] = {{g0.x, g0.y}, {g0.z, g0.w}, {g1.x, g1.y}, {g1.z, g1.w}}, ub[4] = {{u0.x + 1.0f, u0.y + 1.0f}, {u0.z + 1.0f, u0.w + 1.0f}, {u1.x + 1.0f, u1.y + 1.0f}, {u1.z + 1.0f, u1.w + 1.0f}};
        unsigned pw0 = 0u, pw1 = 0u;
#pragma unroll
        for (int ai = 0; ai < 2; ++ai)
#pragma unroll
            for (int m = 0; m < 4; ++m) { f32x2 h[4];
#pragma unroll
                for (int p = 0; p < 4; ++p) {
                    const f32x4 ag = acc[ai][0][m][p >> 1], au = acc[ai][1][m][p >> 1];
                    f32x2 g = (p & 1) ? (f32x2){ag.z, ag.w} : (f32x2){ag.x, ag.y}, up1 = (p & 1) ? (f32x2){au.z, au.w} : (f32x2){au.x, au.y};
                    g = g * WSCALE_INV + gb[p]; up1 = up1 * WSCALE_INV + ub[p];
                    g.x = fminf(g.x, 7.0f); g.y = fminf(g.y, 7.0f);
                    up1.x = __builtin_amdgcn_fmed3f(up1.x, -6.0f, 8.0f); up1.y = __builtin_amdgcn_fmed3f(up1.y, -6.0f, 8.0f);
                    const f32x2 ea = g * (-1.702f * 1.44269504089f);
                    f32x2 t; t.x = __builtin_amdgcn_exp2f(ea.x); t.y = __builtin_amdgcn_exp2f(ea.y);
                    t = t + 1.0f;
                    f32x2 sg; sg.x = __builtin_amdgcn_rcpf(t.x); sg.y = __builtin_amdgcn_rcpf(t.y);
                    h[p] = (up1 * g) * sg; }
                const unsigned w0 = pk4_fp8(h[0].x, h[0].y, h[1].x, h[1].y), w1 = pk4_fp8(h[2].x, h[2].y, h[3].x, h[3].y);
                if ((m & 1) == 0) { pw0 = w0; pw1 = w1; }
                else { const auto r0 = __builtin_amdgcn_permlane16_swap(pw0, w0, false, false), r1 = __builtin_amdgcn_permlane16_swap(pw1, w1, false, false);
                    u32x4 wv; wv.x = r0[0]; wv.y = r1[0]; wv.z = r0[1]; wv.w = r1[1];
                    const unsigned long long ad = (unsigned long long)(H + (size_t)(row0 + ai * 128 + (m - 1 + (fq & 1)) * 16) * FF + col0 - 8 * (fq & 1));
                    asm volatile("global_store_dwordx4 %0, %1, off sc1\n\ts_nop 2" :: "v"(ad), "v"(wv) : "memory"); } }
    }
};
struct EpiDown {
    static constexpr bool PERM = true, LDS_BIAS = true;
    unsigned char* Y; const float* bd;
    __device__ __forceinline__ void stage_bias(const UnitM& u, LAS unsigned char* dst, int wid, int lane) const {
        if (wid < 4) { const float* src = bd + u.e * D + u.pn * 256 + wid * 64 + lane;
            __builtin_amdgcn_global_load_lds((const unsigned*)src, (LAS unsigned*)(dst + wid * 256), 4, 0, 0); }
    }
    __device__ __forceinline__ void operator()(const f32x4 (&acc)[2][2][4][2], const UnitM& u, int wr, int wc, int fr, int fq, const LAS unsigned char* lb) const {
        const int row0 = u.row0 + wr * 64 + fr, col0 = u.pn * 256 + wc * 32 + 8 * fq;
        f32x4 b8[2][2];
#pragma unroll
        for (int bj = 0; bj < 2; ++bj) { b8[bj][0] = *(const LAS f32x4*)(lb + (bj * 128 + wc * 32 + 8 * fq) * 4); b8[bj][1] = *(const LAS f32x4*)(lb + (bj * 128 + wc * 32 + 8 * fq + 4) * 4); }
        u32x2 pw[2];
#pragma unroll
        for (int ai = 0; ai < 2; ++ai)
#pragma unroll
            for (int m = 0; m < 4; ++m)
#pragma unroll
                for (int bj = 0; bj < 2; ++bj) { const f32x4 v0 = acc[ai][bj][m][0] * WSCALE_INV + b8[bj][0], v1 = acc[ai][bj][m][1] * WSCALE_INV + b8[bj][1];
                    u32x2 w; w.x = pk4_fp8(v0.x, v0.y, v0.z, v0.w); w.y = pk4_fp8(v1.x, v1.y, v1.z, v1.w);
                    if ((m & 1) == 0) pw[bj] = w;
                    else { const auto r0 = __builtin_amdgcn_permlane16_swap(pw[bj].x, w.x, false, false), r1 = __builtin_amdgcn_permlane16_swap(pw[bj].y, w.y, false, false);
                        u32x4 wv; wv.x = r0[0]; wv.y = r1[0]; wv.z = r0[1]; wv.w = r1[1];
                        *(u32x4*)(Y + (size_t)(row0 + ai * 128 + (m - 1 + (fq & 1)) * 16) * D + col0 - 8 * (fq & 1) + bj * 128) = wv; } }
    }
};

struct Args { const float* in[24]; float* out; unsigned char* ws; int ph_lo, ph_hi, li, pad; };
struct Frame {
    LAS unsigned char* lds; unsigned char* ws; unsigned* ctl;
    int tid, lane, wave, G, bid;
};

struct TItem { const float* src; unsigned char* dst; int ldw, k0, n0, drow0; };
template <int NL> __device__ __forceinline__ void titem_load(const TItem& t, float (&tv)[NL], int lane) {
    const float* wp = t.src + (size_t)(t.k0 + (lane >> 5)) * t.ldw + t.n0 + (lane & 31);
#pragma unroll
    for (int i = 0; i < NL; ++i) tv[i] = wp[(size_t)(2 * i) * t.ldw];
}
__device__ __forceinline__ void titem_finish_bf16(const TItem& t, const float (&tv)[32], LAS float* scr, int lane) {
#pragma unroll
    for (int i = 0; i < 32; ++i) scr[(2 * i + (lane >> 5)) * 33 + (lane & 31)] = tv[i];
    LDS_WAIT(); asm volatile("" ::: "memory");
    const int c = lane & 7;
#pragma unroll
    for (int j = 0; j < 4; ++j) { const int n = (lane >> 3) + 8 * j; const LAS float* s = scr + (8 * c) * 33 + n;
        u32x4 o; o.x = cvt_pk_bf16(s[0 * 33], s[1 * 33]); o.y = cvt_pk_bf16(s[2 * 33], s[3 * 33]); o.z = cvt_pk_bf16(s[4 * 33], s[5 * 33]); o.w = cvt_pk_bf16(s[6 * 33], s[7 * 33]);
        *(u32x4*)(t.dst + ((size_t)(t.drow0 + n) * 1024 + t.k0 + 8 * c) * 2) = o; }
    LDS_WAIT(); asm volatile("" ::: "memory");
}
__device__ __forceinline__ void titem_load_fp8(const TItem& t, f32x4 (&tv)[16], int lane) {
    const float* wp = t.src + (size_t)(t.k0 + (lane >> 3)) * t.ldw + t.n0 + 4 * (lane & 7);
#pragma unroll
    for (int i = 0; i < 16; ++i) tv[i] = __builtin_nontemporal_load((const f32x4*)(wp + (size_t)(8 * i) * t.ldw));
}
__device__ __forceinline__ void titem_finish_fp8(const TItem& t, const f32x4 (&tv)[16], LAS float* scr, int lane) {
#pragma unroll
    for (int i = 0; i < 16; ++i) { const int row = 8 * i + (lane >> 3); *(LAS f32x4*)(scr + row * 32 + ((4 * (lane & 7)) ^ ((8 * (row >> 4)) & 31))) = tv[i] * WSCALE; }
    LDS_WAIT(); asm volatile("" ::: "memory");
    const int c = lane & 7;
#pragma unroll
    for (int j = 0; j < 4; ++j) { const int n = (lane >> 3) + 8 * j; const LAS float* s = scr + (16 * c) * 32 + (n ^ ((8 * c) & 31));
        u32x4 o; o.x = pk4_fp8(s[0 * 32], s[1 * 32], s[2 * 32], s[3 * 32]); o.y = pk4_fp8(s[4 * 32], s[5 * 32], s[6 * 32], s[7 * 32]);
        o.z = pk4_fp8(s[8 * 32], s[9 * 32], s[10 * 32], s[11 * 32]); o.w = pk4_fp8(s[12 * 32], s[13 * 32], s[14 * 32], s[15 * 32]);
        __builtin_nontemporal_store(o, (u32x4*)(t.dst + (size_t)(t.drow0 >> 5) * 32768 + (size_t)(t.k0 >> 7) * 4096 + n * 128 + 16 * c)); }
    LDS_WAIT(); asm volatile("" ::: "memory");
}
constexpr int TI_IN = 16 * 96, TI_OUT = 8 * 32, TI_E = 8 * 32, TI_EALL = NE * 3 * TI_E;
constexpr int TSCR = 16384;
__device__ __forceinline__ void transpose_items_bf16(const Frame& F, const Args& a, int gw, int NGW, int it0, int it1) {
    const float* w_in = a.in[10]; const float* w_out = a.in[11];
    LAS float* scr = (LAS float*)(F.lds + F.wave * TSCR);
    for (int it = it0 + gw; it < it1; it += NGW) {
        TItem t; float tv[32];
        if (it < TI_IN) { const int kb = it / 96, nb = it % 96; t = TItem{w_in, F.ws + WS_WIN, NIN, kb * 64, nb * 32, nb * 32}; }
        else { const int r = it - TI_IN, kb = r / 32, nb = r % 32; t = TItem{w_out, F.ws + WS_WOUT, 1024, kb * 64, nb * 32, nb * 32}; }
        titem_load<32>(t, tv, F.lane); titem_finish_bf16(t, tv, scr, F.lane);
    }
}
__device__ __forceinline__ void transpose_items_fp8(const Frame& F, const Args& a, int gw, int NGW, int k0, int k1) {
    const float* w_gate = a.in[18]; const float* w_up = a.in[20]; const float* w_down = a.in[22];
    unsigned char* WGU = F.ws + WS_WGU; unsigned char* WDN = F.ws + WS_WDN;
    LAS float* scr = (LAS float*)(F.lds + F.wave * TSCR);
    auto decode = [&](int r, TItem& t) {
        const int e = r / (3 * TI_E), r2 = r % (3 * TI_E), mat = r2 / TI_E, r3 = r2 % TI_E, kb = r3 / 32, nb = r3 % 32, n0 = nb * 32;
        if (mat == 2) t = TItem{w_down + (size_t)e * 1048576, WDN + (size_t)e * 1048576, 1024, kb * 128, n0, n0};
        else t = TItem{(mat == 0 ? w_gate : w_up) + (size_t)e * 1048576, WGU + (size_t)e * 2097152, 1024, kb * 128, n0, 256 * (n0 >> 7) + mat * 128 + (n0 & 127)};
    };
    for (int k = k0; k < k1; ++k) { const int it = gw + k * NGW; if (it >= TI_EALL) break;
        TItem t; f32x4 tv[16]; decode(it, t); titem_load_fp8(t, tv, F.lane); titem_finish_fp8(t, tv, scr, F.lane); }
}
__device__ __forceinline__ void p0_prologue(const Frame& F, const Args& a) {
    const float* c = a.in[1]; const float* c_ctx = a.in[3]; const float* w_ada = a.in[4]; const float* b_ada = a.in[5];
    const float* w_out = a.in[11]; const float* pool_w = a.in[14]; const float* pool_scale = a.in[15];
    bf16_t* WOUT = (bf16_t*)(F.ws + WS_WOUT);
    float* mod = (float*)(F.ws + WS_MOD);
    if (F.bid < 192) {
        LAS float* s = (LAS float*)F.lds;
        LAS float* red = (LAS float*)(F.lds + 20480);
        const int kq = F.tid >> 5, col = F.tid & 31, j = F.bid * 32 + col;
        float w[64];
#pragma unroll
        for (int kk = 0; kk < 64; ++kk) w[kk] = __builtin_nontemporal_load(w_ada + (size_t)(kq * 64 + kk) * 6144 + j);
        { float t[10];
#pragma unroll
          for (int q = 0; q < 10; ++q) { const int i = F.tid + q * 512, r = i >> 10, k = i & 1023; t[q] = (r < 4) ? c[r * 1024 + k] : c_ctx[k]; }
#pragma unroll
          for (int q = 0; q < 10; ++q) s[F.tid + q * 512] = t[q] * sigmoidf_(t[q]); }
        __syncthreads();
        float acc[5] = {0.f, 0.f, 0.f, 0.f, 0.f};
#pragma unroll
        for (int kk = 0; kk < 64; ++kk) { const int k = kq * 64 + kk;
#pragma unroll
            for (int r = 0; r < 5; ++r) acc[r] += s[r * 1024 + k] * w[kk]; }
#pragma unroll
        for (int r = 0; r < 5; ++r) red[(kq * 5 + r) * 32 + col] = acc[r];
        __syncthreads();
        if (F.tid < 160) { const int r = F.tid >> 5, cc = F.tid & 31; float t = b_ada[F.bid * 32 + cc];
#pragma unroll
            for (int q = 0; q < 16; ++q) t += red[(q * 5 + r) * 32 + cc];
            mod[r * 6144 + F.bid * 32 + cc] = t; }
        asm volatile("s_waitcnt vmcnt(0)" ::: "memory");
        __syncthreads();
        if (F.tid == 0) { __builtin_amdgcn_fence(__ATOMIC_RELEASE, "agent"); asm volatile("s_waitcnt vmcnt(0)" ::: "memory");
            __hip_atomic_fetch_add(F.ctl + CW_MOD, 1u, __ATOMIC_RELAXED, __HIP_MEMORY_SCOPE_AGENT); }
    }
    __syncthreads();
    transpose_items_bf16(F, a, F.bid * 8 + F.wave, F.G * 8, 0, TI_IN);
}
__device__ __forceinline__ void p0_late(const Frame& F, const Args& a) {
    const float* w_out = a.in[11]; const float* pool_w = a.in[14]; const float* pool_scale = a.in[15];
    bf16_t* WOUT = (bf16_t*)(F.ws + WS_WOUT);
    if (F.bid >= 128 && F.bid < 256) {
        const int un = F.bid - 128, gi = un >> 5, nb = un & 31;
        LAS float* pw = (LAS float*)F.lds;
        LAS float* wo = (LAS float*)(F.lds + 128 * 129 * 4);
        { float t[32]; const float sc = pool_scale[gi * 128 + (F.tid & 127)];
#pragma unroll
          for (int q = 0; q < 32; ++q) t[q] = pool_w[(size_t)gi * 16384 + F.tid + q * 512];
#pragma unroll
          for (int q = 0; q < 32; ++q) { const int i = F.tid + q * 512; pw[(i >> 7) * 129 + (i & 127)] = t[q] * sc; }
          float u[8];
#pragma unroll
          for (int q = 0; q < 8; ++q) { const int i = F.tid + q * 512; u[q] = w_out[(size_t)(512 + gi * 128 + (i >> 5)) * 1024 + nb * 32 + (i & 31)]; }
#pragma unroll
          for (int q = 0; q < 8; ++q) wo[F.tid + q * 512] = u[q]; }
        __syncthreads();
        const int n = F.tid & 31, cq = F.tid >> 5;
        float acc[8] = {0.f, 0.f, 0.f, 0.f, 0.f, 0.f, 0.f, 0.f};
        for (int j = 0; j < 128; ++j) { const float b = wo[j * 32 + n];
#pragma unroll
            for (int i = 0; i < 8; ++i) acc[i] += pw[(cq * 8 + i) * 129 + j] * b; }
        u32x4 o; o.x = cvt_pk_bf16(acc[0], acc[1]); o.y = cvt_pk_bf16(acc[2], acc[3]); o.z = cvt_pk_bf16(acc[4], acc[5]); o.w = cvt_pk_bf16(acc[6], acc[7]);
        *(u32x4*)(WOUT + (size_t)(nb * 32 + n) * 1024 + 512 + gi * 128 + cq * 8) = o;
        __syncthreads();
    }
    if (F.bid >= 32 && F.bid < 40) {
        const float* w_router = a.in[16]; bf16_t* WRH = (bf16_t*)(F.ws + WS_WRH); bf16_t* WRL = (bf16_t*)(F.ws + WS_WRL);
        for (int i = (F.bid - 32) * 512 + F.tid; i < 32768; i += 8 * 512) { const int k = i >> 5, e = i & 31; const float w = w_router[i];
            const unsigned short hi = f2bf(w); WRH[e * 1024 + k] = hi; WRL[e * 1024 + k] = f2bf(w - bf2f(hi)); }
    }
    __syncthreads();
    transpose_items_bf16(F, a, F.bid * 8 + F.wave, F.G * 8, TI_IN, TI_IN + TI_OUT);
    __syncthreads();
}

__device__ __forceinline__ void p1_normmod(const Frame& F, const Args& a, unsigned need) {
    const float* x = a.in[0]; const float* ctx = a.in[2]; const float* g = a.in[6];
    const float* mod = (const float*)(F.ws + WS_MOD); bf16_t* HX = (bf16_t*)(F.ws + WS_HX);
    const int gw = F.bid * 8 + F.wave;
    auto rowp = [&](int m) { return (m < M) ? x + (size_t)m * D : ctx + (size_t)(m - M) * D; };
    const int NGW = F.G * 8;
    int m0 = gw * 8;
    f32x4 v[4];
    { const float* xr = rowp(m0);
#pragma unroll
      for (int j = 0; j < 4; ++j) v[j] = __builtin_nontemporal_load((const f32x4*)(xr + F.lane * 4 + 256 * j)); }
    if (F.tid == 0) { unsigned sp = 0;
        while (__hip_atomic_load(F.ctl + CW_MOD, __ATOMIC_RELAXED, __HIP_MEMORY_SCOPE_AGENT) < need) { __builtin_amdgcn_s_sleep(2); if (++sp > (1u << 22)) break; }
        __builtin_amdgcn_fence(__ATOMIC_ACQUIRE, "agent"); asm volatile("s_waitcnt vmcnt(0)" ::: "memory"); }
    __syncthreads();
    f32x4 ga[4], hb[4];
    auto ld_par = [&](int mr) { const float* sh = mod + mr * 6144, *sc = sh + 1024;
#pragma unroll
        for (int j = 0; j < 4; ++j) { const int col = F.lane * 4 + 256 * j; ga[j] = *(const f32x4*)(g + col) * (1.0f + *(const f32x4*)(sc + col)); hb[j] = *(const f32x4*)(sh + col); } };
    auto do_row = [&](int m) {
        float s = 0.f;
#pragma unroll
        for (int j = 0; j < 4; ++j) s += (v[j].x * v[j].x + v[j].y * v[j].y) + (v[j].z * v[j].z + v[j].w * v[j].w);
        const float rstd = rsqrtf(wave_sum(s) * (1.f / D) + EPS);
#pragma unroll
        for (int j = 0; j < 4; ++j) { const int col = F.lane * 4 + 256 * j;
            const f32x4 o = v[j] * rstd * ga[j] + hb[j];
            u32x2 w; w.x = cvt_pk_bf16(o.x, o.y); w.y = cvt_pk_bf16(o.z, o.w);
            *(u32x2*)(HX + (size_t)m * D + col) = w; } };
    const bool hasctx = gw < MC;
#pragma unroll 1
    for (; m0 < M; m0 += NGW * 8) {
        const bool lastg = m0 + NGW * 8 >= M;
        ld_par(m0 >> 12);
#pragma unroll 1
        for (int k = 0; k < 8; ++k) {
            const int m = m0 + k, mn = (k < 7) ? m + 1 : (lastg ? (hasctx ? M + gw : m) : m0 + NGW * 8);
            f32x4 vn[4];
            { const float* xr = rowp(mn);
#pragma unroll
              for (int j = 0; j < 4; ++j) vn[j] = __builtin_nontemporal_load((const f32x4*)(xr + F.lane * 4 + 256 * j)); }
            do_row(m);
#pragma unroll
            for (int j = 0; j < 4; ++j) v[j] = vn[j];
        }
    }
    for (int c = gw; c < MC; c += NGW) {
        if (c != gw) { const float* xr = rowp(M + c);
#pragma unroll
            for (int j = 0; j < 4; ++j) v[j] = __builtin_nontemporal_load((const f32x4*)(xr + F.lane * 4 + 256 * j)); }
        ld_par(4); do_row(M + c); }
}

constexpr int G_LF = 0, G_QR = 17408, G_V = 34816, G_Q2 = 52224, G_K2 = 69632, G_ATT = 87040, G_ST = 96256, G_RED = LDS_TAB;
static_assert(G_ST + 128 * 272 <= RING_BYTES, "GLA LDS map");
typedef short s16x4 __attribute__((ext_vector_type(4)));
__device__ __forceinline__ f32x16 mfma32(bf16x8 a, bf16x8 b, f32x16 c) { return __builtin_amdgcn_mfma_f32_32x32x16_bf16(a, b, c, 0, 0, 0); }
__device__ __forceinline__ constexpr int crow0(int reg) { return (reg & 3) + 8 * (reg >> 2); }
__device__ __forceinline__ int opq(int x) { asm volatile("" : "+v"(x)); return x; }
__device__ __forceinline__ unsigned opqu(unsigned x) { asm volatile("" : "+v"(x)); return x; }
__device__ __forceinline__ bf16x8 tr_frag(const LAS unsigned char* img, int trb, int ks, int c) {
    const LAS s16x4* p = (const LAS s16x4*)(img + trb + ks * 16 * 272 + c * 64);
    const s16x4 lo = __builtin_amdgcn_ds_read_tr16_b64_v4i16((LAS s16x4*)p), hi = __builtin_amdgcn_ds_read_tr16_b64_v4i16((LAS s16x4*)(p + 4 * 272 / 8));
    return __builtin_shufflevector(lo, hi, 0, 1, 2, 3, 4, 5, 6, 7);
}
template <int MODE> __device__ __forceinline__ bf16x8 cfrag(int d) {
    u32x4 w;
#pragma unroll
    for (int i = 0; i < 4; ++i) {
        const bool lo = MODE == 0 ? (2 * i <= d) : MODE == 1 ? (2 * i >= d) : MODE == 2 ? (2 * i == d) : true;
        const bool hi = MODE == 0 ? (2 * i + 1 <= d) : MODE == 1 ? (2 * i + 1 >= d) : MODE == 2 ? (2 * i + 1 == d) : true;
        w[i] = (lo ? 0x3F80u : 0u) | (hi ? 0x3F800000u : 0u);
    }
    return __builtin_bit_cast(bf16x8, w);
}
struct RawRegs { u32x4 lf[2], v[2], q[2]; };
template <int DIR, bool WITH_Q>
__device__ __forceinline__ void gla_load_raw(const Frame& F, const bf16_t* P, int row0, int head, RawRegs& R) {
    const bf16_t* rp = P + (size_t)(row0 + (F.tid >> 3)) * NIN + head * 128 + (F.tid & 7) * 16;
    R.lf[0] = *(const u32x4*)(rp + 512 + DIR * 512); R.lf[1] = *(const u32x4*)(rp + 512 + DIR * 512 + 8);
    R.v[0] = *(const u32x4*)(rp + 1536); R.v[1] = *(const u32x4*)(rp + 1536 + 8);
    if (WITH_Q) { R.q[0] = *(const u32x4*)rp; R.q[1] = *(const u32x4*)(rp + 8); }
}
template <bool WITH_Q>
__device__ __forceinline__ void gla_store_raw(const Frame& F, const RawRegs& R) {
    const int o = (F.tid >> 3) * 272 + (F.tid & 7) * 32;
    *(LAS u32x4*)(F.lds + G_LF + o) = R.lf[0]; *(LAS u32x4*)(F.lds + G_LF + o + 16) = R.lf[1];
    *(LAS u32x4*)(F.lds + G_V + o) = R.v[0]; *(LAS u32x4*)(F.lds + G_V + o + 16) = R.v[1];
    if (WITH_Q) { *(LAS u32x4*)(F.lds + G_QR + o) = R.q[0]; *(LAS u32x4*)(F.lds + G_QR + o + 16) = R.q[1]; }
}
template <int DIR, bool WITH_Q>
__device__ __forceinline__ void gla_stage1(const Frame& F, int trb, float (&eh)[16], float* tsum) {
    const int cb = F.wave >> 1, tb = F.wave & 1, l31 = F.lane & 31, lh = F.lane >> 5;
    f32x16 b, T;
#pragma unroll
    for (int r = 0; r < 16; ++r) { b[r] = 0.f; T[r] = 0.f; }
    const u32x4 ones4 = {0x3F803F80u, 0x3F803F80u, 0x3F803F80u, 0x3F803F80u};
#pragma unroll
    for (int ks = 0; ks < 4; ++ks) {
        const int dd = 32 * tb + l31 - 16 * ks - 8 * lh;
        const bf16x8 alf = tr_frag(F.lds + G_LF, trb, ks, cb);
        T = mfma32(alf, __builtin_bit_cast(bf16x8, ones4), T);
        if (DIR ? (tb == 0 || ks >= 2) : (tb == 1 || ks < 2)) b = mfma32(alf, cfrag<DIR>(dd), b);
    }
    const int wb = opq((32 * tb + l31) * 272 + (32 * cb + 4 * lh) * 2);
    typedef float f32x2 __attribute__((ext_vector_type(2)));
    u32x2 lfw[4], qw[4];
#pragma unroll
    for (int g = 0; g < 4; ++g) { lfw[g] = *(const LAS u32x2*)(F.lds + G_LF + wb + g * 16); if (WITH_Q) qw[g] = *(const LAS u32x2*)(F.lds + G_QR + wb + g * 16); }
#pragma unroll
    for (int g = 0; g < 4; ++g) {
        f32x2 k2[2], q2[2];
#pragma unroll
        for (int h = 0; h < 2; ++h) {
            const int r = 4 * g + 2 * h;
            const unsigned lw = h ? lfw[g].y : lfw[g].x;
            const f32x2 lf = {bflo(lw), bfhi(lw)}, Tv = {T[r], T[r + 1]}, bv = {b[r], b[r + 1]};
            const f32x2 mm = Tv * 0.5f, d = mm - bv;
            eh[r] = __builtin_amdgcn_exp2f(mm.x); eh[r + 1] = __builtin_amdgcn_exp2f(mm.y);
            if (tsum) { tsum[r] += Tv.x; tsum[r + 1] += Tv.y; }
            f32x2 ef, ek; ef.x = __builtin_amdgcn_exp2f(lf.x); ef.y = __builtin_amdgcn_exp2f(lf.y); ek.x = __builtin_amdgcn_exp2f(d.x); ek.y = __builtin_amdgcn_exp2f(d.y);
            k2[h] = (1.0f - ef) * ek;
            q2[h] = (f32x2){0.f, 0.f};
            if (WITH_Q) { const unsigned qq = h ? qw[g].y : qw[g].x; const f32x2 q = {bflo(qq), bfhi(qq)}, nd = bv - mm;
                f32x2 eq; eq.x = __builtin_amdgcn_exp2f(nd.x); eq.y = __builtin_amdgcn_exp2f(nd.y); q2[h] = q * eq; }
        }
        u32x2 w; w.x = cvt_pk_bf16(k2[0].x, k2[0].y); w.y = cvt_pk_bf16(k2[1].x, k2[1].y);
        *(LAS u32x2*)(F.lds + G_K2 + wb + g * 16) = w;
        if (WITH_Q) { w.x = cvt_pk_bf16(q2[0].x, q2[0].y); w.y = cvt_pk_bf16(q2[1].x, q2[1].y); *(LAS u32x2*)(F.lds + G_Q2 + wb + g * 16) = w; }
    }
}
__device__ __forceinline__ void gla_state_mma(const Frame& F, int trb, f32x16& s0, f32x16& s1) {
    const int kb = F.wave >> 1, vb = (F.wave & 1) * 2;
#pragma unroll
    for (int ks = 0; ks < 4; ++ks) {
        const bf16x8 a = tr_frag(F.lds + G_K2, trb, ks, kb);
        const bf16x8 b0 = tr_frag(F.lds + G_V, trb, ks, vb), b1 = tr_frag(F.lds + G_V, trb, ks, vb + 1);
        s0 = mfma32(a, b0, s0); s1 = mfma32(a, b1, s1);
    }
}

template <int DIR>
__device__ __forceinline__ void gla_passA_unit(const Frame& F, const bf16_t* P, int b, int h, int blk, bf16_t* dS, float* DD) {
    const int xb = DIR ? (16 - blk) : (blk - 1);
    const int rowb = (blk == 0) ? (M + b * CTXL) : (b * SEQ + xb * 256);
    const int l31 = F.lane & 31, lh = F.lane >> 5;
    const int trb = (8 * lh + ((F.lane & 15) >> 2)) * 272 + (16 * ((F.lane >> 4) & 1) + 4 * (F.lane & 3)) * 2;
    f32x16 s0, s1;
#pragma unroll
    for (int r = 0; r < 16; ++r) { s0[r] = 0.f; s1[r] = 0.f; }
    float tsum[16], eh[16];
#pragma unroll
    for (int i = 0; i < 16; ++i) tsum[i] = 0.f;
    RawRegs R;
    gla_load_raw<DIR, false>(F, P, rowb + (DIR ? 3 : 0) * 64, h, R);
#pragma unroll 1
    for (int ci = 0; ci < 4; ++ci) {
        LSYNC();
        gla_store_raw<false>(F, R);
        if (ci < 3) gla_load_raw<DIR, false>(F, P, rowb + (DIR ? (2 - ci) : (ci + 1)) * 64, h, R);
        LSYNC();
        gla_stage1<DIR, false>(F, trb, eh, tsum);
        LSYNC();
#pragma unroll
        for (int r = 0; r < 16; ++r) { s0[r] *= eh[r]; s1[r] *= eh[r]; }
        gla_state_mma(F, trb, s0, s1);
#pragma unroll
        for (int r = 0; r < 16; ++r) { s0[r] *= eh[r]; s1[r] *= eh[r]; }
    }
    const int kb = F.wave >> 1, vb = (F.wave & 1) * 2;
    const unsigned sb = opqu((unsigned)((32 * kb + 4 * lh) * 128 + 32 * vb + l31));
#pragma unroll
    for (int r = 0; r < 16; ++r) { dS[sb + crow0(r) * 128] = f2bf(s0[r]); dS[sb + 32 + crow0(r) * 128] = f2bf(s1[r]); }
    if ((F.wave & 1) == 0 && l31 == 0) {
#pragma unroll
        for (int r = 0; r < 16; ++r) DD[32 * kb + 4 * lh + crow0(r)] = __builtin_amdgcn_exp2f(tsum[r]);
    }
}

template <int W, class Get, class Emit> __device__ __forceinline__ void win_mean64(const Get& get, const Emit& emit) {
    float s = 0.f;
#pragma unroll
    for (int q = 0; q < W - W / 2; ++q) s += get(q);
#pragma unroll
    for (int r = 0; r < 64; ++r) {
        const int lo = (r - W / 2) < 0 ? 0 : (r - W / 2), hi = (r - W / 2 + W) > 64 ? 64 : (r - W / 2 + W);
        emit(r, s * (1.0f / (float)(hi - lo)));
        if (r + 1 < 64) { if (r + 1 - W / 2 + W <= 64) s += get(r - W / 2 + W); if (r + 1 - W / 2 > 0) s -= get(r - W / 2); }
    }
}
template <int W>
__device__ __forceinline__ void pool_unit(const Frame& F, const bf16_t* __restrict__ U, bf16_t* __restrict__ A2, int b, int slab) {
    LAS float* vm = (LAS float*)F.lds;
    const int ch = F.tid & 7, cc = F.tid >> 3;
    const bf16_t* Us = U + (size_t)(b * 64 + slab) * 4096 * 8;
    {
        unsigned short v[64];
        const unsigned pb = opqu((unsigned)(cc * 8 + ch));
#pragma unroll
        for (int r = 0; r < 64; ++r) v[r] = Us[pb + (unsigned)(r * 64 * 8)];
        const int vb = opq((cc * 8 + ch) * 4);
        win_mean64<W>([&](int q) { return bf2f(v[q]); }, [&](int r, float mean) { *(LAS float*)(F.lds + vb + r * 2080) = mean; });
    }
    __syncthreads();
    {
        const int rr = F.tid >> 3;
        unsigned short uu[64];
        const unsigned pb = opqu((unsigned)(rr * 64 * 8 + ch));
#pragma unroll
        for (int c = 0; c < 64; ++c) uu[c] = Us[pb + (unsigned)(c * 8)];
        const int vb = opq((rr * 520 + ch) * 4);
        const unsigned ab = opqu((unsigned)((b * SEQ + rr * 64) * D + 512 + slab * 8 + ch));
        win_mean64<W>([&](int q) { return *(const LAS float*)(F.lds + vb + q * 32); },
                      [&](int c, float mean) { A2[ab + (unsigned)(c * D)] = f2bf(mean - bf2f(uu[c])); });
    }
    __syncthreads();
}

__device__ __forceinline__ void p4_scan(const Frame& F) {
    bf16_t* ST = (bf16_t*)(F.ws + WS_ST); const float* DDp = (const float*)(F.ws + WS_DD);
    const int gt = F.bid * 512 + F.tid, NT = F.G * 512;
    for (int i = gt; i < 32 * 4096; i += NT) {
        const int seq = i >> 12, e4 = i & 4095, k = e4 >> 5;
        float S[4];
#pragma unroll
        for (int j = 0; j < 4; ++j) S[j] = 0.f;
        u32x2 d[NBLK]; float dec[NBLK];
#pragma unroll
        for (int blk = 0; blk < NBLK; ++blk) { d[blk] = *(const u32x2*)(ST + ((size_t)(seq * NBLK + blk) * 16384) + e4 * 4); dec[blk] = DDp[(seq * NBLK + blk) * 128 + k]; }
#pragma unroll
        for (int blk = 0; blk < NBLK; ++blk) {
            u32x2 o; o.x = cvt_pk_bf16(S[0], S[1]); o.y = cvt_pk_bf16(S[2], S[3]);
            *(u32x2*)(ST + ((size_t)(seq * NBLK + blk) * 16384) + e4 * 4) = o;
            S[0] = S[0] * dec[blk] + bflo(d[blk].x); S[1] = S[1] * dec[blk] + bfhi(d[blk].x); S[2] = S[2] * dec[blk] + bflo(d[blk].y); S[3] = S[3] * dec[blk] + bfhi(d[blk].y);
        }
    }
}

__device__ __forceinline__ float row16_sum(float x) {
    int v;
    v = __builtin_amdgcn_mov_dpp(__float_as_int(x), 0x128, 0xf, 0xf, false); x += __int_as_float(v);
    v = __builtin_amdgcn_mov_dpp(__float_as_int(x), 0x124, 0xf, 0xf, false); x += __int_as_float(v);
    v = __builtin_amdgcn_mov_dpp(__float_as_int(x), 0x122, 0xf, 0xf, false); x += __int_as_float(v);
    v = __builtin_amdgcn_mov_dpp(__float_as_int(x), 0x121, 0xf, 0xf, false); x += __int_as_float(v);
    return x;
}
template <int DIR>
__device__ __forceinline__ void gla_passC_dir(const Frame& F, const bf16_t* P, int b, int h, int xb, const bf16_t* ST, bf16_t* OF, bf16_t* A2, const float* gain) {
    const int blk = DIR ? (16 - xb) : (xb + 1);
    const int seq = b * 8 + h * 2 + DIR;
    const bf16_t* S0 = ST + (size_t)(seq * NBLK + blk) * 16384;
    const int kb = F.wave >> 1, vb = (F.wave & 1) * 2, l31 = F.lane & 31, lh = F.lane >> 5;
    const int trb = (8 * lh + ((F.lane & 15) >> 2)) * 272 + (16 * ((F.lane >> 4) & 1) + 4 * (F.lane & 3)) * 2;
    f32x16 s0, s1;
    const unsigned sb = opqu((unsigned)((32 * kb + 4 * lh) * 128 + 32 * vb + l31));
#pragma unroll
    for (int r = 0; r < 16; ++r) { s0[r] = bf2f(S0[sb + crow0(r) * 128]); s1[r] = bf2f(S0[sb + 32 + crow0(r) * 128]); }
    const int rowb = b * SEQ + xb * 256;
    const int omt = F.wave >> 2, ont = F.wave & 3;
    LAS float* red = (LAS float*)(F.lds + G_RED);
    RawRegs R;
    gla_load_raw<DIR, true>(F, P, rowb + (DIR ? 3 : 0) * 64, h, R);
    LSYNC();
    gla_store_raw<true>(F, R);
#pragma unroll 1
    for (int ci = 0; ci < 4; ++ci) {
        const int c = DIR ? (3 - ci) : ci;
        float eh[16];
        if (ci < 3) gla_load_raw<DIR, true>(F, P, rowb + (DIR ? (2 - ci) : (ci + 1)) * 64, h, R);
        f32x16 o;
        const unsigned trow = (unsigned)(rowb + c * 64 + 32 * omt + l31);
        const unsigned ob = opqu(trow * 512u + (unsigned)(h * 128 + 32 * ont + 4 * lh));
        u32x2 gg[4];
        if (DIR) {
            const unsigned pb = opqu(trow * (unsigned)NIN + (unsigned)(2048 + h * 128 + 32 * ont + 4 * lh));
#pragma unroll
            for (int g = 0; g < 4; ++g) { const u32x2 t4 = *(const u32x2*)(OF + ob + g * 8); o[4 * g] = bflo(t4.x); o[4 * g + 1] = bfhi(t4.x); o[4 * g + 2] = bflo(t4.y); o[4 * g + 3] = bfhi(t4.y); gg[g] = *(const u32x2*)(P + pb + g * 8); }
        } else {
#pragma unroll
            for (int r = 0; r < 16; ++r) o[r] = 0.f;
        }
        LSYNC();
        gla_stage1<DIR, true>(F, trb, eh, nullptr);
        LSYNC();
#pragma unroll
        for (int r = 0; r < 16; ++r) { s0[r] *= eh[r]; s1[r] *= eh[r]; }
        {
            const int stb = opq(G_ST + (32 * vb + l31) * 272 + (32 * kb + 4 * lh) * 2);
#pragma unroll
            for (int g = 0; g < 4; ++g) {
                u32x2 w; w.x = cvt_pk_bf16(s0[4 * g], s0[4 * g + 1]); w.y = cvt_pk_bf16(s0[4 * g + 2], s0[4 * g + 3]);
                *(LAS u32x2*)(F.lds + stb + g * 16) = w;
                w.x = cvt_pk_bf16(s1[4 * g], s1[4 * g + 1]); w.y = cvt_pk_bf16(s1[4 * g + 2], s1[4 * g + 3]);
                *(LAS u32x2*)(F.lds + stb + 32 * 272 + g * 16) = w;
            }
        }
        if (F.wave < 4) {
            const int asb = F.wave >> 1, atb = F.wave & 1;
            f32x16 at, at2;
#pragma unroll
            for (int r = 0; r < 16; ++r) { at[r] = 0.f; at2[r] = 0.f; }
            const int ka = opq(G_K2 + (32 * asb + l31) * 272 + 16 * lh), qa = opq(G_Q2 + (32 * atb + l31) * 272 + 16 * lh);
#pragma unroll
            for (int ks = 0; ks < 8; ks += 2) {
                const bf16x8 a = *(const LAS bf16x8*)(F.lds + ka + ks * 32), a2 = *(const LAS bf16x8*)(F.lds + ka + ks * 32 + 32);
                const bf16x8 bb = *(const LAS bf16x8*)(F.lds + qa + ks * 32), bb2 = *(const LAS bf16x8*)(F.lds + qa + ks * 32 + 32);
                at = mfma32(a, bb, at); at2 = mfma32(a2, bb2, at2);
            }
#pragma unroll
            for (int r = 0; r < 16; ++r) at[r] += at2[r];
            const int dts = opq((32 * atb + l31) - (32 * asb + 4 * lh));
            float am[16];
#pragma unroll
            for (int r = 0; r < 16; ++r) { const bool keep = DIR ? (crow0(r) >= dts) : (crow0(r) <= dts); am[r] = keep ? at[r] : 0.f; }
            const int ab = opq(G_ATT + (32 * atb + l31) * 144 + (32 * asb + 4 * lh) * 2);
#pragma unroll
            for (int g = 0; g < 4; ++g) { u32x2 w; w.x = cvt_pk_bf16(am[4 * g], am[4 * g + 1]); w.y = cvt_pk_bf16(am[4 * g + 2], am[4 * g + 3]); *(LAS u32x2*)(F.lds + ab + g * 16) = w; }
        }
        LSYNC();
        {
            const int qa = opq(G_Q2 + (32 * omt + l31) * 272 + 16 * lh), sa = opq(G_ST + (32 * ont + l31) * 272 + 16 * lh), aa = opq(G_ATT + (32 * omt + l31) * 144 + 16 * lh);
            f32x16 o2;
#pragma unroll
            for (int r = 0; r < 16; ++r) o2[r] = 0.f;
#pragma unroll
            for (int ks = 0; ks < 8; ++ks) {
                const bf16x8 a = *(const LAS bf16x8*)(F.lds + sa + ks * 32);
                const bf16x8 bb = *(const LAS bf16x8*)(F.lds + qa + ks * 32);
                if (ks & 1) o2 = mfma32(a, bb, o2); else o = mfma32(a, bb, o);
            }
#pragma unroll
            for (int ks = 0; ks < 4; ++ks) {
                const bf16x8 a = tr_frag(F.lds + G_V, trb, ks, ont);
                const bf16x8 bb = *(const LAS bf16x8*)(F.lds + aa + ks * 32);
                if (ks & 1) o2 = mfma32(a, bb, o2); else o = mfma32(a, bb, o);
            }
#pragma unroll
            for (int r = 0; r < 16; ++r) o[r] += o2[r];
        }
        gla_state_mma(F, trb, s0, s1);
#pragma unroll
        for (int r = 0; r < 16; ++r) { s0[r] *= eh[r]; s1[r] *= eh[r]; }
        if (DIR == 0) {
#pragma unroll
            for (int g = 0; g < 4; ++g) { u32x2 w; w.x = cvt_pk_bf16(o[4 * g], o[4 * g + 1]); w.y = cvt_pk_bf16(o[4 * g + 2], o[4 * g + 3]); *(u32x2*)(OF + ob + g * 8) = w; }
        } else {
            float sq = 0.f;
#pragma unroll
            for (int r = 0; r < 16; ++r) sq += o[r] * o[r];
            sq += __shfl_xor(sq, 32);
            if (lh == 0) red[(32 * omt + l31) * 4 + ont] = sq;
            LSYNC();
            const f32x4 q4 = *(const LAS f32x4*)(red + (32 * omt + l31) * 4);
            const float rstd = rsqrtf(((q4.x + q4.y) + (q4.z + q4.w)) * (1.0f / 128.0f) + EPS);
            const unsigned a2b = opqu(trow * (unsigned)D + (unsigned)(h * 128 + 32 * ont + 4 * lh));
#pragma unroll
            for (int g = 0; g < 4; ++g) {
                u32x2 w; w.x = cvt_pk_bf16(o[4 * g] * rstd * bflo(gg[g].x), o[4 * g + 1] * rstd * bfhi(gg[g].x));
                w.y = cvt_pk_bf16(o[4 * g + 2] * rstd * bflo(gg[g].y), o[4 * g + 3] * rstd * bfhi(gg[g].y));
                *(u32x2*)(A2 + a2b + g * 8) = w; }
        }
        if (ci < 3) { LSYNC();
            gla_store_raw<true>(F, R); }
    }
}
__device__ __forceinline__ void gla_passC_unit(const Frame& F, const Args& a, int b, int h, int xb) {
    const bf16_t* P = (const bf16_t*)(F.ws + WS_P); const bf16_t* ST = (const bf16_t*)(F.ws + WS_ST); bf16_t* A2 = (bf16_t*)(F.ws + WS_A2);
    bf16_t* OF = (bf16_t*)(F.ws + WS_YX);
    gla_passC_dir<0>(F, P, b, h, xb, ST, OF, A2, a.in[13]);
    gla_passC_dir<1>(F, P, b, h, xb, ST, OF, A2, a.in[13]);
}

__device__ __forceinline__ void p7_rows(const Frame& F, const Args& a, const XcdBarrier& bar, bool pending) {
    const float* x = a.in[0]; const float* gpm = a.in[7]; const float* gpf = a.in[8]; const float* b_router = a.in[17];
    const float* mod = (const float*)(F.ws + WS_MOD); const bf16_t* YX = (const bf16_t*)(F.ws + WS_YXB);
    const bf16_t* WRH = (const bf16_t*)(F.ws + WS_WRH); const bf16_t* WRL = (const bf16_t*)(F.ws + WS_WRL);
    bf16_t* X1B = (bf16_t*)(F.ws + WS_X1B); unsigned char* HX2F = F.ws + WS_HX2F; int* PE = (int*)(F.ws + WS_PE); int* PSLOT = (int*)(F.ws + WS_PSLOT); float* PW = (float*)(F.ws + WS_PW);
    int* RTOK = (int*)(F.ws + WS_RTOK); unsigned* cnt = F.ctl + CW_CNT;
    LAS float* part = (LAS float*)F.lds;
    LAS float* logit = (LAS float*)(F.lds + 65536);
    LAS int* lcnt = (LAS int*)(F.lds + LDS_TAB);
    const int l31 = F.lane & 31, lh = F.lane >> 5;
    for (int g = F.bid; g < M / 64; g += F.G) {
        const int base = (F.G == 256) ? ((8 * (g & 7) + (g >> 5)) * 256 + ((g >> 3) & 3) * 64) : g * 64;
        if (F.tid < 64) lcnt[F.tid] = 0;
        f32x4 cgt[4], e2[4], f2[4];
        { const float* mrow = mod + (base >> 12) * 6144;
#pragma unroll
          for (int j = 0; j < 4; ++j) { const int col = F.lane * 4 + 256 * j; cgt[j] = *(const f32x4*)(mrow + 2048 + col) * *(const f32x4*)(gpm + col);
              e2[j] = *(const f32x4*)(gpf + col) * (1.0f + *(const f32x4*)(mrow + 4096 + col)); f2[j] = *(const f32x4*)(mrow + 3072 + col); } }
        u32x2 yw[4]; f32x4 xx[4];
        { const int m0 = base + F.wave * 8;
#pragma unroll
          for (int j = 0; j < 4; ++j) { const int col = F.lane * 4 + 256 * j; xx[j] = __builtin_nontemporal_load((const f32x4*)(x + (size_t)m0 * D + col)); }
          if (pending && g == F.bid) xcd_wait(bar);
#pragma unroll
          for (int j = 0; j < 4; ++j) { const int col = F.lane * 4 + 256 * j; yw[j] = __builtin_nontemporal_load((const u32x2*)(YX + (size_t)m0 * D + col)); } }
#pragma unroll 1
        for (int r = 0; r < 8; ++r) {
            const int m = base + F.wave * 8 + r, mn = base + F.wave * 8 + (r < 7 ? r + 1 : r);
            u32x2 ywn[4]; f32x4 xn[4];
#pragma unroll
            for (int j = 0; j < 4; ++j) { const int col = F.lane * 4 + 256 * j; ywn[j] = __builtin_nontemporal_load((const u32x2*)(YX + (size_t)mn * D + col)); xn[j] = __builtin_nontemporal_load((const f32x4*)(x + (size_t)mn * D + col)); }
            f32x4 y[4]; float s = 0.f;
#pragma unroll
            for (int j = 0; j < 4; ++j) { y[j] = (f32x4){bflo(yw[j].x), bfhi(yw[j].x), bflo(yw[j].y), bfhi(yw[j].y)};
                s += (y[j].x * y[j].x + y[j].y * y[j].y) + (y[j].z * y[j].z + y[j].w * y[j].w); }
            const float rstd = rsqrtf(wave_sum(s) * (1.f / D) + EPS);
            float s2 = 0.f;
#pragma unroll
            for (int j = 0; j < 4; ++j) { const int col = F.lane * 4 + 256 * j;
                xx[j] = xx[j] + cgt[j] * (y[j] * rstd);
                { u32x2 w1; w1.x = cvt_pk_bf16(xx[j].x, xx[j].y); w1.y = cvt_pk_bf16(xx[j].z, xx[j].w); __builtin_nontemporal_store(w1, (u32x2*)(X1B + (size_t)m * D + col)); }
                s2 += (xx[j].x * xx[j].x + xx[j].y * xx[j].y) + (xx[j].z * xx[j].z + xx[j].w * xx[j].w); }
            const float rstd2 = rsqrtf(wave_sum(s2) * (1.f / D) + EPS);
#pragma unroll
            for (int j = 0; j < 4; ++j) { const int col = F.lane * 4 + 256 * j;
                const f32x4 hh = xx[j] * rstd2 * e2[j] + f2[j];
                u32x2 w; w.x = cvt_pk_bf16(hh.x, hh.y); w.y = cvt_pk_bf16(hh.z, hh.w);
                const int lr = F.wave * 8 + r;
                *(LAS u32x2*)(F.lds + lr * 2048 + ((((F.lane >> 1) + 32 * j) ^ (lr & 15)) * 16) + (F.lane & 1) * 8) = w;
                *(unsigned*)(HX2F + (size_t)m * D + col) = pk4_fp8(hh.x, hh.y, hh.z, hh.w); }
#pragma unroll
            for (int j = 0; j < 4; ++j) { yw[j] = ywn[j]; xx[j] = xn[j]; }
        }
        bf16x8 bh[8], bl[8];
#pragma unroll
        for (int ks = 0; ks < 8; ++ks) { const int k0 = 128 * F.wave + 16 * ks + 8 * lh; bh[ks] = *(const bf16x8*)(WRH + l31 * 1024 + k0); bl[ks] = *(const bf16x8*)(WRL + l31 * 1024 + k0); }
        __syncthreads();
        {
            f32x16 acc0, acc1;
#pragma unroll
            for (int r = 0; r < 16; ++r) { acc0[r] = 0.f; acc1[r] = 0.f; }
#pragma unroll
            for (int ks = 0; ks < 8; ++ks) {
                const int ch = ((16 * F.wave + 2 * ks + lh) ^ (l31 & 15)) * 16;
                const bf16x8 a0 = *(const LAS bf16x8*)(F.lds + l31 * 2048 + ch), a1 = *(const LAS bf16x8*)(F.lds + (32 + l31) * 2048 + ch);
                acc0 = mfma32(a0, bh[ks], acc0); acc0 = mfma32(a0, bl[ks], acc0); acc1 = mfma32(a1, bh[ks], acc1); acc1 = mfma32(a1, bl[ks], acc1);
            }
            const int pb = opq((F.wave * 64 + 4 * lh) * 32 + l31);
            __syncthreads();
#pragma unroll
            for (int r = 0; r < 16; ++r) { part[pb + crow0(r) * 32] = acc0[r]; part[pb + (32 + crow0(r)) * 32] = acc1[r]; }
        }
        __syncthreads();
        { f32x4 t = *(const f32x4*)(b_router + ((F.tid * 4) & 31));
#pragma unroll
          for (int w = 0; w < 8; ++w) t += *(const LAS f32x4*)(part + w * 2048 + F.tid * 4);
          *(LAS f32x4*)(logit + F.tid * 4) = t; }
        __syncthreads();
#pragma unroll 1
        for (int r = 0; r < 8; ++r) {
            const int m = base + F.wave * 8 + r;
            float v = (F.lane < 32) ? logit[(F.wave * 8 + r) * 32 + l31] : -3.0e38f; float tv[4]; int ti[4];
#pragma unroll
            for (int k = 0; k < 4; ++k) {
                float mx = v;
#pragma unroll
                for (int o = 1; o < 64; o <<= 1) mx = fmaxf(mx, __shfl_xor(mx, o));
                const unsigned long long bal = __ballot(v == mx);
                int idx = __ffsll((long long)bal) - 1; idx = idx < 0 ? 0 : (idx > 31 ? 31 : idx);
                tv[k] = mx; ti[k] = idx;
                if (F.lane == idx) v = -3.0e38f;
            }
            const float e1 = __expf(tv[1] - tv[0]), e2 = __expf(tv[2] - tv[0]), e3 = __expf(tv[3] - tv[0]);
            const float inv = 1.0f / (1.0f + e1 + e2 + e3);
            if (F.lane < 4) {
                const int e = F.lane == 0 ? ti[0] : F.lane == 1 ? ti[1] : F.lane == 2 ? ti[2] : ti[3];
                const float w = (F.lane == 0 ? 1.0f : F.lane == 1 ? e1 : F.lane == 2 ? e2 : e3) * inv;
                const int lrank = __hip_atomic_fetch_add(lcnt + e, 1, __ATOMIC_RELAXED, __HIP_MEMORY_SCOPE_WORKGROUP);
                PE[m * 4 + F.lane] = e; PSLOT[m * 4 + F.lane] = lrank; PW[m * 4 + F.lane] = w;
            }
        }
        __syncthreads();
        if (F.tid < 32) { const int c = lcnt[F.tid]; lcnt[32 + F.tid] = c ? (int)__hip_atomic_fetch_add(cnt + 64 * F.tid, (unsigned)c, __ATOMIC_RELAXED, __HIP_MEMORY_SCOPE_AGENT) : 0; }
        __syncthreads();
        if (F.tid < 256) { const int m = base + (F.tid >> 2), k = F.tid & 3; const int e = PE[m * 4 + k]; const int slot = lcnt[32 + e] + PSLOT[m * 4 + k];
            PSLOT[m * 4 + k] = slot; RTOK[e * ECAP + slot] = m * 1024; }
        __syncthreads();
    }
}

__device__ __forceinline__ void moe_tables(const Frame& F) {
    LAS int* tab = (LAS int*)(F.lds + LDS_TAB);
    __syncthreads();
    if (F.tid < 64) {
        const int c = (F.lane < 32) ? (int)__hip_atomic_load(F.ctl + CW_CNT + 64 * (F.lane & 31), __ATOMIC_RELAXED, __HIP_MEMORY_SCOPE_AGENT) : 0;
        const int padded = ((c + 255) >> 8) * 256;
        int incl = padded;
#pragma unroll
        for (int o = 1; o < 32; o <<= 1) { const int t = __shfl_up(incl, o); if (F.lane >= o) incl += t; }
        if (F.lane < 32) { tab[F.lane] = c; tab[32 + F.lane] = incl - padded; }
        if (F.lane == 31) tab[64] = incl >> 8;
    }
    __syncthreads();
}

__device__ __forceinline__ void p10_final(const Frame& F, const Args& a, const XcdBarrier& bar, bool pending) {
    const float* gpo = a.in[9]; const float* mod = (const float*)(F.ws + WS_MOD);
    const unsigned char* YB = F.ws + WS_YB; const bf16_t* X1B = (const bf16_t*)(F.ws + WS_X1B); const int* PE = (const int*)(F.ws + WS_PE); const int* PSLOT = (const int*)(F.ws + WS_PSLOT); const float* PW = (const float*)(F.ws + WS_PW);
    const LAS int* tab = (const LAS int*)(F.lds + LDS_TAB);
    const int gw = F.bid * 8 + F.wave;
    struct Rec { int e[4], s[4]; float w[4]; };
    auto ld_rec = [&](int m, Rec& r) {
#pragma unroll
        for (int k = 0; k < 4; ++k) { r.e[k] = PE[m * 4 + k]; r.s[k] = PSLOT[m * 4 + k]; r.w[k] = PW[m * 4 + k]; } };
    auto ld_x = [&](int m, u32x2 (&xw)[4]) {
#pragma unroll
        for (int j = 0; j < 4; ++j) xw[j] = __builtin_nontemporal_load((const u32x2*)(X1B + (size_t)m * D + F.lane * 4 + 256 * j)); };
    auto ld_y = [&](const Rec& r, int (&yv)[16]) {
#pragma unroll
        for (int k = 0; k < 4; ++k) { const unsigned char* yr = YB + (size_t)(tab[32 + r.e[k]] + r.s[k]) * D + F.lane * 4;
#pragma unroll
            for (int j = 0; j < 4; ++j) yv[k * 4 + j] = __builtin_nontemporal_load((const int*)(yr + 256 * j)); } };
    auto ld_row = [&](int m, const Rec& r, int (&yv)[16], u32x2 (&xw)[4]) { ld_y(r, yv); ld_x(m, xw); };
#pragma unroll 1
    for (int g8 = gw; g8 < M / 8; g8 += F.G * 8) {
    const int mbeg = g8 * 8, mend = mbeg + 7;
    int m = mbeg;
    Rec r0, r1; int yv[16]; u32x2 xw[4];
    f32x4 ggt[4];
    { const float* mrow = mod + (mbeg >> 12) * 6144;
#pragma unroll
      for (int j = 0; j < 4; ++j) { const int col = F.lane * 4 + 256 * j; ggt[j] = *(const f32x4*)(gpo + col) * *(const f32x4*)(mrow + 5120 + col); } }
    ld_rec(m, r0);
    ld_rec(m + 1, r1);
    ld_x(m, xw);
    if (pending && g8 == gw) xcd_wait(bar);
    ld_y(r0, yv);
#pragma unroll 1
    for (; m <= mend; ++m) {
        const int m1 = m + 1 <= mend ? m + 1 : m, m2 = m1 + 1 <= mend ? m1 + 1 : m1;
        Rec r2; ld_rec(m2, r2);
        int yn[16]; u32x2 xn[4];
        ld_row(m1, r1, yn, xn);
        f32x4 y[4];
#pragma unroll
        for (int j = 0; j < 4; ++j) y[j] = (f32x4){0.f, 0.f, 0.f, 0.f};
#pragma unroll
        for (int k = 0; k < 4; ++k) { const float w = r0.w[k];
#pragma unroll
            for (int j = 0; j < 4; ++j) { const int v = yv[k * 4 + j];
                const auto lo = __builtin_amdgcn_cvt_pk_f32_fp8(v, false), hi = __builtin_amdgcn_cvt_pk_f32_fp8(v, true);
                y[j].x += w * lo[0]; y[j].y += w * lo[1]; y[j].z += w * hi[0]; y[j].w += w * hi[1]; } }
        float s = 0.f;
#pragma unroll
        for (int j = 0; j < 4; ++j) s += (y[j].x * y[j].x + y[j].y * y[j].y) + (y[j].z * y[j].z + y[j].w * y[j].w);
        const float rstd = rsqrtf(wave_sum(s) * (1.f / D) + EPS);
#pragma unroll
        for (int j = 0; j < 4; ++j) { const int col = F.lane * 4 + 256 * j;
            float* op = a.out + (size_t)m * D + col; const f32x4 x1 = {bflo(xw[j].x), bfhi(xw[j].x), bflo(xw[j].y), bfhi(xw[j].y)};
            __builtin_nontemporal_store(x1 + ggt[j] * (y[j] * rstd), (f32x4*)op); }
        r0 = r1; r1 = r2;
#pragma unroll
        for (int i = 0; i < 16; ++i) yv[i] = yn[i];
#pragma unroll
        for (int j = 0; j < 4; ++j) xw[j] = xn[j];
    }
    }
}

constexpr int NPHASE = 11;
__global__ void __launch_bounds__(512, 2) mk_fwd(Args args) {
    extern __shared__ __attribute__((aligned(16))) unsigned char lds_raw[];
    Frame F;
    F.lds = (LAS unsigned char*)lds_raw; F.ws = args.ws; F.ctl = (unsigned*)(args.ws + WS_CTL);
    F.tid = threadIdx.x; F.lane = F.tid & 63; F.wave = __builtin_amdgcn_readfirstlane(F.tid >> 6); F.G = gridDim.x; F.bid = blockIdx.x;
    volatile LAS unsigned* MISC = (volatile LAS unsigned*)(F.lds + LDS_MISC);
    if (F.tid < 32) MISC[F.tid] = 0u;
    __syncthreads();
    XcdBarrier bar = xcd_barrier_post(F.ctl + CW_BAR + args.li * XCD_BAR_WORDS, MISC + 8);
    const int lo = args.ph_lo, hi = args.ph_hi;
#ifndef PHMASK
#define PHMASK 0x7ff
#endif
#define IN(k) (((PHMASK >> (k)) & 1) && lo <= (k) && (k) < hi)
#define SEAM(k) do { if (IN(k) && IN((k) + 1)) xcd_barrier(bar); } while (0)

    if (IN(0)) { p0_prologue(F, args); }
    if (IN(1)) for (int rep = 0; rep <= ((REPMASK >> 1) & 1); ++rep) { if (rep) xcd_barrier(bar); p1_normmod(F, args, 192u); }
    if (IN(1) && IN(2)) xcd_arrive(bar);
    if (IN(2)) for (int rep = 0; rep <= ((REPMASK >> 2) & 1); ++rep) { if (rep) xcd_barrier(bar);
        pg8::StaticOrder S; S.init(F.ws + WS_HX, F.ws + WS_WIN, M, NIN, D, F.G, F.bid);
        EpiInProj E{(bf16_t*)(F.ws + WS_P), args.in[12], (bf16_t*)(F.ws + WS_U), args.in[13]};
        const int nctx = 24;
        const bool tfirst = (F.bid >= nctx) && (((F.bid >> 3) & 1) != 0);
        const int nbefore = tfirst ? 11 : 2;
        if (F.bid >= nctx) { transpose_items_fp8(F, args, (F.bid - nctx) * 8 + F.wave, (F.G - nctx) * 8, 0, nbefore); __syncthreads(); }
        if (IN(1) && rep == 0) xcd_wait(bar);
        {
            pg8::P2Order O; O.S = S; O.ctx = (F.bid < nctx);
            O.cu.pm = 64 + F.bid / 6; O.cu.pn = 2 + F.bid % 6; O.cu.A = (const char*)(F.ws + WS_HX) + (size_t)O.cu.pm * 256 * D * 2; O.cu.B = (const char*)(F.ws + WS_WIN) + (size_t)O.cu.pn * 256 * D * 2;
            pg8::gemm_phase<EpiInProj, pg8::P2Order, false, true, true>(F.lds, D, O, E);
        }
        const bool lastrep = rep == ((REPMASK >> 2) & 1);
        if (F.bid >= nctx) {
            if (IN(3) && lastrep) xcd_arrive(bar);
            transpose_items_fp8(F, args, (F.bid - nctx) * 8 + F.wave, (F.G - nctx) * 8, nbefore, 1 << 20); __syncthreads();
        }
        if (F.bid < nctx) {
            asm volatile("s_waitcnt vmcnt(0)" ::: "memory");
            __syncthreads();
            if (F.tid == 0) { __builtin_amdgcn_fence(__ATOMIC_RELEASE, "agent"); asm volatile("s_waitcnt vmcnt(0)" ::: "memory");
                __hip_atomic_fetch_add(F.ctl + CW_CTX + 64 * (F.bid / 6), 1u, __ATOMIC_RELAXED, __HIP_MEMORY_SCOPE_AGENT); }
            if (IN(3) && lastrep) xcd_arrive(bar);
            const bf16_t* P = (const bf16_t*)(F.ws + WS_P); bf16_t* ST = (bf16_t*)(F.ws + WS_ST); float* DDp = (float*)(F.ws + WS_DD);
            for (int u = F.bid; u < 32; u += nctx) {
                const int b = u >> 3, h = (u >> 1) & 3;
                if (F.tid == 0) { unsigned sp = 0;
                    while (__hip_atomic_load(F.ctl + CW_CTX + 64 * b, __ATOMIC_RELAXED, __HIP_MEMORY_SCOPE_AGENT) < 6u * (unsigned)(rep + 1)) { __builtin_amdgcn_s_sleep(2); if (++sp > (1u << 22)) break; }
                    __builtin_amdgcn_fence(__ATOMIC_ACQUIRE, "agent"); asm volatile("s_waitcnt vmcnt(0)" ::: "memory"); }
                __syncthreads();
                if (u & 1) gla_passA_unit<1>(F, P, b, h, 0, ST + (size_t)(u * NBLK) * 16384, DDp + (u * NBLK) * 128);
                else gla_passA_unit<0>(F, P, b, h, 0, ST + (size_t)(u * NBLK) * 16384, DDp + (u * NBLK) * 128);
                __syncthreads();
            }
        }
    }
    if (IN(2) && IN(3)) xcd_wait(bar);
    if (IN(3)) for (int rep = 0; rep <= ((REPMASK >> 3) & 1); ++rep) { if (rep) xcd_barrier(bar);
        const bf16_t* P = (const bf16_t*)(F.ws + WS_P); bf16_t* A2 = (bf16_t*)(F.ws + WS_A2);
        const bf16_t* Up = (const bf16_t*)(F.ws + WS_U);
        bf16_t* ST = (bf16_t*)(F.ws + WS_ST); float* DDp = (float*)(F.ws + WS_DD);
        for (int uu = F.bid; uu < 32 * 16; uu += F.G) { const int seq = uu >> 4, blk = 1 + (uu & 15), b = seq >> 3, h = (seq >> 1) & 3, dir = seq & 1, u = seq * NBLK + blk;
            if (dir == 0) gla_passA_unit<0>(F, P, b, h, blk, ST + (size_t)u * 16384, DDp + u * 128);
            else gla_passA_unit<1>(F, P, b, h, blk, ST + (size_t)u * 16384, DDp + u * 128); }
    }
    if (IN(3) && IN(4)) xcd_arrive(bar);
    if (IN(3)) {
        bf16_t* A2 = (bf16_t*)(F.ws + WS_A2); const bf16_t* Up = (const bf16_t*)(F.ws + WS_U);
        for (int w = F.bid; w < 256; w += F.G) {
            const int grp = (w & 7) * 4 + ((w >> 3) >> 3), mem = (w >> 3) & 7, b = grp >> 3, slab = (grp & 7) * 8 + mem, gi = slab >> 4;
            if (gi == 0) pool_unit<2>(F, Up, A2, b, slab); else if (gi == 1) pool_unit<4>(F, Up, A2, b, slab); else if (gi == 2) pool_unit<8>(F, Up, A2, b, slab); else pool_unit<16>(F, Up, A2, b, slab); }
    }
    if (IN(3) && IN(4)) xcd_wait(bar);
    if (IN(4)) { p4_scan(F); }
    if (IN(4) && IN(5)) xcd_arrive(bar);
    if (IN(4)) p0_late(F, args);
    if (IN(4) && IN(5)) xcd_wait(bar);
    if (IN(5)) for (int rep = 0; rep <= ((REPMASK >> 5) & 1); ++rep) { if (rep) xcd_barrier(bar); for (int u = F.bid; u < 256; u += F.G) {
            const int x = u & 7, slot = u >> 3;
            gla_passC_unit(F, args, x >> 1, slot >> 3, (x & 1) * 8 + (slot & 7)); } }
    SEAM(5);
    if (IN(6)) for (int rep = 0; rep <= ((REPMASK >> 6) & 1); ++rep) { if (rep) xcd_barrier(bar);
        pg8::StaticOrder S; S.init(F.ws + WS_A2, F.ws + WS_WOUT, M, D, D, F.G, F.bid);
        EpiBf16Out E{(bf16_t*)(F.ws + WS_YXB), D};
        pg8::gemm_phase<EpiBf16Out, pg8::StaticOrder, false, false, true>(F.lds, D, S, E);
    }
    if (IN(6) && IN(7)) xcd_arrive(bar);
    if (IN(7)) { p7_rows(F, args, bar, IN(6) && IN(7)); }
    SEAM(7);
    if (IN(8)) for (int rep = 0; rep <= ((REPMASK >> 8) & 1); ++rep) { if (rep) xcd_barrier(bar);
        moe_tables(F);
        MoeOrder<8, true> S; S.tab = (const LAS int*)(F.lds + LDS_TAB); S.Abase = (const char*)(F.ws + WS_HX2F); S.Wbase = (const char*)(F.ws + WS_WGU); S.rtok = (const int*)(F.ws + WS_RTOK);
        S.cls = 0; S.rank = (F.bid & 7) * (F.G >> 3) + (F.bid >> 3); S.nrank = F.G; S.mtc = F.ctl + CW_MT;
        EpiGateUp E{F.ws + WS_H, args.in[19], args.in[21]};
        pg8::gemm_phase<EpiGateUp, MoeOrder<8, true>, true, true, true, true>(F.lds, 512, S, E);
    }
    if (IN(9)) for (int rep = 0; rep <= ((REPMASK >> 9) & 1); ++rep) { if (rep) xcd_barrier(bar);
        if (!IN(8) || rep) moe_tables(F);
        MoeOrder<4, false> S; S.tab = (const LAS int*)(F.lds + LDS_TAB); S.Abase = (const char*)(F.ws + WS_H); S.Wbase = (const char*)(F.ws + WS_WDN); S.rtok = nullptr;
        S.cls = 0; S.rank = F.G - 1 - ((F.bid & 7) * (F.G >> 3) + (F.bid >> 3)); S.nrank = F.G; S.mtc = F.ctl + CW_MT;
        EpiDown E{F.ws + WS_YB, args.in[23]};
        pg8::gemm_phase<EpiDown, MoeOrder<4, false>, false, true, true, true>(F.lds, 512, S, E);
    }
    if (IN(9) && IN(10)) xcd_arrive(bar);
    if (IN(10)) { if (!IN(9)) moe_tables(F);
        p10_final(F, args, bar, IN(9) && IN(10)); }
#undef IN
#undef SEAM
}

extern "C" void kernel_launch(void* const* d_in, const int* in_sizes, int n_in, void* d_out, int out_size, void* d_ws, size_t ws_size, hipStream_t stream) {
    static int grid = 0;
    if (grid == 0) {
        if (n_in != 24 || out_size != M * D || ws_size < WS_END) { fprintf(stderr, "kernel_launch: unexpected shapes (n_in %d out %d ws %zu)\n", n_in, out_size, ws_size); grid = -1; return; }
        int dev = 0, cus = 0, per_cu = 0;
        if (hipGetDevice(&dev) != hipSuccess || hipDeviceGetAttribute(&cus, hipDeviceAttributeMultiprocessorCount, dev) != hipSuccess) { grid = -1; return; }
        if (hipFuncSetAttribute((const void*)mk_fwd, hipFuncAttributeMaxDynamicSharedMemorySize, LDS_BYTES) != hipSuccess) { fprintf(stderr, "kernel_launch: hipFuncSetAttribute failed\n"); grid = -1; return; }
        if (hipOccupancyMaxActiveBlocksPerMultiprocessor(&per_cu, (const void*)mk_fwd, 512, LDS_BYTES) != hipSuccess || per_cu < 1) { fprintf(stderr, "kernel_launch: occupancy query says %d\n", per_cu); }
        (void)hipGetLastError();
        grid = cus;
        if (grid % 8 != 0 || M % grid != 0 || (M / grid) % 64 != 0) { fprintf(stderr, "kernel_launch: unsupported CU count %d\n", cus); grid = -1; return; }
    }
    if (grid < 0) return;
    if (hipMemsetAsync((char*)d_ws + WS_CTL, 0, CTL_ZERO_BYTES, stream) != hipSuccess) return;
    Args a{};
    for (int i = 0; i < 24; ++i) a.in[i] = (const float*)d_in[i];
    a.out = (float*)d_out; a.ws = (unsigned char*)d_ws; a.pad = 0;
    constexpr int NL = MK_N_LAUNCHES;
    for (int li = 0; li < NL; ++li) {
        a.ph_lo = (NL == 1) ? 0 : li; a.ph_hi = (NL == 1) ? NPHASE : li + 1; a.li = (NL == 1) ? 0 : 0;
        hipLaunchKernelGGL(mk_fwd, dim3(grid), dim3(512), LDS_BYTES, stream, a);
    }
}
```

```cpp
#include <hip/hip_runtime.h>
#include <cstdio>
#include <cstdint>

#define LAS __attribute__((address_space(3)))
typedef unsigned short bf16_t;
typedef short bf16x8 __attribute__((ext_vector_type(8)));
typedef float f32x4 __attribute__((ext_vector_type(4)));
typedef float f32x16 __attribute__((ext_vector_type(16)));
typedef unsigned u32x4 __attribute__((ext_vector_type(4)));
typedef unsigned u32x2 __attribute__((ext_vector_type(2)));

#ifndef MK_N_LAUNCHES
#define MK_N_LAUNCHES 1
#endif
#ifndef REPMASK
#define REPMASK 0x000
#endif

constexpr int D = 1024, NB = 4, SEQ = 4096, M = NB * SEQ, CTXL = 256, MC = NB * CTXL, MTOT = M + MC;
constexpr int NIN = 3072, NE = 32, TOPK = 4, FF = 1024;
constexpr int NHEAD = 4, HD = 128;
constexpr int NBLK = 17;
constexpr int ECAP = 16384;
constexpr int HROWS = 65536 + NE * 256;
constexpr float EPS = 1e-6f;

constexpr size_t MiB = 1u << 20;
constexpr size_t WS_CTL = 0, CTL_ZERO_BYTES = 1 * MiB;
constexpr size_t WS_MOD = 1 * MiB;
constexpr size_t WS_WRH = 1 * MiB + 128 * 1024;
constexpr size_t WS_WRL = 1 * MiB + 192 * 1024;
constexpr size_t WS_PE = 1 * MiB + 256 * 1024;
constexpr size_t WS_PSLOT = WS_PE + 256 * 1024;
constexpr size_t WS_PW = WS_PSLOT + 256 * 1024;
constexpr size_t WS_WIN = 2 * MiB;
constexpr size_t WS_WOUT = 8 * MiB;
constexpr size_t WS_WGU = 10 * MiB;
constexpr size_t WS_WDN = 74 * MiB;
constexpr size_t WS_HX2 = 106 * MiB;
constexpr size_t WS_HX2F = 138 * MiB;
constexpr size_t WS_U = 138 * MiB;
constexpr size_t WS_YB = 154 * MiB;
constexpr size_t WS_P = 234 * MiB;
constexpr size_t WS_X1B = 234 * MiB;
constexpr size_t WS_H = 298 * MiB;
constexpr size_t WS_HX = 336 * MiB;
constexpr size_t WS_ST = 370 * MiB;
constexpr size_t WS_DD = 405 * MiB;
constexpr size_t WS_A2 = 406 * MiB;
constexpr size_t WS_YX = 438 * MiB;
constexpr size_t WS_YXB = 470 * MiB;
constexpr size_t WS_RTOK = 502 * MiB;
constexpr size_t WS_END = 504 * MiB;
static_assert(WS_YB + (size_t)HROWS * 1024 * 2 <= WS_H && WS_H + (size_t)HROWS * 1024 <= WS_ST, "MoE buffers");
static_assert(WS_P + (size_t)MTOT * NIN * 2 <= WS_HX && WS_HX + (size_t)MTOT * D * 2 <= WS_ST && WS_ST + (size_t)32 * NBLK * 16384 * 4 <= WS_DD, "ws map");
constexpr float WSCALE = 256.0f, WSCALE_INV = 1.0f / 256.0f;

constexpr int CW_BAR = 4096;
constexpr int CW_CNT = 8192;
constexpr int CW_MT = 32768;
constexpr int CW_MOD = 12800;
constexpr int CW_CTX = 12288;

constexpr int RING_BYTES = 131072;
constexpr int LDS_TAB = RING_BYTES;
constexpr int LDS_MISC = RING_BYTES + 4096;
constexpr int LDS_BIAS = RING_BYTES + 1024;
constexpr int LDS_GOFF = RING_BYTES + 6144;
constexpr int LDS_BYTES = 155648;
static_assert(LDS_GOFF + 2 * 512 * 16 <= LDS_BYTES, "LDS map");
static_assert(8 * 16384 <= RING_BYTES, "per-wave scratch stays below the LDS tables / control words");

typedef float f32x2_ __attribute__((ext_vector_type(2)));
typedef __bf16 bf16x2_ __attribute__((ext_vector_type(2)));
__device__ __forceinline__ unsigned cvt_pk_bf16(float lo, float hi) { const bf16x2_ r = __builtin_convertvector((f32x2_){lo, hi}, bf16x2_); return __builtin_bit_cast(unsigned, r); }
__device__ __forceinline__ float bf2f(unsigned short b) { return __uint_as_float(((unsigned)b) << 16); }
__device__ __forceinline__ float bflo(unsigned w) { return __uint_as_float(w << 16); }
__device__ __forceinline__ float bfhi(unsigned w) { return __uint_as_float(w & 0xffff0000u); }
__device__ __forceinline__ unsigned short f2bf(float f) { return (unsigned short)(cvt_pk_bf16(f, 0.f) & 0xffffu); }
__device__ __forceinline__ unsigned pk4_fp8(float a, float b, float c, float d) { int w = __builtin_amdgcn_cvt_pk_fp8_f32(a, b, 0, false); w = __builtin_amdgcn_cvt_pk_fp8_f32(c, d, w, true); return (unsigned)w; }
__device__ __forceinline__ float sigmoidf_(float x) { return __builtin_amdgcn_rcpf(1.0f + __builtin_amdgcn_exp2f(-1.44269504089f * x)); }
__device__ __forceinline__ float wave_sum(float v) {
#pragma unroll
    for (int o = 1; o < 64; o <<= 1) v += __shfl_xor(v, o);
    return v;
}
#define TOUCH4(v) asm volatile("" : "+v"((v).x), "+v"((v).y), "+v"((v).z), "+v"((v).w))
#define TOUCH2(v) asm volatile("" : "+v"((v).x), "+v"((v).y))
#define LDS_WAIT() asm volatile("s_waitcnt lgkmcnt(0)" ::: "memory")
#define VM_WAIT() asm volatile("s_waitcnt vmcnt(0)" ::: "memory")
#define LSYNC() do { asm volatile("s_waitcnt lgkmcnt(0)" ::: "memory"); __builtin_amdgcn_s_barrier(); asm volatile("" ::: "memory"); } while (0)

#define XB_TMO      128
#define XB_XCNT(j)  (256  + 64 * (j))
#define XB_XSUB(j)  (1280 + 64 * (j))
#define XB_XGEN(j)  (2304 + 64 * (j))
#define XB_TOP      3328
#define XB_TOPGEN   3392
#define XCD_BAR_WORDS 3456
#define XB_SPIN_CAP (1u << 18)
__device__ __forceinline__ unsigned xb_ld(unsigned* p)              { return __hip_atomic_load(p, __ATOMIC_RELAXED, __HIP_MEMORY_SCOPE_AGENT); }
__device__ __forceinline__ unsigned xb_add(unsigned* p, unsigned v) { return __hip_atomic_fetch_add(p, v, __ATOMIC_RELAXED, __HIP_MEMORY_SCOPE_AGENT); }
__device__ __forceinline__ unsigned xb_xcc_id() { return (unsigned)__builtin_amdgcn_s_getreg((3 << 11) | 20) & 0xFu; }
#define XB_SPIN(cond, bar) do { unsigned _sp = 0; while (cond) { __builtin_amdgcn_s_sleep(1); \
    if ((++_sp & 255u) == 0u) { if (xb_ld(&(bar)[XB_TMO])) break; if (_sp > XB_SPIN_CAP) { atomicAdd(&(bar)[XB_TMO], 1u); break; } } } } while (0)
struct XcdBarrier { unsigned* bar; unsigned x; volatile LAS unsigned* st; };
__device__ __forceinline__ XcdBarrier xcd_barrier_post(unsigned* bar, volatile LAS unsigned* st) {
    XcdBarrier b; b.bar = bar; b.x = xb_xcc_id(); b.st = st;
    if (threadIdx.x == 0) (void)xb_add(&bar[XB_XCNT(b.x)], 1u);
    return b;
}
__device__ __forceinline__ void xcd_barrier_complete(unsigned* bar, unsigned x, unsigned& nloc, unsigned& nx) {
    const unsigned G = gridDim.x * gridDim.y * gridDim.z;
    unsigned sum, cnt, mine, sp = 0u;
    for (;;) {
        sum = 0u; cnt = 0u; mine = 0u;
#pragma unroll
        for (unsigned j = 0; j < 16; ++j) { const unsigned c = xb_ld(&bar[XB_XCNT(j)]); sum += c; cnt += (c > 0u) ? 1u : 0u; mine = (j == x) ? c : mine; }
        if (sum == G) break;
        __builtin_amdgcn_s_sleep(1);
        if ((++sp & 255u) == 0u) { if (xb_ld(&bar[XB_TMO])) break; if (sp > XB_SPIN_CAP) { atomicAdd(&bar[XB_TMO], 1u); break; } }
    }
    nloc = mine > 0u ? mine : 1u; nx = cnt > 0u ? cnt : 1u;
}
__device__ __forceinline__ void xcd_arrive(const XcdBarrier& b) {
    asm volatile("s_waitcnt vmcnt(0)" ::: "memory");
    __syncthreads();
    if (threadIdx.x == 0) {
        unsigned* bar = b.bar;
        __builtin_amdgcn_s_waitcnt(0);
        unsigned nloc = b.st[0], nx = b.st[1];
        if (nloc == 0u) { xcd_barrier_complete(bar, b.x, nloc, nx); b.st[0] = nloc; b.st[1] = nx; }
        const unsigned old = xb_add(&bar[XB_XSUB(b.x)], 1u);
        const unsigned gen = old / nloc;
        if (old + 1u == (gen + 1u) * nloc) {
            __builtin_amdgcn_fence(__ATOMIC_RELEASE, "agent");
            asm volatile("s_waitcnt vmcnt(0)" ::: "memory");
#pragma unroll
            for (unsigned j = 0; j < 16; ++j) (void)xb_add(&bar[XB_XGEN(j)], 1u);
        }
        b.st[2] = nx * (gen + 1u);
    }
}
__device__ __forceinline__ void xcd_wait(const XcdBarrier& b) {
    if (threadIdx.x == 0) {
        unsigned* bar = b.bar;
        const unsigned need = b.st[2];
        XB_SPIN((int)(xb_ld(&bar[XB_XGEN(b.x)]) - need) < 0, bar);
        __builtin_amdgcn_fence(__ATOMIC_ACQUIRE, "agent");
        asm volatile("s_waitcnt vmcnt(0)" ::: "memory");
    }
    __syncthreads();
}
__device__ __forceinline__ void xcd_barrier(const XcdBarrier& b) { xcd_arrive(b); xcd_wait(b); }

namespace pg8 {
constexpr int BM = 256, BK = 64, HALF = 128, HTB = HALF * BK * 2, STAGE_BYTES = 8 * HTB, NXCD = 8, WGM = 8;
__host__ __device__ __forceinline__ int lds_byte(int r, int c) { const int st = (r >> 4) * 2 + (c >> 5), rr = r & 15, cc = c & 31, ob = rr * 64 + cc * 2; return st * 1024 + (ob ^ (((ob >> 9) & 1) << 5)); }
__host__ __device__ __forceinline__ void stage_rc(int b, int& R, int& C) { const int st = b / 1024, sb = b % 1024, swz = sb ^ (((sb >> 9) & 1) << 5); R = (st >> 1) * 16 + swz / 64; C = (st & 1) * 32 + (swz % 64) / 2; }
__host__ __device__ __forceinline__ int perm32(int rho) { const int n = rho >> 4, i = rho & 15; return 8 * (i >> 2) + 4 * n + (i & 3); }

struct UnitS { const char* A; const char* B; int pm, pn; };
struct StaticOrder {
    typedef UnitS Unit;
    const char* Abase; const char* Bbase; size_t tstep;
    int nM, nN, nwg, G, c;
    __device__ void init(const void* A, const void* Bt, int M_, int N_, int K_, int G_, int c_) { Abase = (const char*)A; Bbase = (const char*)Bt; tstep = (size_t)BM * K_ * 2; nM = M_ / BM; nN = N_ / BM; nwg = nM * nN; G = G_; c = c_; }
    __device__ bool next(int i, Unit& u) const {
        const long L = (long)i * G + c; if (L >= nwg) return false;
        int wgid = (int)L; { const int q = nwg / NXCD, r = nwg % NXCD, xcd = wgid % NXCD, off = wgid / NXCD; wgid = (xcd < r ? xcd * (q + 1) : r * (q + 1) + (xcd - r) * q) + off; }
        const int nig = WGM * nN, gid = wgid / nig, fm = gid * WGM, gsz = (nM - fm) < WGM ? (nM - fm) : WGM;
        u.pm = fm + ((wgid % nig) % gsz); u.pn = (wgid % nig) / gsz;
        u.A = Abase + (size_t)u.pm * tstep; u.B = Bbase + (size_t)u.pn * tstep; return true;
    }
    static constexpr bool PUBLISH = false;
    __device__ __forceinline__ const int* row_src(const Unit&, int) const { return nullptr; }
    __device__ __forceinline__ unsigned row_tok(const Unit&, int) const { return 0u; }
    __device__ __forceinline__ void a_ready(const Unit&, int) const {}
    __device__ __forceinline__ int key(const Unit&) const { return 0; }
    __device__ __forceinline__ void publish(int) const {}
};

struct OneUnit { typedef UnitS Unit; UnitS u; static constexpr bool PUBLISH = false;
    __device__ bool next(int i, Unit& o) const { if (i) return false; o = u; return true; }
    __device__ __forceinline__ const int* row_src(const Unit&, int) const { return nullptr; } __device__ __forceinline__ unsigned row_tok(const Unit&, int) const { return 0u; }
    __device__ __forceinline__ void a_ready(const Unit&, int) const {} __device__ __forceinline__ int key(const Unit&) const { return 0; } __device__ __forceinline__ void publish(int) const {} };
struct P2Order { typedef UnitS Unit; StaticOrder S; UnitS cu; bool ctx; static constexpr bool PUBLISH = false;
    __device__ bool next(int i, Unit& o) const { if (i < 3) return S.next(i, o); if (i == 3 && ctx) { o = cu; return true; } return false; }
    __device__ __forceinline__ const int* row_src(const Unit&, int) const { return nullptr; } __device__ __forceinline__ unsigned row_tok(const Unit&, int) const { return 0u; }
    __device__ __forceinline__ void a_ready(const Unit&, int) const {} __device__ __forceinline__ int key(const Unit&) const { return 0; } __device__ __forceinline__ void publish(int) const {} };
typedef int i32x4 __attribute__((ext_vector_type(4)));
typedef int i32x8 __attribute__((ext_vector_type(8)));
template <class Epi, class Sched, bool GATHER, bool ALIGN_EPI, bool SP2, bool FP8 = false>
__device__ __forceinline__ void gemm_phase(LAS unsigned char* lds, const int K, const Sched& S, const Epi& E) {
    typedef typename Sched::Unit Unit;
    const int tid = threadIdx.x, wid = __builtin_amdgcn_readfirstlane(tid >> 6), lane = tid & 63, wr = wid >> 2, wc = wid & 3, fr = lane & 15, fq = lane >> 4;
    const int nt = K / BK;
    const size_t kstep = (size_t)(BK * 2);
    const size_t kstepB = FP8 ? (size_t)4096 : kstep;
    const size_t hstep = (size_t)HALF * K * 2;
    unsigned voffB[2], cA0[2], cA1[2];
#pragma unroll
    for (int i = 0; i < 2; ++i) { int R, C; stage_rc(tid * 16 + i * 8192, R, C); const int Rb = Epi::PERM ? ((R & ~31) + perm32(R & 31)) : R;
        voffB[i] = FP8 ? (unsigned)((Rb >> 5) * 32768 + (Rb & 31) * 128 + C * 2) : (unsigned)(Rb * K + C) * 2u; cA0[i] = (unsigned)(R * K + C) * 2u; cA1[i] = cA0[i] + (unsigned)hstep; }
#define gro(p, v) ((LAS unsigned*)(lds + LDS_GOFF + (p) * 8192 + (v) * 2048 + tid * 4))
    int gp = 0;
    unsigned gcc[2] = {0u, 0u};
    if constexpr (GATHER) { int R, C; stage_rc(tid * 16, R, C); gcc[0] = (unsigned)C * 2u; stage_rc(tid * 16 + 8192, R, C); gcc[1] = (unsigned)C * 2u; }
    const unsigned ldsw = (unsigned)wid * 1024u;
    const int aoff = lds_byte(wr * 64 + fr, fq * 8), boff = lds_byte(wc * 32 + fr, fq * 8);
#define PG8_SA(b, h) (((b) * 2 + (h)) * HTB)
#define PG8_SB(b, h) ((4 + (b) * 2 + (h)) * HTB)
#define PG8_STAGE(bufoff, gbase, voff) do { _Pragma("unroll") for (int _i = 0; _i < 2; ++_i) \
        __builtin_amdgcn_global_load_lds((const unsigned*)((const char*)(gbase) + (voff)[_i]), (LAS unsigned*)(lds + (bufoff) + ldsw + _i * 8192), 16, 0, 0); } while (0)
#define PG8_LDA(dst, b, h) do { _Pragma("unroll") for (int m = 0; m < 4; ++m) { const i32x4 _p0 = *(const LAS i32x4*)(lds + PG8_SA(b, h) + aoff + m * 2048), _p1 = *(const LAS i32x4*)(lds + PG8_SA(b, h) + aoff + m * 2048 + 1024); \
        dst[m] = __builtin_shufflevector(_p0, _p1, 0, 1, 2, 3, 4, 5, 6, 7); } } while (0)
#define PG8_LDB(dst, b, h) do { _Pragma("unroll") for (int n = 0; n < 2; ++n) { const i32x4 _p0 = *(const LAS i32x4*)(lds + PG8_SB(b, h) + boff + n * 2048), _p1 = *(const LAS i32x4*)(lds + PG8_SB(b, h) + boff + n * 2048 + 1024); \
        dst[n] = __builtin_shufflevector(_p0, _p1, 0, 1, 2, 3, 4, 5, 6, 7); } } while (0)
#define PG8_ACC(ai, bj, m, n) ((n) ? __builtin_shufflevector(acc[ai][bj][m], acc[ai][bj][m], 4, 5, 6, 7) : __builtin_shufflevector(acc[ai][bj][m], acc[ai][bj][m], 0, 1, 2, 3))
#define PG8_SETACC(ai, bj, m, n, v) do { const f32x4 _v = (v); if (n) acc[ai][bj][m] = __builtin_shufflevector(acc[ai][bj][m], __builtin_shufflevector(_v, _v, 0, 1, 2, 3, 0, 1, 2, 3), 0, 1, 2, 3, 12, 13, 14, 15); \
        else acc[ai][bj][m] = __builtin_shufflevector(acc[ai][bj][m], __builtin_shufflevector(_v, _v, 0, 1, 2, 3, 0, 1, 2, 3), 8, 9, 10, 11, 4, 5, 6, 7); } while (0)
#define PG8_MMA(ai, bj, At, Bt) do { __builtin_amdgcn_s_setprio(1); _Pragma("unroll") for (int m = 0; m < 4; ++m) _Pragma("unroll") for (int n = 0; n < 2; ++n) { \
        if constexpr (FP8) { PG8_SETACC(ai, bj, m, n, __builtin_amdgcn_mfma_scale_f32_16x16x128_f8f6f4(Bt[n], At[m], PG8_ACC(ai, bj, m, n), 0, 0, 0, 127, 0, 127)); } \
        else { f32x4 _c = __builtin_amdgcn_mfma_f32_16x16x32_bf16(__builtin_bit_cast(bf16x8, __builtin_shufflevector(Bt[n], Bt[n], 0, 1, 2, 3)), __builtin_bit_cast(bf16x8, __builtin_shufflevector(At[m], At[m], 0, 1, 2, 3)), PG8_ACC(ai, bj, m, n), 0, 0, 0); \
               PG8_SETACC(ai, bj, m, n, __builtin_amdgcn_mfma_f32_16x16x32_bf16(__builtin_bit_cast(bf16x8, __builtin_shufflevector(Bt[n], Bt[n], 4, 5, 6, 7)), __builtin_bit_cast(bf16x8, __builtin_shufflevector(At[m], At[m], 4, 5, 6, 7)), _c, 0, 0, 0)); } } \
        __builtin_amdgcn_s_setprio(0); } while (0)
#define PG8_WAIT_V(n) asm volatile("s_waitcnt vmcnt(" #n ")" ::: "memory")
#define PG8_WAIT_L(n) asm volatile("s_waitcnt lgkmcnt(" #n ")" ::: "memory")
#define PG8_BAR __builtin_amdgcn_s_barrier()
#define PG8_SCHED __builtin_amdgcn_sched_barrier(0)
    Unit cur, nxt; int ui = 0; int pkey = 0;
    if (!S.next(0, cur)) return;
    S.a_ready(cur, wid);
    if constexpr (GATHER) {
#pragma unroll
        for (int i = 0; i < 2; ++i) { int R, C; int t2 = tid; asm volatile("" : "+v"(t2)); stage_rc(t2 * 16 + i * 8192, R, C);
            const unsigned r0 = S.row_tok(cur, R), r1 = S.row_tok(cur, HALF + R); *gro(0, i) = r0; *gro(0, 2 + i) = r1;
            cA0[i] = r0 + (unsigned)C * 2u; cA1[i] = r1 + (unsigned)C * 2u; }
    }
    typedef float f32x8_ __attribute__((ext_vector_type(8)));
    f32x8_ acc[2][2][4];
    float zero_; asm volatile("v_mov_b32 %0, 0" : "=v"(zero_));
#pragma unroll
    for (int a = 0; a < 2; ++a)
#pragma unroll
        for (int b = 0; b < 2; ++b)
#pragma unroll
            for (int m = 0; m < 4; ++m) acc[a][b][m] = (f32x8_){zero_, zero_, zero_, zero_, zero_, zero_, zero_, zero_};
    i32x8 At[4], B0[2], B1[2];
    const char* cA = cur.A; const char* cB = cur.B;
    if constexpr (Epi::LDS_BIAS) E.stage_bias(cur, lds + LDS_BIAS, wid, lane);
    if constexpr (SP2) {
        PG8_STAGE(PG8_SB(0, 0), cB, voffB); PG8_STAGE(PG8_SB(0, 1), cB + hstep, voffB); PG8_STAGE(PG8_SA(0, 0), cA, cA0); PG8_STAGE(PG8_SA(0, 1), cA, cA1);
        if (wr == 1) PG8_BAR;
        PG8_WAIT_V(2); PG8_BAR;
        PG8_STAGE(PG8_SB(1, 0), cB + kstepB, voffB); PG8_STAGE(PG8_SA(1, 0), cA + kstep, cA0); PG8_STAGE(PG8_SB(1, 1), cB + hstep + kstepB, voffB);
        PG8_WAIT_V(6); PG8_BAR;
    } else {
        PG8_STAGE(PG8_SB(0, 0), cB, voffB); PG8_STAGE(PG8_SA(0, 0), cA, cA0); PG8_STAGE(PG8_SB(0, 1), cB + hstep, voffB); PG8_STAGE(PG8_SA(0, 1), cA, cA1);
        if (wr == 1) PG8_BAR;
        PG8_WAIT_V(4); PG8_BAR;
        PG8_STAGE(PG8_SB(1, 0), cB + kstepB, voffB); PG8_STAGE(PG8_SA(1, 0), cA + kstep, cA0); PG8_STAGE(PG8_SB(1, 1), cB + hstep + kstepB, voffB);
        PG8_WAIT_V(6); PG8_BAR;
    }
    for (;;) {
        const bool has_next = S.next(ui + 1, nxt);
        const char* nA = has_next ? nxt.A : cA; const char* nB = has_next ? nxt.B : cB;
        if constexpr (GATHER) {
            if (has_next) {
                int R0, C0, R1, C1; int t2 = tid; asm volatile("" : "+v"(t2)); stage_rc(t2 * 16, R0, C0); stage_rc(t2 * 16 + 8192, R1, C1);
                LAS unsigned char* gb = lds + LDS_GOFF + (gp ^ 1) * 8192 + wid * 256;
                __builtin_amdgcn_global_load_lds((const unsigned*)S.row_src(nxt, R0), (LAS unsigned*)(gb), 4, 0, 0);
                __builtin_amdgcn_global_load_lds((const unsigned*)S.row_src(nxt, R1), (LAS unsigned*)(gb + 2048), 4, 0, 0);
                __builtin_amdgcn_global_load_lds((const unsigned*)S.row_src(nxt, HALF + R0), (LAS unsigned*)(gb + 4096), 4, 0, 0);
                __builtin_amdgcn_global_load_lds((const unsigned*)S.row_src(nxt, HALF + R1), (LAS unsigned*)(gb + 6144), 4, 0, 0);
            }
        }
#pragma unroll 1
        for (int t = 0; t < nt; t += 2) {
            const bool last = (t == nt - 2);
            if (last && has_next) S.a_ready(nxt, wid);
            const char* a1 = cA + (size_t)(t + 1) * kstep;
            const char* a2 = last ? nA : cA + (size_t)(t + 2) * kstep; const char* b2 = last ? nB : cB + (size_t)(t + 2) * kstepB;
            const char* a3 = a2 + kstep; const char* b3 = b2 + kstepB;
            const int gq = (last && has_next) ? (gp ^ 1) : gp;
#define PG8_GO(p, v, dst) unsigned dst[2]; if constexpr (GATHER) { dst[0] = *gro(p, v) + gcc[0]; dst[1] = *gro(p, (v) + 1) + gcc[1]; } else { dst[0] = ((v) ? cA1 : cA0)[0]; dst[1] = ((v) ? cA1 : cA0)[1]; }
            if constexpr (SP2) {
            { PG8_GO(gp, 2, y1); PG8_LDB(B0, 0, 0); PG8_LDB(B1, 0, 1); PG8_SCHED; PG8_LDA(At, 0, 0); PG8_STAGE(PG8_SA(1, 1), a1, y1); }
            PG8_WAIT_V(8); PG8_WAIT_L(0); PG8_BAR; PG8_MMA(0, 0, At, B0); PG8_MMA(0, 1, At, B1); PG8_BAR; PG8_SCHED;
            { PG8_GO(gq, 0, x0); PG8_LDA(At, 0, 1); PG8_STAGE(PG8_SB(0, 0), b2, voffB); PG8_STAGE(PG8_SB(0, 1), b2 + hstep, voffB); PG8_STAGE(PG8_SA(0, 0), a2, x0); }
            PG8_WAIT_V(8); PG8_WAIT_L(0); PG8_BAR; PG8_MMA(1, 0, At, B0); PG8_MMA(1, 1, At, B1); PG8_BAR; PG8_SCHED;
            { PG8_GO(gq, 2, x1); PG8_LDB(B0, 1, 0); PG8_LDB(B1, 1, 1); PG8_SCHED; PG8_LDA(At, 1, 0); PG8_STAGE(PG8_SA(0, 1), a2, x1); }
            PG8_WAIT_V(8); PG8_WAIT_L(0); PG8_BAR; PG8_MMA(0, 0, At, B0); PG8_MMA(0, 1, At, B1); PG8_BAR; PG8_SCHED;
            { PG8_GO(gq, 0, x0); PG8_LDA(At, 1, 1); PG8_STAGE(PG8_SB(1, 0), b3, voffB); PG8_STAGE(PG8_SB(1, 1), b3 + hstep, voffB); PG8_STAGE(PG8_SA(1, 0), a3, x0); }
            PG8_WAIT_V(8); PG8_WAIT_L(0); PG8_BAR; PG8_MMA(1, 0, At, B0); PG8_MMA(1, 1, At, B1); PG8_BAR; PG8_SCHED;
            } else {
            PG8_GO(gp, 2, y1); PG8_GO(gq, 0, x0); PG8_GO(gq, 2, x1);
            PG8_LDB(B0, 0, 0); PG8_SCHED; PG8_LDA(At, 0, 0); PG8_STAGE(PG8_SA(1, 1), a1, y1);
            PG8_WAIT_L(8); PG8_BAR; PG8_WAIT_L(0); PG8_MMA(0, 0, At, B0); PG8_BAR; PG8_SCHED;
            PG8_LDB(B1, 0, 1); PG8_STAGE(PG8_SB(0, 0), b2, voffB);
            PG8_BAR; PG8_WAIT_L(0); PG8_MMA(0, 1, At, B1); PG8_BAR;
            PG8_LDA(At, 0, 1); PG8_STAGE(PG8_SA(0, 0), a2, x0);
            PG8_BAR; PG8_WAIT_L(0); PG8_MMA(1, 0, At, B0); PG8_BAR; PG8_SCHED;
            PG8_STAGE(PG8_SB(0, 1), b2 + hstep, voffB);
            PG8_WAIT_V(6); PG8_BAR; PG8_MMA(1, 1, At, B1); PG8_BAR;
            PG8_LDB(B0, 1, 0); PG8_SCHED; PG8_LDA(At, 1, 0); PG8_STAGE(PG8_SA(0, 1), a2, x1);
            PG8_WAIT_L(8); PG8_BAR; PG8_WAIT_L(0); PG8_MMA(0, 0, At, B0); PG8_BAR; PG8_SCHED;
            PG8_LDB(B1, 1, 1); PG8_STAGE(PG8_SB(1, 0), b3, voffB);
            PG8_BAR; PG8_WAIT_L(0); PG8_MMA(0, 1, At, B1); PG8_BAR;
            PG8_LDA(At, 1, 1); PG8_STAGE(PG8_SA(1, 0), a3, x0);
            PG8_BAR; PG8_WAIT_L(0); PG8_MMA(1, 0, At, B0); PG8_BAR; PG8_SCHED;
            PG8_STAGE(PG8_SB(1, 1), b3 + hstep, voffB);
            PG8_WAIT_V(6); PG8_BAR; PG8_MMA(1, 1, At, B1); PG8_BAR;
            }
        }
        if constexpr (ALIGN_EPI) { if (wr == 0) PG8_BAR; }
        asm volatile("" ::: "memory");
        if constexpr (Sched::PUBLISH) { if (ui > 0) S.publish(pkey); }
        { f32x4 av[2][2][4][2];
#pragma unroll
          for (int a = 0; a < 2; ++a)
#pragma unroll
              for (int b = 0; b < 2; ++b)
#pragma unroll
                  for (int m = 0; m < 4; ++m) { av[a][b][m][0] = PG8_ACC(a, b, m, 0); av[a][b][m][1] = PG8_ACC(a, b, m, 1); }
          int t3 = tid; asm volatile("" : "+v"(t3)); const int fr3 = t3 & 15, fq3 = (t3 & 63) >> 4;
          if constexpr (Epi::LDS_BIAS) E(av, cur, wr, wc, fr3, fq3, lds + LDS_BIAS + (ui & 1) * 1024); else E(av, cur, wr, wc, fr3, fq3); }
        if constexpr (Sched::PUBLISH) { pkey = S.key(cur); if (!has_next) S.publish(pkey); }
        if (!has_next) break;
#pragma unroll
        for (int a = 0; a < 2; ++a)
#pragma unroll
            for (int b = 0; b < 2; ++b)
#pragma unroll
                for (int m = 0; m < 4; ++m) acc[a][b][m] = (f32x8_){zero_, zero_, zero_, zero_, zero_, zero_, zero_, zero_};
        cur = nxt; cA = nA; cB = nB; ++ui;
        if constexpr (Epi::LDS_BIAS) E.stage_bias(cur, lds + LDS_BIAS + (ui & 1) * 1024, wid, lane);
        if constexpr (GATHER) gp ^= 1;
        if constexpr (ALIGN_EPI) { if (wr == 1) PG8_BAR; }
    }
    PG8_WAIT_V(0);
    if constexpr (!ALIGN_EPI) { if (wr == 0) PG8_BAR; }
    PG8_BAR;
#undef PG8_SA
#undef PG8_SB
#undef PG8_STAGE
#undef PG8_LDA
#undef PG8_LDB
#undef PG8_MMA
#undef gro
#undef PG8_GO
#undef PG8_ACC
#undef PG8_SETACC
#undef PG8_WAIT_V
#undef PG8_WAIT_L
#undef PG8_BAR
#undef PG8_SCHED
}
}

struct EpiInProj {
    static constexpr bool PERM = true, LDS_BIAS = false;
    bf16_t* P; const float* lbl; bf16_t* U; const float* gain;
    __device__ __forceinline__ void operator()(const f32x4 (&acc)[2][2][4][2], const pg8::UnitS& u, int wr, int wc, int fr, int fq) const {
        typedef float f32x2 __attribute__((ext_vector_type(2)));
        const int row0 = u.pm * 256 + wr * 64 + fr, col0 = u.pn * 256 + wc * 32 + 8 * fq, type = u.pn >> 1;
        f32x2 lbv[2][4], olb[2][4];
#pragma unroll
        for (int bj = 0; bj < 2; ++bj)
#pragma unroll
            for (int p = 0; p < 4; ++p) { lbv[bj][p] = (f32x2){0.f, 0.f}; olb[bj][p] = (f32x2){1.f, 1.f}; }
        if (type == 4) {
#pragma unroll
            for (int bj = 0; bj < 2; ++bj) { const int ch = col0 + bj * 128 - 2048;
#pragma unroll
                for (int p = 0; p < 4; ++p) { lbv[bj][p].x = gain[ch + 2 * p]; lbv[bj][p].y = gain[ch + 2 * p + 1]; } }
#pragma unroll
            for (int bj = 0; bj < 2; ++bj)
#pragma unroll
                for (int p = 0; p < 4; ++p) TOUCH2(lbv[bj][p]);
        }
        if (type == 1 || type == 2) {
#pragma unroll
            for (int bj = 0; bj < 2; ++bj) { const int ch = col0 + bj * 128 - 512;
#pragma unroll
                for (int p = 0; p < 4; ++p) { lbv[bj][p].x = sigmoidf_(lbl[ch + 2 * p] - lbl[1024 + ch + 2 * p]); lbv[bj][p].y = sigmoidf_(lbl[ch + 2 * p + 1] - lbl[1024 + ch + 2 * p + 1]); olb[bj][p] = 1.0f - lbv[bj][p]; } }
        }
#pragma unroll
        for (int ai = 0; ai < 2; ++ai)
#pragma unroll
            for (int m = 0; m < 4; ++m) { bf16_t* rowp = P + (size_t)(row0 + ai * 128 + m * 16) * NIN + col0;
#pragma unroll
                for (int bj = 0; bj < 2; ++bj) { f32x2 v[4];
#pragma unroll
                    for (int p = 0; p < 4; ++p) { const f32x4 a = acc[ai][bj][m][p >> 1]; v[p] = (p & 1) ? (f32x2){a.z, a.w} : (f32x2){a.x, a.y}; }
                    if (type == 0 || type == 1 || type == 2 || type == 4) {
#pragma unroll
                        for (int p = 0; p < 4; ++p) { const f32x2 ea = v[p] * (-1.44269504089f);
                            f32x2 t; t.x = __builtin_amdgcn_exp2f(ea.x); t.y = __builtin_amdgcn_exp2f(ea.y); t = t + 1.0f;
                            f32x2 sg; sg.x = __builtin_amdgcn_rcpf(t.x); sg.y = __builtin_amdgcn_rcpf(t.y);
                            if (type == 0) v[p] = v[p] * sg;
                            else if (type == 4) v[p] = sg * lbv[bj][p];
                            else { const f32x2 f = sg * olb[bj][p] + lbv[bj][p]; f32x2 lg; lg.x = __builtin_amdgcn_logf(f.x); lg.y = __builtin_amdgcn_logf(f.y); v[p] = lg; } }
                    }
                    u32x4 w; w.x = cvt_pk_bf16(v[0].x, v[0].y); w.y = cvt_pk_bf16(v[1].x, v[1].y); w.z = cvt_pk_bf16(v[2].x, v[2].y); w.w = cvt_pk_bf16(v[3].x, v[3].y);
                    if (type == 5) { const int row = row0 + ai * 128 + m * 16, slab = (col0 + bj * 128 - 2560) >> 3;
                        *(u32x4*)(U + ((size_t)((row >> 12) * 64 + slab) * 4096 + (row & 4095)) * 8) = w; }
                    else *(u32x4*)(rowp + bj * 128) = w; } }
    }
};
struct EpiBf16Out {
    static constexpr bool PERM = true, LDS_BIAS = false;
    bf16_t* C; int ldc;
    __device__ __forceinline__ void operator()(const f32x4 (&acc)[2][2][4][2], const pg8::UnitS& u, int wr, int wc, int fr, int fq) const {
        const int row0 = u.pm * 256 + wr * 64 + fr, col0 = u.pn * 256 + wc * 32 + 8 * fq;
#pragma unroll
        for (int ai = 0; ai < 2; ++ai)
#pragma unroll
            for (int m = 0; m < 4; ++m) { bf16_t* rowp = C + (size_t)(row0 + ai * 128 + m * 16) * ldc + col0;
#pragma unroll
                for (int bj = 0; bj < 2; ++bj) { const f32x4 v0 = acc[ai][bj][m][0], v1 = acc[ai][bj][m][1];
                    u32x4 w; w.x = cvt_pk_bf16(v0[0], v0[1]); w.y = cvt_pk_bf16(v0[2], v0[3]); w.z = cvt_pk_bf16(v1[0], v1[1]); w.w = cvt_pk_bf16(v1[2], v1[3]);
                    *(u32x4*)(rowp + bj * 128) = w; } }
    }
};

struct UnitM { const char* A; const char* B; int e, mt, pn, row0, cnt; };
typedef int i32x4_ __attribute__((ext_vector_type(4)));
template <int NT_, bool GATHER_>
struct MoeOrder {
    typedef UnitM Unit;
    static constexpr int pitch = 1024; static constexpr size_t wstride = (size_t)NT_ * 256 * 1024;
    const LAS int* tab;
    const char* Abase; const char* Wbase; const int* rtok;
    unsigned* mtc;
    int cls, rank, nrank;
    static constexpr bool PUBLISH = GATHER_;
    __device__ __forceinline__ int key(const Unit& u) const { return u.row0 >> 8; }
    __device__ __forceinline__ void publish(int k) const {
        asm volatile("s_waitcnt vmcnt(0)" ::: "memory");
        if ((threadIdx.x & 63) == 0) __hip_atomic_fetch_add(mtc + 64 * k, 1u, __ATOMIC_RELAXED, __HIP_MEMORY_SCOPE_AGENT);
    }
    __device__ __forceinline__ void a_ready(const Unit& u, int wid) const {
        if constexpr (!GATHER_) {
            if (wid == 0) { unsigned sp = 0;
                while ((unsigned)__builtin_amdgcn_readfirstlane(__hip_atomic_load(mtc + 64 * (u.row0 >> 8), __ATOMIC_RELAXED, __HIP_MEMORY_SCOPE_AGENT)) < 64u) { __builtin_amdgcn_s_sleep(2); if (++sp > (1u << 22)) break; }
                __builtin_amdgcn_fence(__ATOMIC_ACQUIRE, "agent");
                asm volatile("s_waitcnt vmcnt(0)" ::: "memory"); }
            asm volatile("" ::: "memory"); __builtin_amdgcn_s_barrier(); asm volatile("" ::: "memory");
        }
    }
    __device__ bool next(int i, Unit& u) const {
        const int L = i * nrank + rank; const int mtg = L / NT_; u.pn = L - mtg * NT_;
        if (mtg >= __builtin_amdgcn_readfirstlane(tab[64])) return false;
        int ecount = 0;
#pragma unroll
        for (int q = 0; q < 8; ++q) { const i32x4_ p4 = *(const LAS i32x4_*)(tab + 32 + 4 * q); const int row = mtg * 256;
            ecount += (p4.x <= row) + (p4.y <= row) + (p4.z <= row) + (p4.w <= row); }
        const int e = __builtin_amdgcn_readfirstlane(ecount) - 1;
        const int pb = __builtin_amdgcn_readfirstlane(tab[32 + e]);
        u.e = e; u.mt = mtg - (pb >> 8); u.cnt = __builtin_amdgcn_readfirstlane(tab[e]); u.row0 = mtg * 256;
        u.B = Wbase + (size_t)e * wstride + (size_t)u.pn * 256 * pitch;
        u.A = GATHER_ ? Abase : Abase + (size_t)u.row0 * pitch;
        return true;
    }
    __device__ __forceinline__ const int* row_src(const Unit& u, int r) const { const int slot = u.mt * 256 + r; return rtok + u.e * ECAP + (slot < u.cnt ? slot : 0); }
    __device__ __forceinline__ unsigned row_tok(const Unit& u, int r) const { return (unsigned)*row_src(u, r); }
};
struct EpiGateUp {
    static constexpr bool PERM = true, LDS_BIAS = true;
    unsigned char* H; const float* bg; const float* bu;
    __device__ __forceinline__ void stage_bias(const UnitM& u, LAS unsigned char* dst, int wid, int lane) const {
        if (wid < 4) { const float* src = ((wid & 2) ? bu : bg) + u.e * FF + u.pn * 128 + (wid & 1) * 64 + lane;
            __builtin_amdgcn_global_load_lds((const unsigned*)src, (LAS unsigned*)(dst + wid * 256), 4, 0, 0); }
    }
    __device__ __forceinline__ void operator()(const f32x4 (&acc)[2][2][4][2], const UnitM& u, int wr, int wc, int fr, int fq, const LAS unsigned char* lb) const {
        typedef float f32x2 __attribute__((ext_vector_type(2)));
        const int row0 = u.row0 + wr * 64 + fr, col0 = u.pn * 128 + wc * 32 + 8 * fq;
        const f32x4 g0 = *(const LAS f32x4*)(lb + (wc * 32 + 8 * fq) * 4), g1 = *(const LAS f32x4*)(lb + (wc * 32 + 8 * fq + 4) * 4);
        const f32x4 u0 = *(const LAS f32x4*)(lb + 512 + (wc * 32 + 8 * fq) * 4), u1 = *(const LAS f32x4*)(lb + 512 + (wc * 32 + 8 * fq + 4) * 4);
        const f32x2 gb[4] = {{g0.x, g0.y}, {g0.z, g0.w}, {g1.x, g1.y}, {g1.z, g1.w}}, ub[4] = {{u0.x + 1.0f, u0.y + 1.0f}, {u0.z + 1.0f, u0.w + 1.0f}, {u1.x + 1.0f, u1.y + 1.0f}, {u1.z + 1.0f, u1.w + 1.0f}};
        unsigned pw0 = 0u, pw1 = 0u;
#pragma unroll
        for (int ai = 0; ai < 2; ++ai)
#pragma unroll
            for (int m = 0; m < 4; ++m) { f32x2 h[4];
#pragma unroll
                for (int p = 0; p < 4; ++p) {
                    const f32x4 ag = acc[ai][0][m][p >> 1], au = acc[ai][1][m][p >> 1];
                    f32x2 g = (p & 1) ? (f32x2){ag.z, ag.w} : (f32x2){ag.x, ag.y}, up1 = (p & 1) ? (f32x2){au.z, au.w} : (f32x2){au.x, au.y};
                    g = g * WSCALE_INV + gb[p]; up1 = up1 * WSCALE_INV + ub[p];
                    g.x = fminf(g.x, 7.0f); g.y = fminf(g.y, 7.0f);
                    up1.x = __builtin_amdgcn_fmed3f(up1.x, -6.0f, 8.0f); up1.y = __builtin_amdgcn_fmed3f(up1.y, -6.0f, 8.0f);
                    const f32x2 ea = g * (-1.702f * 1.44269504089f);
                    f32x2 t; t.x = __builtin_amdgcn_exp2f(ea.x); t.y = __builtin_amdgcn_exp2f(ea.y);
                    t = t + 1.0f;
                    f32x2 sg; sg.x = __builtin_amdgcn_rcpf(t.x); sg.y = __builtin_amdgcn_rcpf(t.y);
                    h[p] = (up1 * g) * sg; }
                const unsigned w0 = pk4_fp8(h[0].x, h[0].y, h[1].x, h[1].y), w1 = pk4_fp8(h[2].x, h[2].y, h[3].x, h[3].y);
                if ((m & 1) == 0) { pw0 = w0; pw1 = w1; }
                else { const auto r0 = __builtin_amdgcn_permlane16_swap(pw0, w0, false, false), r1 = __builtin_amdgcn_permlane16_swap(pw1, w1, false, false);
                    u32x4 wv; wv.x = r0[0]; wv.y = r1[0]; wv.z = r0[1]; wv.w = r1[1];
                    const unsigned long long ad = (unsigned long long)(H + (size_t)(row0 + ai * 128 + (m - 1 + (fq & 1)) * 16) * FF + col0 - 8 * (fq & 1));
                    asm volatile("global_store_dwordx4 %0, %1, off sc1\n\ts_nop 2" :: "v"(ad), "v"(wv) : "memory"); } }
    }
};
struct EpiDown {
    static constexpr bool PERM = true, LDS_BIAS = true;
    unsigned char* Y; const float* bd;
    __device__ __forceinline__ void stage_bias(const UnitM& u, LAS unsigned char* dst, int wid, int lane) const {
        if (wid < 4) { const float* src = bd + u.e * D + u.pn * 256 + wid * 64 + lane;
            __builtin_amdgcn_global_load_lds((const unsigned*)src, (LAS unsigned*)(dst + wid * 256), 4, 0, 0); }
    }
    __device__ __forceinline__ void operator()(const f32x4 (&acc)[2][2][4][2], const UnitM& u, int wr, int wc, int fr, int fq, const LAS unsigned char* lb) const {
        const int row0 = u.row0 + wr * 64 + fr, col0 = u.pn * 256 + wc * 32 + 8 * fq;
        f32x4 b8[2][2];
#pragma unroll
        for (int bj = 0; bj < 2; ++bj) { b8[bj][0] = *(const LAS f32x4*)(lb + (bj * 128 + wc * 32 + 8 * fq) * 4); b8[bj][1] = *(const LAS f32x4*)(lb + (bj * 128 + wc * 32 + 8 * fq + 4) * 4); }
        u32x2 pw[2];
#pragma unroll
        for (int ai = 0; ai < 2; ++ai)
#pragma unroll
            for (int m = 0; m < 4; ++m)
#pragma unroll
                for (int bj = 0; bj < 2; ++bj) { const f32x4 v0 = acc[ai][bj][m][0] * WSCALE_INV + b8[bj][0], v1 = acc[ai][bj][m][1] * WSCALE_INV + b8[bj][1];
                    u32x2 w; w.x = pk4_fp8(v0.x, v0.y, v0.z, v0.w); w.y = pk4_fp8(v1.x, v1.y, v1.z, v1.w);
                    if ((m & 1) == 0) pw[bj] = w;
                    else { const auto r0 = __builtin_amdgcn_permlane16_swap(pw[bj].x, w.x, false, false), r1 = __builtin_amdgcn_permlane16_swap(pw[bj].y, w.y, false, false);
                        u32x4 wv; wv.x = r0[0]; wv.y = r1[0]; wv.z = r0[1]; wv.w = r1[1];
                        *(u32x4*)(Y + (size_t)(row0 + ai * 128 + (m - 1 + (fq & 1)) * 16) * D + col0 - 8 * (fq & 1) + bj * 128) = wv; } }
    }
};

struct Args { const float* in[24]; float* out; unsigned char* ws; int ph_lo, ph_hi, li, pad; };
struct Frame {
    LAS unsigned char* lds; unsigned char* ws; unsigned* ctl;
    int tid, lane, wave, G, bid;
};

struct TItem { const float* src; unsigned char* dst; int ldw, k0, n0, drow0; };
template <int NL> __device__ __forceinline__ void titem_load(const TItem& t, float (&tv)[NL], int lane) {
    const float* wp = t.src + (size_t)(t.k0 + (lane >> 5)) * t.ldw + t.n0 + (lane & 31);
#pragma unroll
    for (int i = 0; i < NL; ++i) tv[i] = wp[(size_t)(2 * i) * t.ldw];
}
__device__ __forceinline__ void titem_finish_bf16(const TItem& t, const float (&tv)[32], LAS float* scr, int lane) {
#pragma unroll
    for (int i = 0; i < 32; ++i) scr[(2 * i + (lane >> 5)) * 33 + (lane & 31)] = tv[i];
    LDS_WAIT(); asm volatile("" ::: "memory");
    const int c = lane & 7;
#pragma unroll
    for (int j = 0; j < 4; ++j) { const int n = (lane >> 3) + 8 * j; const LAS float* s = scr + (8 * c) * 33 + n;
        u32x4 o; o.x = cvt_pk_bf16(s[0 * 33], s[1 * 33]); o.y = cvt_pk_bf16(s[2 * 33], s[3 * 33]); o.z = cvt_pk_bf16(s[4 * 33], s[5 * 33]); o.w = cvt_pk_bf16(s[6 * 33], s[7 * 33]);
        *(u32x4*)(t.dst + ((size_t)(t.drow0 + n) * 1024 + t.k0 + 8 * c) * 2) = o; }
    LDS_WAIT(); asm volatile("" ::: "memory");
}
__device__ __forceinline__ void titem_load_fp8(const TItem& t, f32x4 (&tv)[16], int lane) {
    const float* wp = t.src + (size_t)(t.k0 + (lane >> 3)) * t.ldw + t.n0 + 4 * (lane & 7);
#pragma unroll
    for (int i = 0; i < 16; ++i) tv[i] = __builtin_nontemporal_load((const f32x4*)(wp + (size_t)(8 * i) * t.ldw));
}
__device__ __forceinline__ void titem_finish_fp8(const TItem& t, const f32x4 (&tv)[16], LAS float* scr, int lane) {
#pragma unroll
    for (int i = 0; i < 16; ++i) { const int row = 8 * i + (lane >> 3); *(LAS f32x4*)(scr + row * 32 + ((4 * (lane & 7)) ^ ((8 * (row >> 4)) & 31))) = tv[i] * WSCALE; }
    LDS_WAIT(); asm volatile("" ::: "memory");
    const int c = lane & 7;
#pragma unroll
    for (int j = 0; j < 4; ++j) { const int n = (lane >> 3) + 8 * j; const LAS float* s = scr + (16 * c) * 32 + (n ^ ((8 * c) & 31));
        u32x4 o; o.x = pk4_fp8(s[0 * 32], s[1 * 32], s[2 * 32], s[3 * 32]); o.y = pk4_fp8(s[4 * 32], s[5 * 32], s[6 * 32], s[7 * 32]);
        o.z = pk4_fp8(s[8 * 32], s[9 * 32], s[10 * 32], s[11 * 32]); o.w = pk4_fp8(s[12 * 32], s[13 * 32], s[14 * 32], s[15 * 32]);
        __builtin_nontemporal_store(o, (u32x4*)(t.dst + (size_t)(t.drow0 >> 5) * 32768 + (size_t)(t.k0 >> 7) * 4096 + n * 128 + 16 * c)); }
    LDS_WAIT(); asm volatile("" ::: "memory");
}
constexpr int TI_IN = 16 * 96, TI_OUT = 8 * 32, TI_E = 8 * 32, TI_EALL = NE * 3 * TI_E;
constexpr int TSCR = 16384;
__device__ __forceinline__ void transpose_items_bf16(const Frame& F, const Args& a, int gw, int NGW, int it0, int it1) {
    const float* w_in = a.in[10]; const float* w_out = a.in[11];
    LAS float* scr = (LAS float*)(F.lds + F.wave * TSCR);
    for (int it = it0 + gw; it < it1; it += NGW) {
        TItem t; float tv[32];
        if (it < TI_IN) { const int kb = it / 96, nb = it % 96; t = TItem{w_in, F.ws + WS_WIN, NIN, kb * 64, nb * 32, nb * 32}; }
        else { const int r = it - TI_IN, kb = r / 32, nb = r % 32; t = TItem{w_out, F.ws + WS_WOUT, 1024, kb * 64, nb * 32, nb * 32}; }
        titem_load<32>(t, tv, F.lane); titem_finish_bf16(t, tv, scr, F.lane);
    }
}
__device__ __forceinline__ void transpose_items_fp8(const Frame& F, const Args& a, int gw, int NGW, int k0, int k1) {
    const float* w_gate = a.in[18]; const float* w_up = a.in[20]; const float* w_down = a.in[22];
    unsigned char* WGU = F.ws + WS_WGU; unsigned char* WDN = F.ws + WS_WDN;
    LAS float* scr = (LAS float*)(F.lds + F.wave * TSCR);
    auto decode = [&](int r, TItem& t) {
        const int e = r / (3 * TI_E), r2 = r % (3 * TI_E), mat = r2 / TI_E, r3 = r2 % TI_E, kb = r3 / 32, nb = r3 % 32, n0 = nb * 32;
        if (mat == 2) t = TItem{w_down + (size_t)e * 1048576, WDN + (size_t)e * 1048576, 1024, kb * 128, n0, n0};
        else t = TItem{(mat == 0 ? w_gate : w_up) + (size_t)e * 1048576, WGU + (size_t)e * 2097152, 1024, kb * 128, n0, 256 * (n0 >> 7) + mat * 128 + (n0 & 127)};
    };
    for (int k = k0; k < k1; ++k) { const int it = gw + k * NGW; if (it >= TI_EALL) break;
        TItem t; f32x4 tv[16]; decode(it, t); titem_load_fp8(t, tv, F.lane); titem_finish_fp8(t, tv, scr, F.lane); }
}
__device__ __forceinline__ void p0_prologue(const Frame& F, const Args& a) {
    const float* c = a.in[1]; const float* c_ctx = a.in[3]; const float* w_ada = a.in[4]; const float* b_ada = a.in[5];
    const float* w_out = a.in[11]; const float* pool_w = a.in[14]; const float* pool_scale = a.in[15];
    bf16_t* WOUT = (bf16_t*)(F.ws + WS_WOUT);
    float* mod = (float*)(F.ws + WS_MOD);
    if (F.bid < 192) {
        LAS float* s = (LAS float*)F.lds;
        LAS float* red = (LAS float*)(F.lds + 20480);
        const int kq = F.tid >> 5, col = F.tid & 31, j = F.bid * 32 + col;
        float w[64];
#pragma unroll
        for (int kk = 0; kk < 64; ++kk) w[kk] = __builtin_nontemporal_load(w_ada + (size_t)(kq * 64 + kk) * 6144 + j);
        { float t[10];
#pragma unroll
          for (int q = 0; q < 10; ++q) { const int i = F.tid + q * 512, r = i >> 10, k = i & 1023; t[q] = (r < 4) ? c[r * 1024 + k] : c_ctx[k]; }
#pragma unroll
          for (int q = 0; q < 10; ++q) s[F.tid + q * 512] = t[q] * sigmoidf_(t[q]); }
        __syncthreads();
        float acc[5] = {0.f, 0.f, 0.f, 0.f, 0.f};
#pragma unroll
        for (int kk = 0; kk < 64; ++kk) { const int k = kq * 64 + kk;
#pragma unroll
            for (int r = 0; r < 5; ++r) acc[r] += s[r * 1024 + k] * w[kk]; }
#pragma unroll
        for (int r = 0; r < 5; ++r) red[(kq * 5 + r) * 32 + col] = acc[r];
        __syncthreads();
        if (F.tid < 160) { const int r = F.tid >> 5, cc = F.tid & 31; float t = b_ada[F.bid * 32 + cc];
#pragma unroll
            for (int q = 0; q < 16; ++q) t += red[(q * 5 + r) * 32 + cc];
            mod[r * 6144 + F.bid * 32 + cc] = t; }
        asm volatile("s_waitcnt vmcnt(0)" ::: "memory");
        __syncthreads();
        if (F.tid == 0) { __builtin_amdgcn_fence(__ATOMIC_RELEASE, "agent"); asm volatile("s_waitcnt vmcnt(0)" ::: "memory");
            __hip_atomic_fetch_add(F.ctl + CW_MOD, 1u, __ATOMIC_RELAXED, __HIP_MEMORY_SCOPE_AGENT); }
    }
    __syncthreads();
    transpose_items_bf16(F, a, F.bid * 8 + F.wave, F.G * 8, 0, TI_IN);
}
__device__ __forceinline__ void p0_late(const Frame& F, const Args& a) {
    const float* w_out = a.in[11]; const float* pool_w = a.in[14]; const float* pool_scale = a.in[15];
    bf16_t* WOUT = (bf16_t*)(F.ws + WS_WOUT);
    if (F.bid >= 128 && F.bid < 256) {
        const int un = F.bid - 128, gi = un >> 5, nb = un & 31;
        LAS float* pw = (LAS float*)F.lds;
        LAS float* wo = (LAS float*)(F.lds + 128 * 129 * 4);
        { float t[32]; const float sc = pool_scale[gi * 128 + (F.tid & 127)];
#pragma unroll
          for (int q = 0; q < 32; ++q) t[q] = pool_w[(size_t)gi * 16384 + F.tid + q * 512];
#pragma unroll
          for (int q = 0; q < 32; ++q) { const int i = F.tid + q * 512; pw[(i >> 7) * 129 + (i & 127)] = t[q] * sc; }
          float u[8];
#pragma unroll
          for (int q = 0; q < 8; ++q) { const int i = F.tid + q * 512; u[q] = w_out[(size_t)(512 + gi * 128 + (i >> 5)) * 1024 + nb * 32 + (i & 31)]; }
#pragma unroll
          for (int q = 0; q < 8; ++q) wo[F.tid + q * 512] = u[q]; }
        __syncthreads();
        const int n = F.tid & 31, cq = F.tid >> 5;
        float acc[8] = {0.f, 0.f, 0.f, 0.f, 0.f, 0.f, 0.f, 0.f};
        for (int j = 0; j < 128; ++j) { const float b = wo[j * 32 + n];
#pragma unroll
            for (int i = 0; i < 8; ++i) acc[i] += pw[(cq * 8 + i) * 129 + j] * b; }
        u32x4 o; o.x = cvt_pk_bf16(acc[0], acc[1]); o.y = cvt_pk_bf16(acc[2], acc[3]); o.z = cvt_pk_bf16(acc[4], acc[5]); o.w = cvt_pk_bf16(acc[6], acc[7]);
        *(u32x4*)(WOUT + (size_t)(nb * 32 + n) * 1024 + 512 + gi * 128 + cq * 8) = o;
        __syncthreads();
    }
    if (F.bid >= 32 && F.bid < 40) {
        const float* w_router = a.in[16]; bf16_t* WRH = (bf16_t*)(F.ws + WS_WRH); bf16_t* WRL = (bf16_t*)(F.ws + WS_WRL);
        for (int i = (F.bid - 32) * 512 + F.tid; i < 32768; i += 8 * 512) { const int k = i >> 5, e = i & 31; const float w = w_router[i];
            const unsigned short hi = f2bf(w); WRH[e * 1024 + k] = hi; WRL[e * 1024 + k] = f2bf(w - bf2f(hi)); }
    }
    __syncthreads();
    transpose_items_bf16(F, a, F.bid * 8 + F.wave, F.G * 8, TI_IN, TI_IN + TI_OUT);
    __syncthreads();
}

__device__ __forceinline__ void p1_normmod(const Frame& F, const Args& a, unsigned need) {
    const float* x = a.in[0]; const float* ctx = a.in[2]; const float* g = a.in[6];
    const float* mod = (const float*)(F.ws + WS_MOD); bf16_t* HX = (bf16_t*)(F.ws + WS_HX);
    const int gw = F.bid * 8 + F.wave;
    auto rowp = [&](int m) { return (m < M) ? x + (size_t)m * D : ctx + (size_t)(m - M) * D; };
    const int NGW = F.G * 8;
    int m0 = gw * 8;
    f32x4 v[4];
    { const float* xr = rowp(m0);
#pragma unroll
      for (int j = 0; j < 4; ++j) v[j] = __builtin_nontemporal_load((const f32x4*)(xr + F.lane * 4 + 256 * j)); }
    if (F.tid == 0) { unsigned sp = 0;
        while (__hip_atomic_load(F.ctl + CW_MOD, __ATOMIC_RELAXED, __HIP_MEMORY_SCOPE_AGENT) < need) { __builtin_amdgcn_s_sleep(2); if (++sp > (1u << 22)) break; }
        __builtin_amdgcn_fence(__ATOMIC_ACQUIRE, "agent"); asm volatile("s_waitcnt vmcnt(0)" ::: "memory"); }
    __syncthreads();
    f32x4 ga[4], hb[4];
    auto ld_par = [&](int mr) { const float* sh = mod + mr * 6144, *sc = sh + 1024;
#pragma unroll
        for (int j = 0; j < 4; ++j) { const int col = F.lane * 4 + 256 * j; ga[j] = *(const f32x4*)(g + col) * (1.0f + *(const f32x4*)(sc + col)); hb[j] = *(const f32x4*)(sh + col); } };
    auto do_row = [&](int m) {
        float s = 0.f;
#pragma unroll
        for (int j = 0; j < 4; ++j) s += (v[j].x * v[j].x + v[j].y * v[j].y) + (v[j].z * v[j].z + v[j].w * v[j].w);
        const float rstd = rsqrtf(wave_sum(s) * (1.f / D) + EPS);
#pragma unroll
        for (int j = 0; j < 4; ++j) { const int col = F.lane * 4 + 256 * j;
            const f32x4 o = v[j] * rstd * ga[j] + hb[j];
            u32x2 w; w.x = cvt_pk_bf16(o.x, o.y); w.y = cvt_pk_bf16(o.z, o.w);
            *(u32x2*)(HX + (size_t)m * D + col) = w; } };
    const bool hasctx = gw < MC;
#pragma unroll 1
    for (; m0 < M; m0 += NGW * 8) {
        const bool lastg = m0 + NGW * 8 >= M;
        ld_par(m0 >> 12);
#pragma unroll 1
        for (int k = 0; k < 8; ++k) {
            const int m = m0 + k, mn = (k < 7) ? m + 1 : (lastg ? (hasctx ? M + gw : m) : m0 + NGW * 8);
            f32x4 vn[4];
            { const float* xr = rowp(mn);
#pragma unroll
              for (int j = 0; j < 4; ++j) vn[j] = __builtin_nontemporal_load((const f32x4*)(xr + F.lane * 4 + 256 * j)); }
            __builtin_amdgcn_sched_barrier(0);
            do_row(m);
            __builtin_amdgcn_sched_barrier(0);
#pragma unroll
            for (int j = 0; j < 4; ++j) v[j] = vn[j];
        }
    }
    for (int c = gw; c < MC; c += NGW) {
        if (c != gw) { const float* xr = rowp(M + c);
#pragma unroll
            for (int j = 0; j < 4; ++j) v[j] = __builtin_nontemporal_load((const f32x4*)(xr + F.lane * 4 + 256 * j)); }
        ld_par(4); do_row(M + c); }
}

constexpr int G_LF = 0, G_QR = 17408, G_V = 34816, G_Q2 = 52224, G_K2 = 69632, G_ATT = 87040, G_ST = 96256, G_RED = LDS_TAB;
static_assert(G_ST + 128 * 272 <= RING_BYTES, "GLA LDS map");
typedef short s16x4 __attribute__((ext_vector_type(4)));
__device__ __forceinline__ f32x16 mfma32(bf16x8 a, bf16x8 b, f32x16 c) { return __builtin_amdgcn_mfma_f32_32x32x16_bf16(a, b, c, 0, 0, 0); }
__device__ __forceinline__ constexpr int crow0(int reg) { return (reg & 3) + 8 * (reg >> 2); }
__device__ __forceinline__ int opq(int x) { asm volatile("" : "+v"(x)); return x; }
__device__ __forceinline__ unsigned opqu(unsigned x) { asm volatile("" : "+v"(x)); return x; }
__device__ __forceinline__ bf16x8 tr_frag(const LAS unsigned char* img, int trb, int ks, int c) {
    const LAS s16x4* p = (const LAS s16x4*)(img + trb + ks * 16 * 272 + c * 64);
    const s16x4 lo = __builtin_amdgcn_ds_read_tr16_b64_v4i16((LAS s16x4*)p), hi = __builtin_amdgcn_ds_read_tr16_b64_v4i16((LAS s16x4*)(p + 4 * 272 / 8));
    return __builtin_shufflevector(lo, hi, 0, 1, 2, 3, 4, 5, 6, 7);
}
template <int MODE> __device__ __forceinline__ bf16x8 cfrag(int d) {
    u32x4 w;
#pragma unroll
    for (int i = 0; i < 4; ++i) {
        const bool lo = MODE == 0 ? (2 * i <= d) : MODE == 1 ? (2 * i >= d) : MODE == 2 ? (2 * i == d) : true;
        const bool hi = MODE == 0 ? (2 * i + 1 <= d) : MODE == 1 ? (2 * i + 1 >= d) : MODE == 2 ? (2 * i + 1 == d) : true;
        w[i] = (lo ? 0x3F80u : 0u) | (hi ? 0x3F800000u : 0u);
    }
    return __builtin_bit_cast(bf16x8, w);
}
struct RawRegs { u32x4 lf[2], v[2], q[2]; };
template <int DIR, bool WITH_Q>
__device__ __forceinline__ void gla_load_raw(const Frame& F, const bf16_t* P, int row0, int head, RawRegs& R) {
    const bf16_t* rp = P + (size_t)(row0 + (F.tid >> 3)) * NIN + head * 128 + (F.tid & 7) * 16;
    R.lf[0] = *(const u32x4*)(rp + 512 + DIR * 512); R.lf[1] = *(const u32x4*)(rp + 512 + DIR * 512 + 8);
    R.v[0] = *(const u32x4*)(rp + 1536); R.v[1] = *(const u32x4*)(rp + 1536 + 8);
    if (WITH_Q) { R.q[0] = *(const u32x4*)rp; R.q[1] = *(const u32x4*)(rp + 8); }
}
template <bool WITH_Q>
__device__ __forceinline__ void gla_store_raw(const Frame& F, const RawRegs& R) {
    const int o = (F.tid >> 3) * 272 + (F.tid & 7) * 32;
    *(LAS u32x4*)(F.lds + G_LF + o) = R.lf[0]; *(LAS u32x4*)(F.lds + G_LF + o + 16) = R.lf[1];
    *(LAS u32x4*)(F.lds + G_V + o) = R.v[0]; *(LAS u32x4*)(F.lds + G_V + o + 16) = R.v[1];
    if (WITH_Q) { *(LAS u32x4*)(F.lds + G_QR + o) = R.q[0]; *(LAS u32x4*)(F.lds + G_QR + o + 16) = R.q[1]; }
}
template <int DIR, bool WITH_Q>
__device__ __forceinline__ void gla_stage1(const Frame& F, int trb, float (&eh)[16], float* tsum) {
    const int cb = F.wave >> 1, tb = F.wave & 1, l31 = F.lane & 31, lh = F.lane >> 5;
    f32x16 b, T;
#pragma unroll
    for (int r = 0; r < 16; ++r) { b[r] = 0.f; T[r] = 0.f; }
    const u32x4 ones4 = {0x3F803F80u, 0x3F803F80u, 0x3F803F80u, 0x3F803F80u};
#pragma unroll
    for (int ks = 0; ks < 4; ++ks) {
        const int dd = 32 * tb + l31 - 16 * ks - 8 * lh;
        const bf16x8 alf = tr_frag(F.lds + G_LF, trb, ks, cb);
        T = mfma32(alf, __builtin_bit_cast(bf16x8, ones4), T);
        if (DIR ? (tb == 0 || ks >= 2) : (tb == 1 || ks < 2)) b = mfma32(alf, cfrag<DIR>(dd), b);
    }
    const int wb = opq((32 * tb + l31) * 272 + (32 * cb + 4 * lh) * 2);
    typedef float f32x2 __attribute__((ext_vector_type(2)));
    u32x2 lfw[4], qw[4];
#pragma unroll
    for (int g = 0; g < 4; ++g) { lfw[g] = *(const LAS u32x2*)(F.lds + G_LF + wb + g * 16); if (WITH_Q) qw[g] = *(const LAS u32x2*)(F.lds + G_QR + wb + g * 16); }
#pragma unroll
    for (int g = 0; g < 4; ++g) {
        f32x2 k2[2], q2[2];
#pragma unroll
        for (int h = 0; h < 2; ++h) {
            const int r = 4 * g + 2 * h;
            const unsigned lw = h ? lfw[g].y : lfw[g].x;
            const f32x2 lf = {bflo(lw), bfhi(lw)}, Tv = {T[r], T[r + 1]}, bv = {b[r], b[r + 1]};
            const f32x2 mm = Tv * 0.5f, d = mm - bv;
            eh[r] = __builtin_amdgcn_exp2f(mm.x); eh[r + 1] = __builtin_amdgcn_exp2f(mm.y);
            if (tsum) { tsum[r] += Tv.x; tsum[r + 1] += Tv.y; }
            f32x2 ef, ek; ef.x = __builtin_amdgcn_exp2f(lf.x); ef.y = __builtin_amdgcn_exp2f(lf.y); ek.x = __builtin_amdgcn_exp2f(d.x); ek.y = __builtin_amdgcn_exp2f(d.y);
            k2[h] = (1.0f - ef) * ek;
            q2[h] = (f32x2){0.f, 0.f};
            if (WITH_Q) { const unsigned qq = h ? qw[g].y : qw[g].x; const f32x2 q = {bflo(qq), bfhi(qq)}, nd = bv - mm;
                f32x2 eq; eq.x = __builtin_amdgcn_exp2f(nd.x); eq.y = __builtin_amdgcn_exp2f(nd.y); q2[h] = q * eq; }
        }
        u32x2 w; w.x = cvt_pk_bf16(k2[0].x, k2[0].y); w.y = cvt_pk_bf16(k2[1].x, k2[1].y);
        *(LAS u32x2*)(F.lds + G_K2 + wb + g * 16) = w;
        if (WITH_Q) { w.x = cvt_pk_bf16(q2[0].x, q2[0].y); w.y = cvt_pk_bf16(q2[1].x, q2[1].y); *(LAS u32x2*)(F.lds + G_Q2 + wb + g * 16) = w; }
    }
}
__device__ __forceinline__ void gla_state_mma(const Frame& F, int trb, f32x16& s0, f32x16& s1) {
    const int kb = F.wave >> 1, vb = (F.wave & 1) * 2;
#pragma unroll
    for (int ks = 0; ks < 4; ++ks) {
        const bf16x8 a = tr_frag(F.lds + G_K2, trb, ks, kb);
        const bf16x8 b0 = tr_frag(F.lds + G_V, trb, ks, vb), b1 = tr_frag(F.lds + G_V, trb, ks, vb + 1);
        s0 = mfma32(a, b0, s0); s1 = mfma32(a, b1, s1);
    }
}

template <int DIR>
__device__ __forceinline__ void gla_passA_unit(const Frame& F, const bf16_t* P, int b, int h, int blk, bf16_t* dS, float* DD) {
    const int xb = DIR ? (16 - blk) : (blk - 1);
    const int rowb = (blk == 0) ? (M + b * CTXL) : (b * SEQ + xb * 256);
    const int l31 = F.lane & 31, lh = F.lane >> 5;
    const int trb = (8 * lh + ((F.lane & 15) >> 2)) * 272 + (16 * ((F.lane >> 4) & 1) + 4 * (F.lane & 3)) * 2;
    f32x16 s0, s1;
#pragma unroll
    for (int r = 0; r < 16; ++r) { s0[r] = 0.f; s1[r] = 0.f; }
    float tsum[16], eh[16];
#pragma unroll
    for (int i = 0; i < 16; ++i) tsum[i] = 0.f;
    RawRegs R;
    gla_load_raw<DIR, false>(F, P, rowb + (DIR ? 3 : 0) * 64, h, R);
#pragma unroll 1
    for (int ci = 0; ci < 4; ++ci) {
        LSYNC();
        gla_store_raw<false>(F, R);
        if (ci < 3) gla_load_raw<DIR, false>(F, P, rowb + (DIR ? (2 - ci) : (ci + 1)) * 64, h, R);
        LSYNC();
        gla_stage1<DIR, false>(F, trb, eh, tsum);
        LSYNC();
#pragma unroll
        for (int r = 0; r < 16; ++r) { s0[r] *= eh[r]; s1[r] *= eh[r]; }
        gla_state_mma(F, trb, s0, s1);
#pragma unroll
        for (int r = 0; r < 16; ++r) { s0[r] *= eh[r]; s1[r] *= eh[r]; }
    }
    const int kb = F.wave >> 1, vb = (F.wave & 1) * 2;
    const unsigned sb = opqu((unsigned)((32 * kb + 4 * lh) * 128 + 32 * vb + l31));
#pragma unroll
    for (int r = 0; r < 16; ++r) { dS[sb + crow0(r) * 128] = f2bf(s0[r]); dS[sb + 32 + crow0(r) * 128] = f2bf(s1[r]); }
    if ((F.wave & 1) == 0 && l31 == 0) {
#pragma unroll
        for (int r = 0; r < 16; ++r) DD[32 * kb + 4 * lh + crow0(r)] = __builtin_amdgcn_exp2f(tsum[r]);
    }
}

template <int W, class Get, class Emit> __device__ __forceinline__ void win_mean64(const Get& get, const Emit& emit) {
    float s = 0.f;
#pragma unroll
    for (int q = 0; q < W - W / 2; ++q) s += get(q);
#pragma unroll
    for (int r = 0; r < 64; ++r) {
        const int lo = (r - W / 2) < 0 ? 0 : (r - W / 2), hi = (r - W / 2 + W) > 64 ? 64 : (r - W / 2 + W);
        emit(r, s * (1.0f / (float)(hi - lo)));
        if (r + 1 < 64) { if (r + 1 - W / 2 + W <= 64) s += get(r - W / 2 + W); if (r + 1 - W / 2 > 0) s -= get(r - W / 2); }
    }
}
template <int W>
__device__ __forceinline__ void pool_unit(const Frame& F, const bf16_t* __restrict__ U, bf16_t* __restrict__ A2, int b, int slab) {
    LAS float* vm = (LAS float*)F.lds;
    const int ch = F.tid & 7, cc = F.tid >> 3;
    const bf16_t* Us = U + (size_t)(b * 64 + slab) * 4096 * 8;
    {
        unsigned short v[64];
        const unsigned pb = opqu((unsigned)(cc * 8 + ch));
#pragma unroll
        for (int r = 0; r < 64; ++r) v[r] = Us[pb + (unsigned)(r * 64 * 8)];
        const int vb = opq((cc * 8 + ch) * 4);
        win_mean64<W>([&](int q) { return bf2f(v[q]); }, [&](int r, float mean) { *(LAS float*)(F.lds + vb + r * 2080) = mean; });
    }
    __syncthreads();
    {
        const int rr = F.tid >> 3;
        unsigned short uu[64];
        const unsigned pb = opqu((unsigned)(rr * 64 * 8 + ch));
#pragma unroll
        for (int c = 0; c < 64; ++c) uu[c] = Us[pb + (unsigned)(c * 8)];
        const int vb = opq((rr * 520 + ch) * 4);
        const unsigned ab = opqu((unsigned)((b * SEQ + rr * 64) * D + 512 + slab * 8 + ch));
        win_mean64<W>([&](int q) { return *(const LAS float*)(F.lds + vb + q * 32); },
                      [&](int c, float mean) { A2[ab + (unsigned)(c * D)] = f2bf(mean - bf2f(uu[c])); });
    }
    __syncthreads();
}

__device__ __forceinline__ void p4_scan(const Frame& F) {
    bf16_t* ST = (bf16_t*)(F.ws + WS_ST); const float* DDp = (const float*)(F.ws + WS_DD);
    const int gt = F.bid * 512 + F.tid, NT = F.G * 512;
    for (int i = gt; i < 32 * 4096; i += NT) {
        const int seq = i >> 12, e4 = i & 4095, k = e4 >> 5;
        float S[4];
#pragma unroll
        for (int j = 0; j < 4; ++j) S[j] = 0.f;
        u32x2 d[NBLK]; float dec[NBLK];
#pragma unroll
        for (int blk = 0; blk < NBLK; ++blk) { d[blk] = *(const u32x2*)(ST + ((size_t)(seq * NBLK + blk) * 16384) + e4 * 4); dec[blk] = DDp[(seq * NBLK + blk) * 128 + k]; }
#pragma unroll
        for (int blk = 0; blk < NBLK; ++blk) {
            u32x2 o; o.x = cvt_pk_bf16(S[0], S[1]); o.y = cvt_pk_bf16(S[2], S[3]);
            *(u32x2*)(ST + ((size_t)(seq * NBLK + blk) * 16384) + e4 * 4) = o;
            S[0] = S[0] * dec[blk] + bflo(d[blk].x); S[1] = S[1] * dec[blk] + bfhi(d[blk].x); S[2] = S[2] * dec[blk] + bflo(d[blk].y); S[3] = S[3] * dec[blk] + bfhi(d[blk].y);
        }
    }
}

__device__ __forceinline__ float row16_sum(float x) {
    int v;
    v = __builtin_amdgcn_mov_dpp(__float_as_int(x), 0x128, 0xf, 0xf, false); x += __int_as_float(v);
    v = __builtin_amdgcn_mov_dpp(__float_as_int(x), 0x124, 0xf, 0xf, false); x += __int_as_float(v);
    v = __builtin_amdgcn_mov_dpp(__float_as_int(x), 0x122, 0xf, 0xf, false); x += __int_as_float(v);
    v = __builtin_amdgcn_mov_dpp(__float_as_int(x), 0x121, 0xf, 0xf, false); x += __int_as_float(v);
    return x;
}
template <int DIR>
__device__ __forceinline__ void gla_passC_dir(const Frame& F, const bf16_t* P, int b, int h, int xb, const bf16_t* ST, bf16_t* OF, bf16_t* A2, const float* gain) {
    const int blk = DIR ? (16 - xb) : (xb + 1);
    const int seq = b * 8 + h * 2 + DIR;
    const bf16_t* S0 = ST + (size_t)(seq * NBLK + blk) * 16384;
    const int kb = F.wave >> 1, vb = (F.wave & 1) * 2, l31 = F.lane & 31, lh = F.lane >> 5;
    const int trb = (8 * lh + ((F.lane & 15) >> 2)) * 272 + (16 * ((F.lane >> 4) & 1) + 4 * (F.lane & 3)) * 2;
    f32x16 s0, s1;
    const unsigned sb = opqu((unsigned)((32 * kb + 4 * lh) * 128 + 32 * vb + l31));
#pragma unroll
    for (int r = 0; r < 16; ++r) { s0[r] = bf2f(S0[sb + crow0(r) * 128]); s1[r] = bf2f(S0[sb + 32 + crow0(r) * 128]); }
    const int rowb = b * SEQ + xb * 256;
    const int omt = F.wave >> 2, ont = F.wave & 3;
    LAS float* red = (LAS float*)(F.lds + G_RED);
    RawRegs R;
    gla_load_raw<DIR, true>(F, P, rowb + (DIR ? 3 : 0) * 64, h, R);
    LSYNC();
    gla_store_raw<true>(F, R);
#pragma unroll 1
    for (int ci = 0; ci < 4; ++ci) {
        const int c = DIR ? (3 - ci) : ci;
        float eh[16];
        if (ci < 3) gla_load_raw<DIR, true>(F, P, rowb + (DIR ? (2 - ci) : (ci + 1)) * 64, h, R);
        f32x16 o;
        const unsigned trow = (unsigned)(rowb + c * 64 + 32 * omt + l31);
        const unsigned ob = opqu(trow * 512u + (unsigned)(h * 128 + 32 * ont + 4 * lh));
        u32x2 gg[4];
        if (DIR) {
            const unsigned pb = opqu(trow * (unsigned)NIN + (unsigned)(2048 + h * 128 + 32 * ont + 4 * lh));
#pragma unroll
            for (int g = 0; g < 4; ++g) { const u32x2 t4 = *(const u32x2*)(OF + ob + g * 8); o[4 * g] = bflo(t4.x); o[4 * g + 1] = bfhi(t4.x); o[4 * g + 2] = bflo(t4.y); o[4 * g + 3] = bfhi(t4.y); gg[g] = *(const u32x2*)(P + pb + g * 8); }
        } else {
#pragma unroll
            for (int r = 0; r < 16; ++r) o[r] = 0.f;
        }
        LSYNC();
        gla_stage1<DIR, true>(F, trb, eh, nullptr);
        LSYNC();
#pragma unroll
        for (int r = 0; r < 16; ++r) { s0[r] *= eh[r]; s1[r] *= eh[r]; }
        {
            const int stb = opq(G_ST + (32 * vb + l31) * 272 + (32 * kb + 4 * lh) * 2);
#pragma unroll
            for (int g = 0; g < 4; ++g) {
                u32x2 w; w.x = cvt_pk_bf16(s0[4 * g], s0[4 * g + 1]); w.y = cvt_pk_bf16(s0[4 * g + 2], s0[4 * g + 3]);
                *(LAS u32x2*)(F.lds + stb + g * 16) = w;
                w.x = cvt_pk_bf16(s1[4 * g], s1[4 * g + 1]); w.y = cvt_pk_bf16(s1[4 * g + 2], s1[4 * g + 3]);
                *(LAS u32x2*)(F.lds + stb + 32 * 272 + g * 16) = w;
            }
        }
        if (F.wave < 4) {
            const int asb = F.wave >> 1, atb = F.wave & 1;
            f32x16 at, at2;
#pragma unroll
            for (int r = 0; r < 16; ++r) { at[r] = 0.f; at2[r] = 0.f; }
            const int ka = opq(G_K2 + (32 * asb + l31) * 272 + 16 * lh), qa = opq(G_Q2 + (32 * atb + l31) * 272 + 16 * lh);
#pragma unroll
            for (int ks = 0; ks < 8; ks += 2) {
                const bf16x8 a = *(const LAS bf16x8*)(F.lds + ka + ks * 32), a2 = *(const LAS bf16x8*)(F.lds + ka + ks * 32 + 32);
                const bf16x8 bb = *(const LAS bf16x8*)(F.lds + qa + ks * 32), bb2 = *(const LAS bf16x8*)(F.lds + qa + ks * 32 + 32);
                at = mfma32(a, bb, at); at2 = mfma32(a2, bb2, at2);
            }
#pragma unroll
            for (int r = 0; r < 16; ++r) at[r] += at2[r];
            const int dts = opq((32 * atb + l31) - (32 * asb + 4 * lh));
            float am[16];
#pragma unroll
            for (int r = 0; r < 16; ++r) { const bool keep = DIR ? (crow0(r) >= dts) : (crow0(r) <= dts); am[r] = keep ? at[r] : 0.f; }
            const int ab = opq(G_ATT + (32 * atb + l31) * 144 + (32 * asb + 4 * lh) * 2);
#pragma unroll
            for (int g = 0; g < 4; ++g) { u32x2 w; w.x = cvt_pk_bf16(am[4 * g], am[4 * g + 1]); w.y = cvt_pk_bf16(am[4 * g + 2], am[4 * g + 3]); *(LAS u32x2*)(F.lds + ab + g * 16) = w; }
        }
        LSYNC();
        {
            const int qa = opq(G_Q2 + (32 * omt + l31) * 272 + 16 * lh), sa = opq(G_ST + (32 * ont + l31) * 272 + 16 * lh), aa = opq(G_ATT + (32 * omt + l31) * 144 + 16 * lh);
            f32x16 o2;
#pragma unroll
            for (int r = 0; r < 16; ++r) o2[r] = 0.f;
#pragma unroll
            for (int ks = 0; ks < 8; ++ks) {
                const bf16x8 a = *(const LAS bf16x8*)(F.lds + sa + ks * 32);
                const bf16x8 bb = *(const LAS bf16x8*)(F.lds + qa + ks * 32);
                if (ks & 1) o2 = mfma32(a, bb, o2); else o = mfma32(a, bb, o);
            }
#pragma unroll
            for (int ks = 0; ks < 4; ++ks) {
                const bf16x8 a = tr_frag(F.lds + G_V, trb, ks, ont);
                const bf16x8 bb = *(const LAS bf16x8*)(F.lds + aa + ks * 32);
                if (ks & 1) o2 = mfma32(a, bb, o2); else o = mfma32(a, bb, o);
            }
#pragma unroll
            for (int r = 0; r < 16; ++r) o[r] += o2[r];
        }
        gla_state_mma(F, trb, s0, s1);
#pragma unroll
        for (int r = 0; r < 16; ++r) { s0[r] *= eh[r]; s1[r] *= eh[r]; }
        if (DIR == 0) {
#pragma unroll
            for (int g = 0; g < 4; ++g) { u32x2 w; w.x = cvt_pk_bf16(o[4 * g], o[4 * g + 1]); w.y = cvt_pk_bf16(o[4 * g + 2], o[4 * g + 3]); *(u32x2*)(OF + ob + g * 8) = w; }
        } else {
            float sq = 0.f;
#pragma unroll
            for (int r = 0; r < 16; ++r) sq += o[r] * o[r];
            sq += __shfl_xor(sq, 32);
            if (lh == 0) red[(32 * omt + l31) * 4 + ont] = sq;
            LSYNC();
            const f32x4 q4 = *(const LAS f32x4*)(red + (32 * omt + l31) * 4);
            const float rstd = rsqrtf(((q4.x + q4.y) + (q4.z + q4.w)) * (1.0f / 128.0f) + EPS);
            const unsigned a2b = opqu(trow * (unsigned)D + (unsigned)(h * 128 + 32 * ont + 4 * lh));
#pragma unroll
            for (int g = 0; g < 4; ++g) {
                u32x2 w; w.x = cvt_pk_bf16(o[4 * g] * rstd * bflo(gg[g].x), o[4 * g + 1] * rstd * bfhi(gg[g].x));
                w.y = cvt_pk_bf16(o[4 * g + 2] * rstd * bflo(gg[g].y), o[4 * g + 3] * rstd * bfhi(gg[g].y));
                *(u32x2*)(A2 + a2b + g * 8) = w; }
        }
        if (ci < 3) { LSYNC();
            gla_store_raw<true>(F, R); }
    }
}
__device__ __forceinline__ void gla_passC_unit(const Frame& F, const Args& a, int b, int h, int xb) {
    const bf16_t* P = (const bf16_t*)(F.ws + WS_P); const bf16_t* ST = (const bf16_t*)(F.ws + WS_ST); bf16_t* A2 = (bf16_t*)(F.ws + WS_A2);
    bf16_t* OF = (bf16_t*)(F.ws + WS_YX);
    gla_passC_dir<0>(F, P, b, h, xb, ST, OF, A2, a.in[13]);
    gla_passC_dir<1>(F, P, b, h, xb, ST, OF, A2, a.in[13]);
}

__device__ __forceinline__ void p7_rows(const Frame& F, const Args& a, const XcdBarrier& bar, bool pending) {
    const float* x = a.in[0]; const float* gpm = a.in[7]; const float* gpf = a.in[8]; const float* b_router = a.in[17];
    const float* mod = (const float*)(F.ws + WS_MOD); const bf16_t* YX = (const bf16_t*)(F.ws + WS_YXB);
    const bf16_t* WRH = (const bf16_t*)(F.ws + WS_WRH); const bf16_t* WRL = (const bf16_t*)(F.ws + WS_WRL);
    bf16_t* X1B = (bf16_t*)(F.ws + WS_X1B); unsigned char* HX2F = F.ws + WS_HX2F; int* PE = (int*)(F.ws + WS_PE); int* PSLOT = (int*)(F.ws + WS_PSLOT); float* PW = (float*)(F.ws + WS_PW);
    int* RTOK = (int*)(F.ws + WS_RTOK); unsigned* cnt = F.ctl + CW_CNT;
    LAS float* part = (LAS float*)F.lds;
    LAS float* logit = (LAS float*)(F.lds + 65536);
    LAS int* lcnt = (LAS int*)(F.lds + LDS_TAB);
    const int l31 = F.lane & 31, lh = F.lane >> 5;
    for (int g = F.bid; g < M / 64; g += F.G) {
        const int base = (F.G == 256) ? ((8 * (g & 7) + (g >> 5)) * 256 + ((g >> 3) & 3) * 64) : g * 64;
        if (F.tid < 64) lcnt[F.tid] = 0;
        f32x4 cgt[4], e2[4], f2[4];
        { const float* mrow = mod + (base >> 12) * 6144;
#pragma unroll
          for (int j = 0; j < 4; ++j) { const int col = F.lane * 4 + 256 * j; cgt[j] = *(const f32x4*)(mrow + 2048 + col) * *(const f32x4*)(gpm + col);
              e2[j] = *(const f32x4*)(gpf + col) * (1.0f + *(const f32x4*)(mrow + 4096 + col)); f2[j] = *(const f32x4*)(mrow + 3072 + col); } }
        u32x2 yw[4]; f32x4 xx[4];
        { const int m0 = base + F.wave * 8;
#pragma unroll
          for (int j = 0; j < 4; ++j) { const int col = F.lane * 4 + 256 * j; xx[j] = __builtin_nontemporal_load((const f32x4*)(x + (size_t)m0 * D + col)); }
          if (pending && g == F.bid) xcd_wait(bar);
#pragma unroll
          for (int j = 0; j < 4; ++j) { const int col = F.lane * 4 + 256 * j; yw[j] = __builtin_nontemporal_load((const u32x2*)(YX + (size_t)m0 * D + col)); } }
#pragma unroll 1
        for (int r = 0; r < 8; ++r) {
            const int m = base + F.wave * 8 + r, mn = base + F.wave * 8 + (r < 7 ? r + 1 : r);
            u32x2 ywn[4]; f32x4 xn[4];
#pragma unroll
            for (int j = 0; j < 4; ++j) { const int col = F.lane * 4 + 256 * j; ywn[j] = __builtin_nontemporal_load((const u32x2*)(YX + (size_t)mn * D + col)); xn[j] = __builtin_nontemporal_load((const f32x4*)(x + (size_t)mn * D + col)); }
            __builtin_amdgcn_sched_barrier(0);
            f32x4 y[4]; float s = 0.f;
#pragma unroll
            for (int j = 0; j < 4; ++j) { y[j] = (f32x4){bflo(yw[j].x), bfhi(yw[j].x), bflo(yw[j].y), bfhi(yw[j].y)};
                s += (y[j].x * y[j].x + y[j].y * y[j].y) + (y[j].z * y[j].z + y[j].w * y[j].w); }
            const float rstd = rsqrtf(wave_sum(s) * (1.f / D) + EPS);
            float s2 = 0.f;
#pragma unroll
            for (int j = 0; j < 4; ++j) { const int col = F.lane * 4 + 256 * j;
                xx[j] = xx[j] + cgt[j] * (y[j] * rstd);
                { u32x2 w1; w1.x = cvt_pk_bf16(xx[j].x, xx[j].y); w1.y = cvt_pk_bf16(xx[j].z, xx[j].w); __builtin_nontemporal_store(w1, (u32x2*)(X1B + (size_t)m * D + col)); }
                s2 += (xx[j].x * xx[j].x + xx[j].y * xx[j].y) + (xx[j].z * xx[j].z + xx[j].w * xx[j].w); }
            const float rstd2 = rsqrtf(wave_sum(s2) * (1.f / D) + EPS);
#pragma unroll
            for (int j = 0; j < 4; ++j) { const int col = F.lane * 4 + 256 * j;
                const f32x4 hh = xx[j] * rstd2 * e2[j] + f2[j];
                u32x2 w; w.x = cvt_pk_bf16(hh.x, hh.y); w.y = cvt_pk_bf16(hh.z, hh.w);
                const int lr = F.wave * 8 + r;
                *(LAS u32x2*)(F.lds + lr * 2048 + ((((F.lane >> 1) + 32 * j) ^ (lr & 15)) * 16) + (F.lane & 1) * 8) = w;
                *(unsigned*)(HX2F + (size_t)m * D + col) = pk4_fp8(hh.x, hh.y, hh.z, hh.w); }
            __builtin_amdgcn_sched_barrier(0);
#pragma unroll
            for (int j = 0; j < 4; ++j) { yw[j] = ywn[j]; xx[j] = xn[j]; }
        }
        bf16x8 bh[8], bl[8];
#pragma unroll
        for (int ks = 0; ks < 8; ++ks) { const int k0 = 128 * F.wave + 16 * ks + 8 * lh; bh[ks] = *(const bf16x8*)(WRH + l31 * 1024 + k0); bl[ks] = *(const bf16x8*)(WRL + l31 * 1024 + k0); }
        __syncthreads();
        {
            f32x16 acc0, acc1;
#pragma unroll
            for (int r = 0; r < 16; ++r) { acc0[r] = 0.f; acc1[r] = 0.f; }
#pragma unroll
            for (int ks = 0; ks < 8; ++ks) {
                const int ch = ((16 * F.wave + 2 * ks + lh) ^ (l31 & 15)) * 16;
                const bf16x8 a0 = *(const LAS bf16x8*)(F.lds + l31 * 2048 + ch), a1 = *(const LAS bf16x8*)(F.lds + (32 + l31) * 2048 + ch);
                acc0 = mfma32(a0, bh[ks], acc0); acc0 = mfma32(a0, bl[ks], acc0); acc1 = mfma32(a1, bh[ks], acc1); acc1 = mfma32(a1, bl[ks], acc1);
            }
            const int pb = opq((F.wave * 64 + 4 * lh) * 32 + l31);
            __syncthreads();
#pragma unroll
            for (int r = 0; r < 16; ++r) { part[pb + crow0(r) * 32] = acc0[r]; part[pb + (32 + crow0(r)) * 32] = acc1[r]; }
        }
        __syncthreads();
        { f32x4 t = *(const f32x4*)(b_router + ((F.tid * 4) & 31));
#pragma unroll
          for (int w = 0; w < 8; ++w) t += *(const LAS f32x4*)(part + w * 2048 + F.tid * 4);
          *(LAS f32x4*)(logit + F.tid * 4) = t; }
        __syncthreads();
#pragma unroll 1
        for (int r = 0; r < 8; ++r) {
            const int m = base + F.wave * 8 + r;
            float v = (F.lane < 32) ? logit[(F.wave * 8 + r) * 32 + l31] : -3.0e38f; float tv[4]; int ti[4];
#pragma unroll
            for (int k = 0; k < 4; ++k) {
                float mx = v;
#pragma unroll
                for (int o = 1; o < 64; o <<= 1) mx = fmaxf(mx, __shfl_xor(mx, o));
                const unsigned long long bal = __ballot(v == mx);
                int idx = __ffsll((long long)bal) - 1; idx = idx < 0 ? 0 : (idx > 31 ? 31 : idx);
                tv[k] = mx; ti[k] = idx;
                if (F.lane == idx) v = -3.0e38f;
            }
            const float e1 = __expf(tv[1] - tv[0]), e2 = __expf(tv[2] - tv[0]), e3 = __expf(tv[3] - tv[0]);
            const float inv = 1.0f / (1.0f + e1 + e2 + e3);
            if (F.lane < 4) {
                const int e = F.lane == 0 ? ti[0] : F.lane == 1 ? ti[1] : F.lane == 2 ? ti[2] : ti[3];
                const float w = (F.lane == 0 ? 1.0f : F.lane == 1 ? e1 : F.lane == 2 ? e2 : e3) * inv;
                const int lrank = __hip_atomic_fetch_add(lcnt + e, 1, __ATOMIC_RELAXED, __HIP_MEMORY_SCOPE_WORKGROUP);
                PE[m * 4 + F.lane] = e; PSLOT[m * 4 + F.lane] = lrank; PW[m * 4 + F.lane] = w;
            }
        }
        __syncthreads();
        if (F.tid < 32) { const int c = lcnt[F.tid]; lcnt[32 + F.tid] = c ? (int)__hip_atomic_fetch_add(cnt + 64 * F.tid, (unsigned)c, __ATOMIC_RELAXED, __HIP_MEMORY_SCOPE_AGENT) : 0; }
        __syncthreads();
        if (F.tid < 256) { const int m = base + (F.tid >> 2), k = F.tid & 3; const int e = PE[m * 4 + k]; const int slot = lcnt[32 + e] + PSLOT[m * 4 + k];
            PSLOT[m * 4 + k] = slot; RTOK[e * ECAP + slot] = m * 1024; }
        __syncthreads();
    }
}

__device__ __forceinline__ void moe_tables(const Frame& F) {
    LAS int* tab = (LAS int*)(F.lds + LDS_TAB);
    __syncthreads();
    if (F.tid < 64) {
        const int c = (F.lane < 32) ? (int)__hip_atomic_load(F.ctl + CW_CNT + 64 * (F.lane & 31), __ATOMIC_RELAXED, __HIP_MEMORY_SCOPE_AGENT) : 0;
        const int padded = ((c + 255) >> 8) * 256;
        int incl = padded;
#pragma unroll
        for (int o = 1; o < 32; o <<= 1) { const int t = __shfl_up(incl, o); if (F.lane >= o) incl += t; }
        if (F.lane < 32) { tab[F.lane] = c; tab[32 + F.lane] = incl - padded; }
        if (F.lane == 31) tab[64] = incl >> 8;
    }
    __syncthreads();
}

__device__ __forceinline__ void p10_final(const Frame& F, const Args& a, const XcdBarrier& bar, bool pending) {
    const float* gpo = a.in[9]; const float* mod = (const float*)(F.ws + WS_MOD);
    const unsigned char* YB = F.ws + WS_YB; const bf16_t* X1B = (const bf16_t*)(F.ws + WS_X1B); const int* PE = (const int*)(F.ws + WS_PE); const int* PSLOT = (const int*)(F.ws + WS_PSLOT); const float* PW = (const float*)(F.ws + WS_PW);
    const LAS int* tab = (const LAS int*)(F.lds + LDS_TAB);
    const int gw = F.bid * 8 + F.wave;
    struct Rec { int e[4], s[4]; float w[4]; };
    auto ld_rec = [&](int m, Rec& r) {
#pragma unroll
        for (int k = 0; k < 4; ++k) { r.e[k] = PE[m * 4 + k]; r.s[k] = PSLOT[m * 4 + k]; r.w[k] = PW[m * 4 + k]; } };
    auto ld_x = [&](int m, u32x2 (&xw)[4]) {
#pragma unroll
        for (int j = 0; j < 4; ++j) xw[j] = __builtin_nontemporal_load((const u32x2*)(X1B + (size_t)m * D + F.lane * 4 + 256 * j)); };
    auto ld_y = [&](const Rec& r, int (&yv)[16]) {
#pragma unroll
        for (int k = 0; k < 4; ++k) { const unsigned char* yr = YB + (size_t)(tab[32 + r.e[k]] + r.s[k]) * D + F.lane * 4;
#pragma unroll
            for (int j = 0; j < 4; ++j) yv[k * 4 + j] = __builtin_nontemporal_load((const int*)(yr + 256 * j)); } };
    auto ld_row = [&](int m, const Rec& r, int (&yv)[16], u32x2 (&xw)[4]) { ld_y(r, yv); ld_x(m, xw); };
#pragma unroll 1
    for (int g8 = gw; g8 < M / 8; g8 += F.G * 8) {
    const int mbeg = g8 * 8, mend = mbeg + 7;
    int m = mbeg;
    Rec r0, r1; int yv[16]; u32x2 xw[4];
    f32x4 ggt[4];
    { const float* mrow = mod + (mbeg >> 12) * 6144;
#pragma unroll
      for (int j = 0; j < 4; ++j) { const int col = F.lane * 4 + 256 * j; ggt[j] = *(const f32x4*)(gpo + col) * *(const f32x4*)(mrow + 5120 + col); } }
    ld_rec(m, r0);
    ld_rec(m + 1, r1);
    ld_x(m, xw);
    if (pending && g8 == gw) xcd_wait(bar);
    ld_y(r0, yv);
#pragma unroll 1
    for (; m <= mend; ++m) {
        const int m1 = m + 1 <= mend ? m + 1 : m, m2 = m1 + 1 <= mend ? m1 + 1 : m1;
        Rec r2; ld_rec(m2, r2);
        int yn[16]; u32x2 xn[4];
        ld_row(m1, r1, yn, xn);
        __builtin_amdgcn_sched_barrier(0);
        f32x4 y[4];
#pragma unroll
        for (int j = 0; j < 4; ++j) y[j] = (f32x4){0.f, 0.f, 0.f, 0.f};
#pragma unroll
        for (int k = 0; k < 4; ++k) { const float w = r0.w[k];
#pragma unroll
            for (int j = 0; j < 4; ++j) { const int v = yv[k * 4 + j];
                const auto lo = __builtin_amdgcn_cvt_pk_f32_fp8(v, false), hi = __builtin_amdgcn_cvt_pk_f32_fp8(v, true);
                y[j].x += w * lo[0]; y[j].y += w * lo[1]; y[j].z += w * hi[0]; y[j].w += w * hi[1]; } }
        float s = 0.f;
#pragma unroll
        for (int j = 0; j < 4; ++j) s += (y[j].x * y[j].x + y[j].y * y[j].y) + (y[j].z * y[j].z + y[j].w * y[j].w);
        const float rstd = rsqrtf(wave_sum(s) * (1.f / D) + EPS);
#pragma unroll
        for (int j = 0; j < 4; ++j) { const int col = F.lane * 4 + 256 * j;
            float* op = a.out + (size_t)m * D + col; const f32x4 x1 = {bflo(xw[j].x), bfhi(xw[j].x), bflo(xw[j].y), bfhi(xw[j].y)};
            __builtin_nontemporal_store(x1 + ggt[j] * (y[j] * rstd), (f32x4*)op); }
        __builtin_amdgcn_sched_barrier(0);
        r0 = r1; r1 = r2;
#pragma unroll
        for (int i = 0; i < 16; ++i) yv[i] = yn[i];
#pragma unroll
        for (int j = 0; j < 4; ++j) xw[j] = xn[j];
    }
    }
}

constexpr int NPHASE = 11;
__global__ void __launch_bounds__(512, 2) mk_fwd(Args args) {
    extern __shared__ __attribute__((aligned(16))) unsigned char lds_raw[];
    Frame F;
    F.lds = (LAS unsigned char*)lds_raw; F.ws = args.ws; F.ctl = (unsigned*)(args.ws + WS_CTL);
    F.tid = threadIdx.x; F.lane = F.tid & 63; F.wave = __builtin_amdgcn_readfirstlane(F.tid >> 6); F.G = gridDim.x; F.bid = blockIdx.x;
    volatile LAS unsigned* MISC = (volatile LAS unsigned*)(F.lds + LDS_MISC);
    if (F.tid < 32) MISC[F.tid] = 0u;
    __syncthreads();
    XcdBarrier bar = xcd_barrier_post(F.ctl + CW_BAR + args.li * XCD_BAR_WORDS, MISC + 8);
    const int lo = args.ph_lo, hi = args.ph_hi;
#ifndef PHMASK
#define PHMASK 0x7ff
#endif
#define IN(k) (((PHMASK >> (k)) & 1) && lo <= (k) && (k) < hi)
#define SEAM(k) do { if (IN(k) && IN((k) + 1)) xcd_barrier(bar); } while (0)

    if (IN(0)) { p0_prologue(F, args); }
    if (IN(1)) for (int rep = 0; rep <= ((REPMASK >> 1) & 1); ++rep) { if (rep) xcd_barrier(bar); p1_normmod(F, args, 192u); }
    if (IN(1) && IN(2)) xcd_arrive(bar);
    if (IN(2)) for (int rep = 0; rep <= ((REPMASK >> 2) & 1); ++rep) { if (rep) xcd_barrier(bar);
        pg8::StaticOrder S; S.init(F.ws + WS_HX, F.ws + WS_WIN, M, NIN, D, F.G, F.bid);
        EpiInProj E{(bf16_t*)(F.ws + WS_P), args.in[12], (bf16_t*)(F.ws + WS_U), args.in[13]};
        const int nctx = 24;
        const bool tfirst = (F.bid >= nctx) && (((F.bid >> 3) & 1) != 0);
        const int nbefore = tfirst ? 11 : 2;
        if (F.bid >= nctx) { transpose_items_fp8(F, args, (F.bid - nctx) * 8 + F.wave, (F.G - nctx) * 8, 0, nbefore); __syncthreads(); }
        if (IN(1) && rep == 0) xcd_wait(bar);
        {
            pg8::P2Order O; O.S = S; O.ctx = (F.bid < nctx);
            O.cu.pm = 64 + F.bid / 6; O.cu.pn = 2 + F.bid % 6; O.cu.A = (const char*)(F.ws + WS_HX) + (size_t)O.cu.pm * 256 * D * 2; O.cu.B = (const char*)(F.ws + WS_WIN) + (size_t)O.cu.pn * 256 * D * 2;
            pg8::gemm_phase<EpiInProj, pg8::P2Order, false, true, true>(F.lds, D, O, E);
        }
        const bool lastrep = rep == ((REPMASK >> 2) & 1);
        if (F.bid >= nctx) {
            if (IN(3) && lastrep) xcd_arrive(bar);
            transpose_items_fp8(F, args, (F.bid - nctx) * 8 + F.wave, (F.G - nctx) * 8, nbefore, 1 << 20); __syncthreads();
        }
        if (F.bid < nctx) {
            asm volatile("s_waitcnt vmcnt(0)" ::: "memory");
            __syncthreads();
            if (F.tid == 0) { __builtin_amdgcn_fence(__ATOMIC_RELEASE, "agent"); asm volatile("s_waitcnt vmcnt(0)" ::: "memory");
                __hip_atomic_fetch_add(F.ctl + CW_CTX + 64 * (F.bid / 6), 1u, __ATOMIC_RELAXED, __HIP_MEMORY_SCOPE_AGENT); }
            if (IN(3) && lastrep) xcd_arrive(bar);
            const bf16_t* P = (const bf16_t*)(F.ws + WS_P); bf16_t* ST = (bf16_t*)(F.ws + WS_ST); float* DDp = (float*)(F.ws + WS_DD);
            for (int u = F.bid; u < 32; u += nctx) {
                const int b = u >> 3, h = (u >> 1) & 3;
                if (F.tid == 0) { unsigned sp = 0;
                    while (__hip_atomic_load(F.ctl + CW_CTX + 64 * b, __ATOMIC_RELAXED, __HIP_MEMORY_SCOPE_AGENT) < 6u * (unsigned)(rep + 1)) { __builtin_amdgcn_s_sleep(2); if (++sp > (1u << 22)) break; }
                    __builtin_amdgcn_fence(__ATOMIC_ACQUIRE, "agent"); asm volatile("s_waitcnt vmcnt(0)" ::: "memory"); }
                __syncthreads();
                if (u & 1) gla_passA_unit<1>(F, P, b, h, 0, ST + (size_t)(u * NBLK) * 16384, DDp + (u * NBLK) * 128);
                else gla_passA_unit<0>(F, P, b, h, 0, ST + (size_t)(u * NBLK) * 16384, DDp + (u * NBLK) * 128);
                __syncthreads();
            }
        }
    }
    if (IN(2) && IN(3)) xcd_wait(bar);
    if (IN(3)) for (int rep = 0; rep <= ((REPMASK >> 3) & 1); ++rep) { if (rep) xcd_barrier(bar);
        const bf16_t* P = (const bf16_t*)(F.ws + WS_P); bf16_t* A2 = (bf16_t*)(F.ws + WS_A2);
        const bf16_t* Up = (const bf16_t*)(F.ws + WS_U);
        bf16_t* ST = (bf16_t*)(F.ws + WS_ST); float* DDp = (float*)(F.ws + WS_DD);
        for (int uu = F.bid; uu < 32 * 16; uu += F.G) { const int seq = uu >> 4, blk = 1 + (uu & 15), b = seq >> 3, h = (seq >> 1) & 3, dir = seq & 1, u = seq * NBLK + blk;
            if (dir == 0) gla_passA_unit<0>(F, P, b, h, blk, ST + (size_t)u * 16384, DDp + u * 128);
            else gla_passA_unit<1>(F, P, b, h, blk, ST + (size_t)u * 16384, DDp + u * 128); }
    }
    if (IN(3) && IN(4)) xcd_arrive(bar);
    if (IN(3)) {
        bf16_t* A2 = (bf16_t*)(F.ws + WS_A2); const bf16_t* Up = (const bf16_t*)(F.ws + WS_U);
        for (int w = F.bid; w < 256; w += F.G) {
            const int grp = (w & 7) * 4 + ((w >> 3) >> 3), mem = (w >> 3) & 7, b = grp >> 3, slab = (grp & 7) * 8 + mem, gi = slab >> 4;
            if (gi == 0) pool_unit<2>(F, Up, A2, b, slab); else if (gi == 1) pool_unit<4>(F, Up, A2, b, slab); else if (gi == 2) pool_unit<8>(F, Up, A2, b, slab); else pool_unit<16>(F, Up, A2, b, slab); }
    }
    if (IN(3) && IN(4)) xcd_wait(bar);
    if (IN(4)) { p4_scan(F); }
    if (IN(4) && IN(5)) xcd_arrive(bar);
    if (IN(4)) p0_late(F, args);
    if (IN(4) && IN(5)) xcd_wait(bar);
    if (IN(5)) for (int rep = 0; rep <= ((REPMASK >> 5) & 1); ++rep) { if (rep) xcd_barrier(bar); for (int u = F.bid; u < 256; u += F.G) {
            const int x = u & 7, slot = u >> 3;
            gla_passC_unit(F, args, x >> 1, slot >> 3, (x & 1) * 8 + (slot & 7)); } }
    SEAM(5);
    if (IN(6)) for (int rep = 0; rep <= ((REPMASK >> 6) & 1); ++rep) { if (rep) xcd_barrier(bar);
        pg8::StaticOrder S; S.init(F.ws + WS_A2, F.ws + WS_WOUT, M, D, D, F.G, F.bid);
        EpiBf16Out E{(bf16_t*)(F.ws + WS_YXB), D};
        pg8::gemm_phase<EpiBf16Out, pg8::StaticOrder, false, false, true>(F.lds, D, S, E);
    }
    if (IN(6) && IN(7)) xcd_arrive(bar);
    if (IN(7)) { p7_rows(F, args, bar, IN(6) && IN(7)); }
    SEAM(7);
    if (IN(8)) for (int rep = 0; rep <= ((REPMASK >> 8) & 1); ++rep) { if (rep) xcd_barrier(bar);
        moe_tables(F);
        MoeOrder<8, true> S; S.tab = (const LAS int*)(F.lds + LDS_TAB); S.Abase = (const char*)(F.ws + WS_HX2F); S.Wbase = (const char*)(F.ws + WS_WGU); S.rtok = (const int*)(F.ws + WS_RTOK);
        S.cls = 0; S.rank = (F.bid & 7) * (F.G >> 3) + (F.bid >> 3); S.nrank = F.G; S.mtc = F.ctl + CW_MT;
        EpiGateUp E{F.ws + WS_H, args.in[19], args.in[21]};
        pg8::gemm_phase<EpiGateUp, MoeOrder<8, true>, true, true, true, true>(F.lds, 512, S, E);
    }
    if (IN(9)) for (int rep = 0; rep <= ((REPMASK >> 9) & 1); ++rep) { if (rep) xcd_barrier(bar);
        if (!IN(8) || rep) moe_tables(F);
        MoeOrder<4, false> S; S.tab = (const LAS int*)(F.lds + LDS_TAB); S.Abase = (const char*)(F.ws + WS_H); S.Wbase = (const char*)(F.ws + WS_WDN); S.rtok = nullptr;
        S.cls = 0; S.rank = F.G - 1 - ((F.bid & 7) * (F.G >> 3) + (F.bid >> 3)); S.nrank = F.G; S.mtc = F.ctl + CW_MT;
        EpiDown E{F.ws + WS_YB, args.in[23]};
        pg8::gemm_phase<EpiDown, MoeOrder<4, false>, false, true, true, true>(F.lds, 512, S, E);
    }
    if (IN(9) && IN(10)) xcd_arrive(bar);
    if (IN(10)) { if (!IN(9)) moe_tables(F);
        p10_final(F, args, bar, IN(9) && IN(10)); }
#undef IN
#undef SEAM
}

extern "C" void kernel_launch(void* const* d_in, const int* in_sizes, int n_in, void* d_out, int out_size, void* d_ws, size_t ws_size, hipStream_t stream) {
    static int grid = 0;
    if (grid == 0) {
        if (n_in != 24 || out_size != M * D || ws_size < WS_END) { fprintf(stderr, "kernel_launch: unexpected shapes (n_in %d out %d ws %zu)\n", n_in, out_size, ws_size); grid = -1; return; }
        int dev = 0, cus = 0, per_cu = 0;
        if (hipGetDevice(&dev) != hipSuccess || hipDeviceGetAttribute(&cus, hipDeviceAttributeMultiprocessorCount, dev) != hipSuccess) { grid = -1; return; }
        if (hipFuncSetAttribute((const void*)mk_fwd, hipFuncAttributeMaxDynamicSharedMemorySize, LDS_BYTES) != hipSuccess) { fprintf(stderr, "kernel_launch: hipFuncSetAttribute failed\n"); grid = -1; return; }
        if (hipOccupancyMaxActiveBlocksPerMultiprocessor(&per_cu, (const void*)mk_fwd, 512, LDS_BYTES) != hipSuccess || per_cu < 1) { fprintf(stderr, "kernel_launch: occupancy query says %d\n", per_cu); }
        (void)hipGetLastError();
        grid = cus;
        if (grid % 8 != 0 || M % grid != 0 || (M / grid) % 64 != 0) { fprintf(stderr, "kernel_launch: unsupported CU count %d\n", cus); grid = -1; return; }
    }
    if (grid < 0) return;
    if (hipMemsetAsync((char*)d_ws + WS_CTL, 0, CTL_ZERO_BYTES, stream) != hipSuccess) return;
    Args a{};
    for (int i = 0; i < 24; ++i) a.in[i] = (const float*)d_in[i];
    a.out = (float*)d_out; a.ws = (unsigned char*)d_ws; a.pad = 0;
    constexpr int NL = MK_N_LAUNCHES;
    for (int li = 0; li < NL; ++li) {
        a.ph_lo = (NL == 1) ? 0 : li; a.ph_hi = (NL == 1) ? NPHASE : li + 1; a.li = (NL == 1) ? 0 : 0;
        hipLaunchKernelGGL(mk_fwd, dim3(grid), dim3(512), LDS_BYTES, stream, a);
    }
}
```

```cpp
#include <hip/hip_runtime.h>
#include <cstdio>
#include <cstdint>

#define LAS __attribute__((address_space(3)))
typedef unsigned short bf16_t;
typedef short bf16x8 __attribute__((ext_vector_type(8)));
typedef float f32x4 __attribute__((ext_vector_type(4)));
typedef float f32x16 __attribute__((ext_vector_type(16)));
typedef unsigned u32x4 __attribute__((ext_vector_type(4)));
typedef unsigned u32x2 __attribute__((ext_vector_type(2)));

#ifndef MK_N_LAUNCHES
#define MK_N_LAUNCHES 1
#endif
#ifndef REPMASK
#define REPMASK 0x000
#endif

constexpr int D = 1024, NB = 4, SEQ = 4096, M = NB * SEQ, CTXL = 256, MC = NB * CTXL, MTOT = M + MC;
constexpr int NIN = 3072, NE = 32, TOPK = 4, FF = 1024;
constexpr int NHEAD = 4, HD = 128;
constexpr int NBLK = 17;
constexpr int ECAP = 16384;
constexpr int HROWS = 65536 + NE * 256;
constexpr float EPS = 1e-6f;

constexpr size_t MiB = 1u << 20;
constexpr size_t WS_CTL = 0, CTL_ZERO_BYTES = 256 * 1024;
constexpr size_t WS_MOD = 1 * MiB;
constexpr size_t WS_WRH = 1 * MiB + 128 * 1024;
constexpr size_t WS_WRL = 1 * MiB + 192 * 1024;
constexpr size_t WS_PE = 1 * MiB + 256 * 1024;
constexpr size_t WS_PSLOT = WS_PE + 256 * 1024;
constexpr size_t WS_PW = WS_PSLOT + 256 * 1024;
constexpr size_t WS_WIN = 2 * MiB;
constexpr size_t WS_WOUT = 8 * MiB;
constexpr size_t WS_WGU = 10 * MiB;
constexpr size_t WS_WDN = 74 * MiB;
constexpr size_t WS_HX2 = 106 * MiB;
constexpr size_t WS_HX2F = 138 * MiB;
constexpr size_t WS_U = 138 * MiB;
constexpr size_t WS_YB = 154 * MiB;
constexpr size_t WS_P = 234 * MiB;
constexpr size_t WS_X1B0 = 454 * MiB;
constexpr size_t WS_X1B1 = 388 * MiB;
constexpr size_t WS_H = 298 * MiB;
constexpr size_t WS_HX = 336 * MiB;
constexpr size_t WS_ST = 370 * MiB;
constexpr size_t WS_DD = 405 * MiB;
constexpr size_t WS_A2 = 406 * MiB;
constexpr size_t WS_YX = 438 * MiB;
constexpr size_t WS_YXB = 470 * MiB;
constexpr size_t WS_RTOK = 502 * MiB;
constexpr size_t WS_END = 504 * MiB;
static_assert(WS_YB + (size_t)HROWS * 1024 * 2 <= WS_H && WS_H + (size_t)HROWS * 1024 <= WS_ST, "MoE buffers");
static_assert(WS_P + (size_t)MTOT * NIN * 2 <= WS_HX && WS_HX + (size_t)MTOT * D * 2 <= WS_ST && WS_ST + (size_t)32 * NBLK * 16384 * 4 <= WS_DD, "ws map");
constexpr float WSCALE = 256.0f, WSCALE_INV = 1.0f / 256.0f;

constexpr int CW_BAR = 4096;
constexpr int CW_CNT = 8192;
constexpr int CW_MT = 32768;
constexpr int CW_MOD = 12800;
constexpr int CW_G5 = 16384;
constexpr int CW_LATE = 20480;
constexpr int CW_G6 = 26624;
constexpr int CW_XCC = 24576;
constexpr int CW_CTX = 12288;

constexpr int RING_BYTES = 131072;
constexpr int LDS_TAB = RING_BYTES;
constexpr int LDS_MISC = RING_BYTES + 4096;
constexpr int LDS_BIAS = RING_BYTES + 1024;
constexpr int LDS_GOFF = RING_BYTES + 6144;
constexpr int LDS_BYTES = 155648;
static_assert(LDS_GOFF + 2 * 512 * 16 <= LDS_BYTES, "LDS map");
static_assert(8 * 16384 <= RING_BYTES, "per-wave scratch stays below the LDS tables / control words");

typedef float f32x2_ __attribute__((ext_vector_type(2)));
typedef __bf16 bf16x2_ __attribute__((ext_vector_type(2)));
__device__ __forceinline__ unsigned cvt_pk_bf16(float lo, float hi) { const bf16x2_ r = __builtin_convertvector((f32x2_){lo, hi}, bf16x2_); return __builtin_bit_cast(unsigned, r); }
__device__ __forceinline__ float bf2f(unsigned short b) { return __uint_as_float(((unsigned)b) << 16); }
__device__ __forceinline__ float bflo(unsigned w) { return __uint_as_float(w << 16); }
__device__ __forceinline__ float bfhi(unsigned w) { return __uint_as_float(w & 0xffff0000u); }
__device__ __forceinline__ unsigned short f2bf(float f) { return (unsigned short)(cvt_pk_bf16(f, 0.f) & 0xffffu); }
__device__ __forceinline__ unsigned pk4_fp8(float a, float b, float c, float d) { int w = __builtin_amdgcn_cvt_pk_fp8_f32(a, b, 0, false); w = __builtin_amdgcn_cvt_pk_fp8_f32(c, d, w, true); return (unsigned)w; }
__device__ __forceinline__ float sigmoidf_(float x) { return __builtin_amdgcn_rcpf(1.0f + __builtin_amdgcn_exp2f(-1.44269504089f * x)); }
__device__ __forceinline__ float wave_sum(float x) {
    int v;
    v = __builtin_amdgcn_mov_dpp(__float_as_int(x), 0x128, 0xf, 0xf, false); x += __int_as_float(v);
    v = __builtin_amdgcn_mov_dpp(__float_as_int(x), 0x124, 0xf, 0xf, false); x += __int_as_float(v);
    v = __builtin_amdgcn_mov_dpp(__float_as_int(x), 0x122, 0xf, 0xf, false); x += __int_as_float(v);
    v = __builtin_amdgcn_mov_dpp(__float_as_int(x), 0x121, 0xf, 0xf, false); x += __int_as_float(v);
    const int xi = __float_as_int(x);
    const float a = __int_as_float(__builtin_amdgcn_readlane(xi, 0)), b = __int_as_float(__builtin_amdgcn_readlane(xi, 16));
    const float c = __int_as_float(__builtin_amdgcn_readlane(xi, 32)), d = __int_as_float(__builtin_amdgcn_readlane(xi, 48));
    return (a + b) + (c + d);
}
__device__ __forceinline__ float wave_max(float x) {
    int v;
    v = __builtin_amdgcn_mov_dpp(__float_as_int(x), 0x128, 0xf, 0xf, false); x = fmaxf(x, __int_as_float(v));
    v = __builtin_amdgcn_mov_dpp(__float_as_int(x), 0x124, 0xf, 0xf, false); x = fmaxf(x, __int_as_float(v));
    v = __builtin_amdgcn_mov_dpp(__float_as_int(x), 0x122, 0xf, 0xf, false); x = fmaxf(x, __int_as_float(v));
    v = __builtin_amdgcn_mov_dpp(__float_as_int(x), 0x121, 0xf, 0xf, false); x = fmaxf(x, __int_as_float(v));
    const int xi = __float_as_int(x);
    const float a = __int_as_float(__builtin_amdgcn_readlane(xi, 0)), b = __int_as_float(__builtin_amdgcn_readlane(xi, 16));
    const float c = __int_as_float(__builtin_amdgcn_readlane(xi, 32)), d = __int_as_float(__builtin_amdgcn_readlane(xi, 48));
    return fmaxf(fmaxf(a, b), fmaxf(c, d));
}
#define TOUCH4(v) asm volatile("" : "+v"((v).x), "+v"((v).y), "+v"((v).z), "+v"((v).w))
#define TOUCH2(v) asm volatile("" : "+v"((v).x), "+v"((v).y))
#define LDS_WAIT() asm volatile("s_waitcnt lgkmcnt(0)" ::: "memory")
#define VM_WAIT() asm volatile("s_waitcnt vmcnt(0)" ::: "memory")
#define LSYNC() do { asm volatile("s_waitcnt lgkmcnt(0)" ::: "memory"); __builtin_amdgcn_s_barrier(); asm volatile("" ::: "memory"); } while (0)

#define XB_TMO      128
#define XB_XCNT(j)  (256  + 64 * (j))
#define XB_XSUB(j)  (1280 + 64 * (j))
#define XB_XGEN(j)  (2304 + 64 * (j))
#define XB_TOP      3328
#define XB_TOPGEN   3392
#define XCD_BAR_WORDS 3456
#define XB_SPIN_CAP (1u << 18)
__device__ __forceinline__ unsigned xb_ld(unsigned* p)              { return __hip_atomic_load(p, __ATOMIC_RELAXED, __HIP_MEMORY_SCOPE_AGENT); }
__device__ __forceinline__ unsigned xb_add(unsigned* p, unsigned v) { return __hip_atomic_fetch_add(p, v, __ATOMIC_RELAXED, __HIP_MEMORY_SCOPE_AGENT); }
__device__ __forceinline__ unsigned xb_xcc_id() { return (unsigned)__builtin_amdgcn_s_getreg((3 << 11) | 20) & 0xFu; }
#define XB_SPIN(cond, bar) do { unsigned _sp = 0; while (cond) { __builtin_amdgcn_s_sleep(1); \
    if ((++_sp & 255u) == 0u) { if (xb_ld(&(bar)[XB_TMO])) break; if (_sp > XB_SPIN_CAP) { atomicAdd(&(bar)[XB_TMO], 1u); break; } } } } while (0)
struct XcdBarrier { unsigned* bar; unsigned x; volatile LAS unsigned* st; };
__device__ __forceinline__ XcdBarrier xcd_barrier_post(unsigned* bar, volatile LAS unsigned* st) {
    XcdBarrier b; b.bar = bar; b.x = xb_xcc_id(); b.st = st;
    if (threadIdx.x == 0) (void)xb_add(&bar[XB_XCNT(b.x)], 1u);
    return b;
}
__device__ __forceinline__ void xcd_barrier_complete(unsigned* bar, unsigned x, unsigned& nloc, unsigned& nx) {
    const unsigned G = gridDim.x * gridDim.y * gridDim.z;
    unsigned sum, cnt, mine, sp = 0u;
    for (;;) {
        sum = 0u; cnt = 0u; mine = 0u;
#pragma unroll
        for (unsigned j = 0; j < 16; ++j) { const unsigned c = xb_ld(&bar[XB_XCNT(j)]); sum += c; cnt += (c > 0u) ? 1u : 0u; mine = (j == x) ? c : mine; }
        if (sum == G) break;
        __builtin_amdgcn_s_sleep(1);
        if ((++sp & 255u) == 0u) { if (xb_ld(&bar[XB_TMO])) break; if (sp > XB_SPIN_CAP) { atomicAdd(&bar[XB_TMO], 1u); break; } }
    }
    nloc = mine > 0u ? mine : 1u; nx = cnt > 0u ? cnt : 1u;
}
__device__ __forceinline__ void xcd_arrive(const XcdBarrier& b) {
    asm volatile("s_waitcnt vmcnt(0)" ::: "memory");
    __syncthreads();
    if (threadIdx.x == 0) {
        unsigned* bar = b.bar;
        __builtin_amdgcn_s_waitcnt(0);
        unsigned nloc = b.st[0], nx = b.st[1];
        if (nloc == 0u) { xcd_barrier_complete(bar, b.x, nloc, nx); b.st[0] = nloc; b.st[1] = nx; }
        const unsigned old = xb_add(&bar[XB_XSUB(b.x)], 1u);
        const unsigned gen = old / nloc;
        if (old + 1u == (gen + 1u) * nloc) {
            __builtin_amdgcn_fence(__ATOMIC_RELEASE, "agent");
            asm volatile("s_waitcnt vmcnt(0)" ::: "memory");
#pragma unroll
            for (unsigned j = 0; j < 16; ++j) (void)xb_add(&bar[XB_XGEN(j)], 1u);
        }
        b.st[2] = nx * (gen + 1u); b.st[3] = 0u;
        asm volatile("buffer_inv sc1" ::: "memory");
    }
}
__device__ __forceinline__ void xcd_try_acquire(const XcdBarrier& b) {
    if (threadIdx.x == 0 && b.st[3] == 0u) {
        if ((int)(xb_ld(&b.bar[XB_XGEN(b.x)]) - b.st[2]) >= 0) { asm volatile("buffer_inv sc1" ::: "memory"); b.st[3] = 1u; }
    }
}
__device__ __forceinline__ void xcd_wait(const XcdBarrier& b) {
    if (threadIdx.x == 0) {
        unsigned* bar = b.bar;
        if (b.st[3] != 0u) { b.st[3] = 0u; asm volatile("s_waitcnt vmcnt(0)" ::: "memory"); }
        else {
            const unsigned need = b.st[2];
            XB_SPIN((int)(xb_ld(&bar[XB_XGEN(b.x)]) - need) < 0, bar);
            asm volatile("s_waitcnt vmcnt(0)" ::: "memory");
        }
    }
    __syncthreads();
}
__device__ __forceinline__ void xcd_barrier(const XcdBarrier& b) { xcd_arrive(b); xcd_wait(b); }

namespace pg8 {
constexpr int BM = 256, BK = 64, HALF = 128, HTB = HALF * BK * 2, STAGE_BYTES = 8 * HTB, NXCD = 8, WGM = 8;
__host__ __device__ __forceinline__ int lds_byte(int r, int c) { const int st = (r >> 4) * 2 + (c >> 5), rr = r & 15, cc = c & 31, ob = rr * 64 + cc * 2; return st * 1024 + (ob ^ (((ob >> 9) & 1) << 5)); }
__host__ __device__ __forceinline__ void stage_rc(int b, int& R, int& C) { const int st = b / 1024, sb = b % 1024, swz = sb ^ (((sb >> 9) & 1) << 5); R = (st >> 1) * 16 + swz / 64; C = (st & 1) * 32 + (swz % 64) / 2; }
__host__ __device__ __forceinline__ int perm32(int rho) { const int n = rho >> 4, i = rho & 15; return 8 * (i >> 2) + 4 * n + (i & 3); }

struct UnitS { const char* A; const char* B; int pm, pn; };
struct StaticOrder {
    typedef UnitS Unit;
    const char* Abase; const char* Bbase; size_t tstep;
    int nM, nN, nwg, G, c;
    __device__ void init(const void* A, const void* Bt, int M_, int N_, int K_, int G_, int c_) { Abase = (const char*)A; Bbase = (const char*)Bt; tstep = (size_t)BM * K_ * 2; nM = M_ / BM; nN = N_ / BM; nwg = nM * nN; G = G_; c = c_; }
    __device__ bool next(int i, Unit& u) const {
        const long L = (long)i * G + c; if (L >= nwg) return false;
        int wgid = (int)L; { const int q = nwg / NXCD, r = nwg % NXCD, xcd = wgid % NXCD, off = wgid / NXCD; wgid = (xcd < r ? xcd * (q + 1) : r * (q + 1) + (xcd - r) * q) + off; }
        const int nig = WGM * nN, gid = wgid / nig, fm = gid * WGM, gsz = (nM - fm) < WGM ? (nM - fm) : WGM;
        u.pm = fm + ((wgid % nig) % gsz); u.pn = (wgid % nig) / gsz;
        u.A = Abase + (size_t)u.pm * tstep; u.B = Bbase + (size_t)u.pn * tstep; return true;
    }
    static constexpr bool PUBLISH = false;
    __device__ __forceinline__ const int* row_src(const Unit&, int) const { return nullptr; }
    __device__ __forceinline__ unsigned row_tok(const Unit&, int) const { return 0u; }
    __device__ __forceinline__ void a_ready(const Unit&, int) const {} __device__ __forceinline__ void a_ready_pre(const Unit&, int) const {} __device__ __forceinline__ void a_prefetch(const Unit&, int) const {}
    __device__ __forceinline__ int key(const Unit&) const { return 0; }
    __device__ __forceinline__ void publish(int) const {}
};

struct OneUnit { typedef UnitS Unit; UnitS u; static constexpr bool PUBLISH = false;
    __device__ bool next(int i, Unit& o) const { if (i) return false; o = u; return true; }
    __device__ __forceinline__ const int* row_src(const Unit&, int) const { return nullptr; } __device__ __forceinline__ unsigned row_tok(const Unit&, int) const { return 0u; }
    __device__ __forceinline__ void a_ready(const Unit&, int) const {} __device__ __forceinline__ void a_ready_pre(const Unit&, int) const {} __device__ __forceinline__ void a_prefetch(const Unit&, int) const {} __device__ __forceinline__ int key(const Unit&) const { return 0; } __device__ __forceinline__ void publish(int) const {} };
struct P2Order { typedef UnitS Unit; StaticOrder S; UnitS cu; bool ctx; static constexpr bool PUBLISH = false;
    __device__ bool next(int i, Unit& o) const {
        if (i < 3) { if (!S.next(i, o)) return false; o.pn = (int)((0xBA7698325410ULL >> (4 * o.pn)) & 15ULL); o.B = S.Bbase + (size_t)o.pn * S.tstep; return true; }
        if (i == 3 && ctx) { o = cu; return true; } return false; }
    __device__ __forceinline__ const int* row_src(const Unit&, int) const { return nullptr; } __device__ __forceinline__ unsigned row_tok(const Unit&, int) const { return 0u; }
    __device__ __forceinline__ void a_ready(const Unit&, int) const {} __device__ __forceinline__ void a_ready_pre(const Unit&, int) const {} __device__ __forceinline__ void a_prefetch(const Unit&, int) const {} __device__ __forceinline__ int key(const Unit&) const { return 0; } __device__ __forceinline__ void publish(int) const {} };
typedef int i32x4 __attribute__((ext_vector_type(4)));
typedef int i32x8 __attribute__((ext_vector_type(8)));
template <class Epi, class Sched, bool GATHER, bool ALIGN_EPI, bool SP2, bool FP8 = false>
__device__ __forceinline__ void gemm_phase(LAS unsigned char* lds, const int K, const Sched& S, const Epi& E) {
    typedef typename Sched::Unit Unit;
    const int tid = threadIdx.x, wid = __builtin_amdgcn_readfirstlane(tid >> 6), lane = tid & 63, wr = wid >> 2, wc = wid & 3, fr = lane & 15, fq = lane >> 4;
    const int nt = K / BK;
    const size_t kstep = (size_t)(BK * 2);
    const size_t kstepB = FP8 ? (size_t)4096 : kstep;
    const size_t hstep = (size_t)HALF * K * 2;
    unsigned voffB[2], cA0[2], cA1[2];
#pragma unroll
    for (int i = 0; i < 2; ++i) { int R, C; stage_rc(tid * 16 + i * 8192, R, C); const int Rb = Epi::PERM ? ((R & ~31) + perm32(R & 31)) : R;
        voffB[i] = FP8 ? (unsigned)((Rb >> 5) * 32768 + (Rb & 31) * 128 + C * 2) : (unsigned)(Rb * K + C) * 2u; cA0[i] = (unsigned)(R * K + C) * 2u; cA1[i] = cA0[i] + (unsigned)hstep; }
#define gro(p, v) ((LAS unsigned*)(lds + LDS_GOFF + (p) * 8192 + (v) * 2048 + tid * 4))
    int gp = 0;
    unsigned gcc[2] = {0u, 0u};
    if constexpr (GATHER) { int R, C; stage_rc(tid * 16, R, C); gcc[0] = (unsigned)C * 2u; stage_rc(tid * 16 + 8192, R, C); gcc[1] = (unsigned)C * 2u; }
    const unsigned ldsw = (unsigned)wid * 1024u;
    const int aoff = lds_byte(wr * 64 + fr, fq * 8), boff = lds_byte(wc * 32 + fr, fq * 8);
#define PG8_SA(b, h) (((b) * 2 + (h)) * HTB)
#define PG8_SB(b, h) ((4 + (b) * 2 + (h)) * HTB)
#define PG8_STAGE(bufoff, gbase, voff) do { _Pragma("unroll") for (int _i = 0; _i < 2; ++_i) \
        __builtin_amdgcn_global_load_lds((const unsigned*)((const char*)(gbase) + (voff)[_i]), (LAS unsigned*)(lds + (bufoff) + ldsw + _i * 8192), 16, 0, 0); } while (0)
#define PG8_LDA(dst, b, h) do { _Pragma("unroll") for (int m = 0; m < 4; ++m) { const i32x4 _p0 = *(const LAS i32x4*)(lds + PG8_SA(b, h) + aoff + m * 2048), _p1 = *(const LAS i32x4*)(lds + PG8_SA(b, h) + aoff + m * 2048 + 1024); \
        dst[m] = __builtin_shufflevector(_p0, _p1, 0, 1, 2, 3, 4, 5, 6, 7); } } while (0)
#define PG8_LDB(dst, b, h) do { _Pragma("unroll") for (int n = 0; n < 2; ++n) { const i32x4 _p0 = *(const LAS i32x4*)(lds + PG8_SB(b, h) + boff + n * 2048), _p1 = *(const LAS i32x4*)(lds + PG8_SB(b, h) + boff + n * 2048 + 1024); \
        dst[n] = __builtin_shufflevector(_p0, _p1, 0, 1, 2, 3, 4, 5, 6, 7); } } while (0)
#define PG8_ACC(ai, bj, m, n) ((n) ? __builtin_shufflevector(acc[ai][bj][m], acc[ai][bj][m], 4, 5, 6, 7) : __builtin_shufflevector(acc[ai][bj][m], acc[ai][bj][m], 0, 1, 2, 3))
#define PG8_SETACC(ai, bj, m, n, v) do { const f32x4 _v = (v); if (n) acc[ai][bj][m] = __builtin_shufflevector(acc[ai][bj][m], __builtin_shufflevector(_v, _v, 0, 1, 2, 3, 0, 1, 2, 3), 0, 1, 2, 3, 12, 13, 14, 15); \
        else acc[ai][bj][m] = __builtin_shufflevector(acc[ai][bj][m], __builtin_shufflevector(_v, _v, 0, 1, 2, 3, 0, 1, 2, 3), 8, 9, 10, 11, 4, 5, 6, 7); } while (0)
#define PG8_MMA(ai, bj, At, Bt) do { __builtin_amdgcn_s_setprio(1); _Pragma("unroll") for (int m = 0; m < 4; ++m) _Pragma("unroll") for (int n = 0; n < 2; ++n) { \
        if constexpr (FP8) { PG8_SETACC(ai, bj, m, n, __builtin_amdgcn_mfma_scale_f32_16x16x128_f8f6f4(Bt[n], At[m], PG8_ACC(ai, bj, m, n), 0, 0, 0, 127, 0, 127)); } \
        else { f32x4 _c = __builtin_amdgcn_mfma_f32_16x16x32_bf16(__builtin_bit_cast(bf16x8, __builtin_shufflevector(Bt[n], Bt[n], 0, 1, 2, 3)), __builtin_bit_cast(bf16x8, __builtin_shufflevector(At[m], At[m], 0, 1, 2, 3)), PG8_ACC(ai, bj, m, n), 0, 0, 0); \
               PG8_SETACC(ai, bj, m, n, __builtin_amdgcn_mfma_f32_16x16x32_bf16(__builtin_bit_cast(bf16x8, __builtin_shufflevector(Bt[n], Bt[n], 4, 5, 6, 7)), __builtin_bit_cast(bf16x8, __builtin_shufflevector(At[m], At[m], 4, 5, 6, 7)), _c, 0, 0, 0)); } } \
        __builtin_amdgcn_s_setprio(0); } while (0)
#define PG8_WAIT_V(n) asm volatile("s_waitcnt vmcnt(" #n ")" ::: "memory")
#define PG8_WAIT_L(n) asm volatile("s_waitcnt lgkmcnt(" #n ")" ::: "memory")
#define PG8_BAR __builtin_amdgcn_s_barrier()
#define PG8_SCHED __builtin_amdgcn_sched_barrier(0)
    Unit cur, nxt; int ui = 0; int pkey = 0;
    if (!S.next(0, cur)) return;
    S.a_ready(cur, wid);
    if constexpr (GATHER) {
#pragma unroll
        for (int i = 0; i < 2; ++i) { int R, C; int t2 = tid; asm volatile("" : "+v"(t2)); stage_rc(t2 * 16 + i * 8192, R, C);
            const unsigned r0 = S.row_tok(cur, R), r1 = S.row_tok(cur, HALF + R); *gro(0, i) = r0; *gro(0, 2 + i) = r1;
            cA0[i] = r0 + (unsigned)C * 2u; cA1[i] = r1 + (unsigned)C * 2u; }
    }
    typedef float f32x8_ __attribute__((ext_vector_type(8)));
    f32x8_ acc[2][2][4];
    typedef double f64x4_ __attribute__((ext_vector_type(4)));
    double zero_; asm volatile("v_mov_b64 %0, 0" : "=v"(zero_));
#pragma unroll
    for (int a = 0; a < 2; ++a)
#pragma unroll
        for (int b = 0; b < 2; ++b)
#pragma unroll
            for (int m = 0; m < 4; ++m) acc[a][b][m] = __builtin_bit_cast(f32x8_, (f64x4_){zero_, zero_, zero_, zero_});
    i32x8 At[4], B0[2], B1[2];
    const char* cA = cur.A; const char* cB = cur.B;
    if constexpr (Epi::LDS_BIAS) E.stage_bias(cur, lds + LDS_BIAS, wid, lane);
    if constexpr (SP2) {
        PG8_STAGE(PG8_SB(0, 0), cB, voffB); PG8_STAGE(PG8_SB(0, 1), cB + hstep, voffB); PG8_STAGE(PG8_SA(0, 0), cA, cA0); PG8_STAGE(PG8_SA(0, 1), cA, cA1);
        if (wr == 1) PG8_BAR;
        PG8_WAIT_V(2); PG8_BAR;
        PG8_STAGE(PG8_SB(1, 0), cB + kstepB, voffB); PG8_STAGE(PG8_SA(1, 0), cA + kstep, cA0); PG8_STAGE(PG8_SB(1, 1), cB + hstep + kstepB, voffB);
        PG8_WAIT_V(6); PG8_BAR;
    } else {
        PG8_STAGE(PG8_SB(0, 0), cB, voffB); PG8_STAGE(PG8_SA(0, 0), cA, cA0); PG8_STAGE(PG8_SB(0, 1), cB + hstep, voffB); PG8_STAGE(PG8_SA(0, 1), cA, cA1);
        if (wr == 1) PG8_BAR;
        PG8_WAIT_V(4); PG8_BAR;
        PG8_STAGE(PG8_SB(1, 0), cB + kstepB, voffB); PG8_STAGE(PG8_SA(1, 0), cA + kstep, cA0); PG8_STAGE(PG8_SB(1, 1), cB + hstep + kstepB, voffB);
        PG8_WAIT_V(6); PG8_BAR;
    }
    for (;;) {
        const bool has_next = S.next(ui + 1, nxt);
        if (has_next) S.a_prefetch(nxt, wid);
        const char* nA = has_next ? nxt.A : cA; const char* nB = has_next ? nxt.B : cB;
        if constexpr (GATHER) {
            if (has_next) {
                int R0, C0, R1, C1; int t2 = tid; asm volatile("" : "+v"(t2)); stage_rc(t2 * 16, R0, C0); stage_rc(t2 * 16 + 8192, R1, C1);
                LAS unsigned char* gb = lds + LDS_GOFF + (gp ^ 1) * 8192 + wid * 256;
                __builtin_amdgcn_global_load_lds((const unsigned*)S.row_src(nxt, R0), (LAS unsigned*)(gb), 4, 0, 0);
                __builtin_amdgcn_global_load_lds((const unsigned*)S.row_src(nxt, R1), (LAS unsigned*)(gb + 2048), 4, 0, 0);
                __builtin_amdgcn_global_load_lds((const unsigned*)S.row_src(nxt, HALF + R0), (LAS unsigned*)(gb + 4096), 4, 0, 0);
                __builtin_amdgcn_global_load_lds((const unsigned*)S.row_src(nxt, HALF + R1), (LAS unsigned*)(gb + 6144), 4, 0, 0);
            }
        }
#pragma unroll 1
        for (int t = 0; t < nt; t += 2) {
            const bool last = (t == nt - 2);
            if (last && has_next) S.a_ready_pre(nxt, wid);
            const char* a1 = cA + (size_t)(t + 1) * kstep;
            const char* a2 = last ? nA : cA + (size_t)(t + 2) * kstep; const char* b2 = last ? nB : cB + (size_t)(t + 2) * kstepB;
            const char* a3 = a2 + kstep; const char* b3 = b2 + kstepB;
            const int gq = (last && has_next) ? (gp ^ 1) : gp;
#define PG8_GO(p, v, dst) unsigned dst[2]; if constexpr (GATHER) { dst[0] = *gro(p, v) + gcc[0]; dst[1] = *gro(p, (v) + 1) + gcc[1]; } else { dst[0] = ((v) ? cA1 : cA0)[0]; dst[1] = ((v) ? cA1 : cA0)[1]; }
            if constexpr (SP2) {
            { PG8_GO(gp, 2, y1); PG8_LDB(B0, 0, 0); PG8_LDB(B1, 0, 1); PG8_SCHED; PG8_LDA(At, 0, 0); PG8_STAGE(PG8_SA(1, 1), a1, y1); }
            PG8_WAIT_V(8); PG8_WAIT_L(0); PG8_BAR; PG8_MMA(0, 0, At, B0); PG8_MMA(0, 1, At, B1); PG8_BAR; PG8_SCHED;
            { PG8_GO(gq, 0, x0); PG8_LDA(At, 0, 1); PG8_STAGE(PG8_SB(0, 0), b2, voffB); PG8_STAGE(PG8_SB(0, 1), b2 + hstep, voffB); PG8_STAGE(PG8_SA(0, 0), a2, x0); }
            PG8_WAIT_V(8); PG8_WAIT_L(0); PG8_BAR; PG8_MMA(1, 0, At, B0); PG8_MMA(1, 1, At, B1); PG8_BAR; PG8_SCHED;
            { PG8_GO(gq, 2, x1); PG8_LDB(B0, 1, 0); PG8_LDB(B1, 1, 1); PG8_SCHED; PG8_LDA(At, 1, 0); PG8_STAGE(PG8_SA(0, 1), a2, x1); }
            PG8_WAIT_V(8); PG8_WAIT_L(0); PG8_BAR; PG8_MMA(0, 0, At, B0); PG8_MMA(0, 1, At, B1); PG8_BAR; PG8_SCHED;
            { PG8_GO(gq, 0, x0); PG8_LDA(At, 1, 1); PG8_STAGE(PG8_SB(1, 0), b3, voffB); PG8_STAGE(PG8_SB(1, 1), b3 + hstep, voffB); PG8_STAGE(PG8_SA(1, 0), a3, x0); }
            PG8_WAIT_V(8); PG8_WAIT_L(0); PG8_BAR; PG8_MMA(1, 0, At, B0); PG8_MMA(1, 1, At, B1); PG8_BAR; PG8_SCHED;
            } else {
            PG8_GO(gp, 2, y1); PG8_GO(gq, 0, x0); PG8_GO(gq, 2, x1);
            PG8_LDB(B0, 0, 0); PG8_SCHED; PG8_LDA(At, 0, 0); PG8_STAGE(PG8_SA(1, 1), a1, y1);
            PG8_WAIT_L(8); PG8_BAR; PG8_WAIT_L(0); PG8_MMA(0, 0, At, B0); PG8_BAR; PG8_SCHED;
            PG8_LDB(B1, 0, 1); PG8_STAGE(PG8_SB(0, 0), b2, voffB);
            PG8_BAR; PG8_WAIT_L(0); PG8_MMA(0, 1, At, B1); PG8_BAR;
            PG8_LDA(At, 0, 1); PG8_STAGE(PG8_SA(0, 0), a2, x0);
            PG8_BAR; PG8_WAIT_L(0); PG8_MMA(1, 0, At, B0); PG8_BAR; PG8_SCHED;
            PG8_STAGE(PG8_SB(0, 1), b2 + hstep, voffB);
            PG8_WAIT_V(6); PG8_BAR; PG8_MMA(1, 1, At, B1); PG8_BAR;
            PG8_LDB(B0, 1, 0); PG8_SCHED; PG8_LDA(At, 1, 0); PG8_STAGE(PG8_SA(0, 1), a2, x1);
            PG8_WAIT_L(8); PG8_BAR; PG8_WAIT_L(0); PG8_MMA(0, 0, At, B0); PG8_BAR; PG8_SCHED;
            PG8_LDB(B1, 1, 1); PG8_STAGE(PG8_SB(1, 0), b3, voffB);
            PG8_BAR; PG8_WAIT_L(0); PG8_MMA(0, 1, At, B1); PG8_BAR;
            PG8_LDA(At, 1, 1); PG8_STAGE(PG8_SA(1, 0), a3, x0);
            PG8_BAR; PG8_WAIT_L(0); PG8_MMA(1, 0, At, B0); PG8_BAR; PG8_SCHED;
            PG8_STAGE(PG8_SB(1, 1), b3 + hstep, voffB);
            PG8_WAIT_V(6); PG8_BAR; PG8_MMA(1, 1, At, B1); PG8_BAR;
            }
        }
        if constexpr (ALIGN_EPI) { if (wr == 0) PG8_BAR; }
        asm volatile("" ::: "memory");
        if constexpr (Sched::PUBLISH) { if (ui > 0) S.publish(pkey); }
        { f32x4 av[2][2][4][2];
#pragma unroll
          for (int a = 0; a < 2; ++a)
#pragma unroll
              for (int b = 0; b < 2; ++b)
#pragma unroll
                  for (int m = 0; m < 4; ++m) { av[a][b][m][0] = PG8_ACC(a, b, m, 0); av[a][b][m][1] = PG8_ACC(a, b, m, 1); }
          int t3 = tid; asm volatile("" : "+v"(t3)); const int fr3 = t3 & 15, fq3 = (t3 & 63) >> 4;
          if constexpr (Epi::LDS_BIAS) E(av, cur, wr, wc, fr3, fq3, lds + LDS_BIAS + (ui & 1) * 1024); else E(av, cur, wr, wc, fr3, fq3); }
        if constexpr (Sched::PUBLISH) { pkey = S.key(cur); if (!has_next) S.publish(pkey); }
        if (!has_next) break;
#pragma unroll
        for (int a = 0; a < 2; ++a)
#pragma unroll
            for (int b = 0; b < 2; ++b)
#pragma unroll
                for (int m = 0; m < 4; ++m) acc[a][b][m] = __builtin_bit_cast(f32x8_, (f64x4_){zero_, zero_, zero_, zero_});
        cur = nxt; cA = nA; cB = nB; ++ui;
        if constexpr (Epi::LDS_BIAS) E.stage_bias(cur, lds + LDS_BIAS + (ui & 1) * 1024, wid, lane);
        if constexpr (GATHER) gp ^= 1;
        if constexpr (ALIGN_EPI) { if (wr == 1) PG8_BAR; }
    }
    PG8_WAIT_V(0);
    if constexpr (!ALIGN_EPI) { if (wr == 0) PG8_BAR; }
    PG8_BAR;
#undef PG8_SA
#undef PG8_SB
#undef PG8_STAGE
#undef PG8_LDA
#undef PG8_LDB
#undef PG8_MMA
#undef gro
#undef PG8_GO
#undef PG8_ACC
#undef PG8_SETACC
#undef PG8_WAIT_V
#undef PG8_WAIT_L
#undef PG8_BAR
#undef PG8_SCHED
}
}

struct EpiInProj {
    static constexpr bool PERM = true, LDS_BIAS = false;
    bf16_t* P; const float* lbl; bf16_t* U; const float* gain;
    template <int TYPE>
    __device__ __forceinline__ void body(const f32x4 (&acc)[2][2][4][2], const pg8::UnitS& u, int wr, int wc, int fr, int fq) const {
        typedef float f32x2 __attribute__((ext_vector_type(2)));
        const int row0 = u.pm * 256 + wr * 64 + fr, col0 = u.pn * 256 + wc * 32 + 8 * fq;
        f32x2 lbv[2][4], olb[2][4];
#pragma unroll
        for (int bj = 0; bj < 2; ++bj)
#pragma unroll
            for (int p = 0; p < 4; ++p) { lbv[bj][p] = (f32x2){0.f, 0.f}; olb[bj][p] = (f32x2){1.f, 1.f}; }
        if (TYPE == 4) {
#pragma unroll
            for (int bj = 0; bj < 2; ++bj) { const int ch = col0 + bj * 128 - 2048;
#pragma unroll
                for (int p = 0; p < 4; ++p) { lbv[bj][p].x = gain[ch + 2 * p]; lbv[bj][p].y = gain[ch + 2 * p + 1]; } }
#pragma unroll
            for (int bj = 0; bj < 2; ++bj)
#pragma unroll
                for (int p = 0; p < 4; ++p) TOUCH2(lbv[bj][p]);
        }
        if (TYPE == 1 || TYPE == 2) {
#pragma unroll
            for (int bj = 0; bj < 2; ++bj) { const int ch = col0 + bj * 128 - 512;
#pragma unroll
                for (int p = 0; p < 4; ++p) { lbv[bj][p].x = sigmoidf_(lbl[ch + 2 * p] - lbl[1024 + ch + 2 * p]); lbv[bj][p].y = sigmoidf_(lbl[ch + 2 * p + 1] - lbl[1024 + ch + 2 * p + 1]); olb[bj][p] = 1.0f - lbv[bj][p]; } }
        }
#pragma unroll
        for (int ai = 0; ai < 2; ++ai)
#pragma unroll
            for (int m = 0; m < 4; ++m) { bf16_t* rowp = P + (size_t)(row0 + ai * 128 + m * 16) * NIN + col0;
#pragma unroll
                for (int bj = 0; bj < 2; ++bj) { f32x2 v[4];
#pragma unroll
                    for (int p = 0; p < 4; ++p) { const f32x4 a = acc[ai][bj][m][p >> 1]; v[p] = (p & 1) ? (f32x2){a.z, a.w} : (f32x2){a.x, a.y}; }
                    if (TYPE == 0 || TYPE == 1 || TYPE == 2 || TYPE == 4) {
#pragma unroll
                        for (int p = 0; p < 4; ++p) { const f32x2 ea = v[p] * (-1.44269504089f);
                            f32x2 t; t.x = __builtin_amdgcn_exp2f(ea.x); t.y = __builtin_amdgcn_exp2f(ea.y); t = t + 1.0f;
                            f32x2 sg; sg.x = __builtin_amdgcn_rcpf(t.x); sg.y = __builtin_amdgcn_rcpf(t.y);
                            if (TYPE == 0) v[p] = v[p] * sg;
                            else if (TYPE == 4) v[p] = sg * lbv[bj][p];
                            else { const f32x2 f = sg * olb[bj][p] + lbv[bj][p]; f32x2 lg; lg.x = __builtin_amdgcn_logf(f.x); lg.y = __builtin_amdgcn_logf(f.y); v[p] = lg; } }
                    }
                    u32x4 w; w.x = cvt_pk_bf16(v[0].x, v[0].y); w.y = cvt_pk_bf16(v[1].x, v[1].y); w.z = cvt_pk_bf16(v[2].x, v[2].y); w.w = cvt_pk_bf16(v[3].x, v[3].y);
                    if (TYPE == 5) { const int row = row0 + ai * 128 + m * 16, slab = (col0 + bj * 128 - 2560) >> 3;
                        *(u32x4*)(U + ((size_t)((row >> 12) * 64 + slab) * 4096 + (row & 4095)) * 8) = w; }
                    else *(u32x4*)(rowp + bj * 128) = w; } }
    }
    __device__ __forceinline__ void operator()(const f32x4 (&acc)[2][2][4][2], const pg8::UnitS& u, int wr, int wc, int fr, int fq) const {
        switch (u.pn >> 1) {
            case 0: body<0>(acc, u, wr, wc, fr, fq); break;
            case 1: body<1>(acc, u, wr, wc, fr, fq); break;
            case 2: body<2>(acc, u, wr, wc, fr, fq); break;
            case 3: body<3>(acc, u, wr, wc, fr, fq); break;
            case 4: body<4>(acc, u, wr, wc, fr, fq); break;
            default: body<5>(acc, u, wr, wc, fr, fq); break;
        }
    }
};
struct EpiBf16Out {
    static constexpr bool PERM = true, LDS_BIAS = false;
    bf16_t* C; int ldc;
    __device__ __forceinline__ void operator()(const f32x4 (&acc)[2][2][4][2], const pg8::UnitS& u, int wr, int wc, int fr, int fq) const {
        const int row0 = u.pm * 256 + wr * 64 + fr, col0 = u.pn * 256 + wc * 32 + 8 * fq;
#pragma unroll
        for (int ai = 0; ai < 2; ++ai)
#pragma unroll
            for (int m = 0; m < 4; ++m) { bf16_t* rowp = C + (size_t)(row0 + ai * 128 + m * 16) * ldc + col0;
#pragma unroll
                for (int bj = 0; bj < 2; ++bj) { const f32x4 v0 = acc[ai][bj][m][0], v1 = acc[ai][bj][m][1];
                    u32x4 w; w.x = cvt_pk_bf16(v0[0], v0[1]); w.y = cvt_pk_bf16(v0[2], v0[3]); w.z = cvt_pk_bf16(v1[0], v1[1]); w.w = cvt_pk_bf16(v1[2], v1[3]);
                    *(u32x4*)(rowp + bj * 128) = w; } }
    }
};

struct UnitM { const char* A; const char* B; int e, mt, pn, row0, cnt; };
typedef int i32x4_ __attribute__((ext_vector_type(4)));
template <int NT_, bool GATHER_>
struct MoeOrder {
    typedef UnitM Unit;
    static constexpr int pitch = 1024; static constexpr size_t wstride = (size_t)NT_ * 256 * 1024;
    const LAS int* tab;
    const char* Abase; const char* Wbase; const int* rtok;
    unsigned* mtc;
    int cls, rank, nrank;
    static constexpr bool PUBLISH = GATHER_;
    __device__ __forceinline__ int key(const Unit& u) const { return u.row0 >> 8; }
    __device__ __forceinline__ void publish(int k) const {
        asm volatile("s_waitcnt vmcnt(0)" ::: "memory");
        if ((threadIdx.x & 63) == 0) __hip_atomic_fetch_add(mtc + 64 * k, 1u, __ATOMIC_RELAXED, __HIP_MEMORY_SCOPE_AGENT);
    }
    LAS unsigned char* ldsb;
    __device__ __forceinline__ void a_prefetch(const Unit& u, int wid) const {
        if constexpr (!GATHER_) { if (wid == 0) __builtin_amdgcn_global_load_lds((const unsigned*)(mtc + 64 * (u.row0 >> 8)), (LAS unsigned*)(ldsb + LDS_MISC + 256), 4, 0, 16); }
    }
    template <bool PRE> __device__ __forceinline__ void a_wait(const Unit& u, int wid) const {
        if constexpr (!GATHER_) {
            if (wid == 0) { unsigned sp = 0;
                bool done = false;
                if (PRE) done = (unsigned)__builtin_amdgcn_readfirstlane(*(volatile LAS unsigned*)(ldsb + LDS_MISC + 256)) >= 64u;
                if (!done) while ((unsigned)__builtin_amdgcn_readfirstlane(__hip_atomic_load(mtc + 64 * (u.row0 >> 8), __ATOMIC_RELAXED, __HIP_MEMORY_SCOPE_AGENT)) < 64u) { __builtin_amdgcn_s_sleep(2); if (++sp > (1u << 22)) break; }
                __builtin_amdgcn_fence(__ATOMIC_ACQUIRE, "agent");
                asm volatile("s_waitcnt vmcnt(0)" ::: "memory"); }
            asm volatile("" ::: "memory"); __builtin_amdgcn_s_barrier(); asm volatile("" ::: "memory");
        }
    }
    __device__ __forceinline__ void a_ready(const Unit& u, int wid) const { a_wait<false>(u, wid); }
    __device__ __forceinline__ void a_ready_pre(const Unit& u, int wid) const { a_wait<true>(u, wid); }
    __device__ bool next(int i, Unit& u) const {
        const int L = i * nrank + rank; const int mtg = L / NT_; u.pn = L - mtg * NT_;
        if (mtg >= __builtin_amdgcn_readfirstlane(tab[64])) return false;
        const int pbe = tab[32 + (threadIdx.x & 31)];
        const unsigned long long own = __ballot(pbe <= mtg * 256);
        const int e = __popcll(own & 0xffffffffull) - 1;
        const int pb = __builtin_amdgcn_readfirstlane(tab[32 + e]);
        u.e = e; u.mt = mtg - (pb >> 8); u.cnt = __builtin_amdgcn_readfirstlane(tab[e]); u.row0 = mtg * 256;
        u.B = Wbase + (size_t)e * wstride + (size_t)u.pn * 256 * pitch;
        u.A = GATHER_ ? Abase : Abase + (size_t)u.row0 * pitch;
        return true;
    }
    __device__ __forceinline__ const int* row_src(const Unit& u, int r) const { const int slot = u.mt * 256 + r; return rtok + u.e * ECAP + (slot < u.cnt ? slot : 0); }
    __device__ __forceinline__ unsigned row_tok(const Unit& u, int r) const { return (unsigned)*row_src(u, r); }
};
struct EpiGateUp {
    static constexpr bool PERM = true, LDS_BIAS = true;
    unsigned char* H; const float* bg; const float* bu;
    __device__ __forceinline__ void stage_bias(const UnitM& u, LAS unsigned char* dst, int wid, int lane) const {
        if (wid < 4) { const float* src = ((wid & 2) ? bu : bg) + u.e * FF + u.pn * 128 + (wid & 1) * 64 + lane;
            __builtin_amdgcn_global_load_lds((const unsigned*)src, (LAS unsigned*)(dst + wid * 256), 4, 0, 0); }
    }
    __device__ __forceinline__ void operator()(const f32x4 (&acc)[2][2][4][2], const UnitM& u, int wr, int wc, int fr, int fq, const LAS unsigned char* lb) const {
        typedef float f32x2 __attribute__((ext_vector_type(2)));
        const int row0 = u.row0 + wr * 64 + fr, col0 = u.pn * 128 + wc * 32 + 8 * fq;
        const f32x4 g0 = *(const LAS f32x4*)(lb + (wc * 32 + 8 * fq) * 4), g1 = *(const LAS f32x4*)(lb + (wc * 32 + 8 * fq + 4) * 4);
        const f32x4 u0 = *(const LAS f32x4*)(lb + 512 + (wc * 32 + 8 * fq) * 4), u1 = *(const LAS f32x4*)(lb + 512 + (wc * 32 + 8 * fq + 4) * 4);
        const f32x2 gb[4] = {{g0.x, g0.y}, {g0.z, g0.w}, {g1.x, g1.y}, {g1.z, g1.w}}, ub[4] = {{u0.x + 1.0f, u0.y + 1.0f}, {u0.z + 1.0f, u0.w + 1.0f}, {u1.x + 1.0f, u1.y + 1.0f}, {u1.z + 1.0f, u1.w + 1.0f}};
        unsigned pw0 = 0u, pw1 = 0u;
#pragma unroll
        for (int ai = 0; ai < 2; ++ai)
#pragma unroll
            for (int m = 0; m < 4; ++m) { f32x2 h[4];
#pragma unroll
                for (int p = 0; p < 4; ++p) {
                    const f32x4 ag = acc[ai][0][m][p >> 1], au = acc[ai][1][m][p >> 1];
                    f32x2 g = (p & 1) ? (f32x2){ag.z, ag.w} : (f32x2){ag.x, ag.y}, up1 = (p & 1) ? (f32x2){au.z, au.w} : (f32x2){au.x, au.y};
                    g = g * WSCALE_INV + gb[p]; up1 = up1 * WSCALE_INV + ub[p];
                    g.x = fminf(g.x, 7.0f); g.y = fminf(g.y, 7.0f);
                    up1.x = __builtin_amdgcn_fmed3f(up1.x, -6.0f, 8.0f); up1.y = __builtin_amdgcn_fmed3f(up1.y, -6.0f, 8.0f);
                    const f32x2 ea = g * (-1.702f * 1.44269504089f);
                    f32x2 t; t.x = __builtin_amdgcn_exp2f(ea.x); t.y = __builtin_amdgcn_exp2f(ea.y);
                    t = t + 1.0f;
                    f32x2 sg; sg.x = __builtin_amdgcn_rcpf(t.x); sg.y = __builtin_amdgcn_rcpf(t.y);
                    h[p] = (up1 * g) * sg; }
                const unsigned w0 = pk4_fp8(h[0].x, h[0].y, h[1].x, h[1].y), w1 = pk4_fp8(h[2].x, h[2].y, h[3].x, h[3].y);
                if ((m & 1) == 0) { pw0 = w0; pw1 = w1; }
                else { const auto r0 = __builtin_amdgcn_permlane16_swap(pw0, w0, false, false), r1 = __builtin_amdgcn_permlane16_swap(pw1, w1, false, false);
                    u32x4 wv; wv.x = r0[0]; wv.y = r1[0]; wv.z = r0[1]; wv.w = r1[1];
                    const unsigned long long ad = (unsigned long long)(H + (size_t)(row0 + ai * 128 + (m - 1 + (fq & 1)) * 16) * FF + col0 - 8 * (fq & 1));
                    asm volatile("global_store_dwordx4 %0, %1, off sc1\n\ts_nop 2" :: "v"(ad), "v"(wv) : "memory"); } }
    }
};
struct EpiDown {
    static constexpr bool PERM = true, LDS_BIAS = true;
    unsigned char* Y; const float* bd;
    __device__ __forceinline__ void stage_bias(const UnitM& u, LAS unsigned char* dst, int wid, int lane) const {
        if (wid < 4) { const float* src = bd + u.e * D + u.pn * 256 + wid * 64 + lane;
            __builtin_amdgcn_global_load_lds((const unsigned*)src, (LAS unsigned*)(dst + wid * 256), 4, 0, 0); }
    }
    __device__ __forceinline__ void operator()(const f32x4 (&acc)[2][2][4][2], const UnitM& u, int wr, int wc, int fr, int fq, const LAS unsigned char* lb) const {
        const int row0 = u.row0 + wr * 64 + fr, col0 = u.pn * 256 + wc * 32 + 8 * fq;
        f32x4 b8[2][2];
#pragma unroll
        for (int bj = 0; bj < 2; ++bj) { b8[bj][0] = *(const LAS f32x4*)(lb + (bj * 128 + wc * 32 + 8 * fq) * 4); b8[bj][1] = *(const LAS f32x4*)(lb + (bj * 128 + wc * 32 + 8 * fq + 4) * 4); }
        u32x2 pw[2];
#pragma unroll
        for (int ai = 0; ai < 2; ++ai)
#pragma unroll
            for (int m = 0; m < 4; ++m)
#pragma unroll
                for (int bj = 0; bj < 2; ++bj) { const f32x4 v0 = acc[ai][bj][m][0] * WSCALE_INV + b8[bj][0], v1 = acc[ai][bj][m][1] * WSCALE_INV + b8[bj][1];
                    u32x2 w; w.x = pk4_fp8(v0.x, v0.y, v0.z, v0.w); w.y = pk4_fp8(v1.x, v1.y, v1.z, v1.w);
                    if ((m & 1) == 0) pw[bj] = w;
                    else { const auto r0 = __builtin_amdgcn_permlane16_swap(pw[bj].x, w.x, false, false), r1 = __builtin_amdgcn_permlane16_swap(pw[bj].y, w.y, false, false);
                        u32x4 wv; wv.x = r0[0]; wv.y = r1[0]; wv.z = r0[1]; wv.w = r1[1];
                        *(u32x4*)(Y + (size_t)(row0 + ai * 128 + (m - 1 + (fq & 1)) * 16) * D + col0 - 8 * (fq & 1) + bj * 128) = wv; } }
    }
};

struct Args { const float* in[24]; float* out; unsigned char* ws; int ph_lo, ph_hi, li, pad; };
struct Frame {
    LAS unsigned char* lds; unsigned char* ws; unsigned* ctl;
    int tid, lane, wave, G, bid;
};

__device__ __forceinline__ bf16_t* x1b_row(unsigned char* ws, int m) { return (bf16_t*)(ws + (m < 8192 ? WS_X1B0 : WS_X1B1 - (size_t)8192 * 2048)) + (size_t)m * 1024; }

struct TItem { const float* src; unsigned char* dst; int ldw, k0, n0, drow0; };
template <int NL> __device__ __forceinline__ void titem_load(const TItem& t, float (&tv)[NL], int lane) {
    const float* wp = t.src + (size_t)(t.k0 + (lane >> 5)) * t.ldw + t.n0 + (lane & 31);
#pragma unroll
    for (int i = 0; i < NL; ++i) tv[i] = wp[(size_t)(2 * i) * t.ldw];
}
template <bool WT> __device__ __forceinline__ void titem_finish_bf16(const TItem& t, const float (&tv)[32], LAS float* scr, int lane) {
#pragma unroll
    for (int i = 0; i < 32; ++i) scr[(2 * i + (lane >> 5)) * 33 + (lane & 31)] = tv[i];
    LDS_WAIT(); asm volatile("" ::: "memory");
    const int c = lane & 7;
#pragma unroll
    for (int j = 0; j < 4; ++j) { const int n = (lane >> 3) + 8 * j; const LAS float* s = scr + (8 * c) * 33 + n;
        u32x4 o; o.x = cvt_pk_bf16(s[0 * 33], s[1 * 33]); o.y = cvt_pk_bf16(s[2 * 33], s[3 * 33]); o.z = cvt_pk_bf16(s[4 * 33], s[5 * 33]); o.w = cvt_pk_bf16(s[6 * 33], s[7 * 33]);
        if (WT) { const unsigned long long ad = (unsigned long long)(t.dst + ((size_t)(t.drow0 + n) * 1024 + t.k0 + 8 * c) * 2); asm volatile("global_store_dwordx4 %0, %1, off sc1\n\ts_nop 2" :: "v"(ad), "v"(o) : "memory"); }
        else *(u32x4*)(t.dst + ((size_t)(t.drow0 + n) * 1024 + t.k0 + 8 * c) * 2) = o; }
    LDS_WAIT(); asm volatile("" ::: "memory");
}
__device__ __forceinline__ void titem_load_fp8(const TItem& t, f32x4 (&tv)[16], int lane) {
    const float* wp = t.src + (size_t)(t.k0 + (lane >> 3)) * t.ldw + t.n0 + 4 * (lane & 7);
#pragma unroll
    for (int i = 0; i < 16; ++i) tv[i] = __builtin_nontemporal_load((const f32x4*)(wp + (size_t)(8 * i) * t.ldw));
}
__device__ __forceinline__ void titem_finish_fp8(const TItem& t, const f32x4 (&tv)[16], LAS float* scr, int lane) {
#pragma unroll
    for (int i = 0; i < 16; ++i) { const int row = 8 * i + (lane >> 3); *(LAS f32x4*)(scr + row * 32 + ((4 * (lane & 7)) ^ ((8 * (row >> 4)) & 31))) = tv[i] * WSCALE; }
    LDS_WAIT(); asm volatile("" ::: "memory");
    const int c = lane & 7;
#pragma unroll
    for (int j = 0; j < 4; ++j) { const int n = (lane >> 3) + 8 * j; const LAS float* s = scr + (16 * c) * 32 + (n ^ ((8 * c) & 31));
        u32x4 o; o.x = pk4_fp8(s[0 * 32], s[1 * 32], s[2 * 32], s[3 * 32]); o.y = pk4_fp8(s[4 * 32], s[5 * 32], s[6 * 32], s[7 * 32]);
        o.z = pk4_fp8(s[8 * 32], s[9 * 32], s[10 * 32], s[11 * 32]); o.w = pk4_fp8(s[12 * 32], s[13 * 32], s[14 * 32], s[15 * 32]);
        __builtin_nontemporal_store(o, (u32x4*)(t.dst + (size_t)(t.drow0 >> 5) * 32768 + (size_t)(t.k0 >> 7) * 4096 + n * 128 + 16 * c)); }
    LDS_WAIT(); asm volatile("" ::: "memory");
}
constexpr int TI_IN = 16 * 96, TI_OUT = 8 * 32, TI_E = 8 * 32, TI_EALL = NE * 3 * TI_E;
constexpr int TSCR = 16384;
template <bool WT = false> __device__ __forceinline__ void transpose_items_bf16(const Frame& F, const Args& a, int gw, int NGW, int it0, int it1) {
    const float* w_in = a.in[10]; const float* w_out = a.in[11];
    LAS float* scr = (LAS float*)(F.lds + F.wave * TSCR);
    for (int it = it0 + gw; it < it1; it += NGW) {
        TItem t; float tv[32];
        if (it < TI_IN) { const int kb = it / 96, nb = it % 96; t = TItem{w_in, F.ws + WS_WIN, NIN, kb * 64, nb * 32, nb * 32}; }
        else { const int r = it - TI_IN, kb = r / 32, nb = r % 32; t = TItem{w_out, F.ws + WS_WOUT, 1024, kb * 64, nb * 32, nb * 32}; }
        titem_load<32>(t, tv, F.lane); titem_finish_bf16<WT>(t, tv, scr, F.lane);
    }
}
__device__ __forceinline__ void transpose_items_fp8(const Frame& F, const Args& a, int gw, int NGW, int k0, int k1) {
    const float* w_gate = a.in[18]; const float* w_up = a.in[20]; const float* w_down = a.in[22];
    unsigned char* WGU = F.ws + WS_WGU; unsigned char* WDN = F.ws + WS_WDN;
    LAS float* scr = (LAS float*)(F.lds + F.wave * TSCR);
    auto decode = [&](int r, TItem& t) {
        const int e = r / (3 * TI_E), r2 = r % (3 * TI_E), mat = r2 / TI_E, r3 = r2 % TI_E, kb = r3 / 32, nb = r3 % 32, n0 = nb * 32;
        if (mat == 2) t = TItem{w_down + (size_t)e * 1048576, WDN + (size_t)e * 1048576, 1024, kb * 128, n0, n0};
        else t = TItem{(mat == 0 ? w_gate : w_up) + (size_t)e * 1048576, WGU + (size_t)e * 2097152, 1024, kb * 128, n0, 256 * (n0 >> 7) + mat * 128 + (n0 & 127)};
    };
    for (int k = k0; k < k1; ++k) { const int it = gw + k * NGW; if (it >= TI_EALL) break;
        TItem t; f32x4 tv[16]; decode(it, t); titem_load_fp8(t, tv, F.lane); titem_finish_fp8(t, tv, scr, F.lane); }
}
__device__ __forceinline__ void p0_prologue(const Frame& F, const Args& a) {
    const float* c = a.in[1]; const float* c_ctx = a.in[3]; const float* w_ada = a.in[4]; const float* b_ada = a.in[5];
    const float* w_out = a.in[11]; const float* pool_w = a.in[14]; const float* pool_scale = a.in[15];
    bf16_t* WOUT = (bf16_t*)(F.ws + WS_WOUT);
    float* mod = (float*)(F.ws + WS_MOD);
    if (F.bid < 192) {
        LAS float* s = (LAS float*)F.lds;
        LAS float* red = (LAS float*)(F.lds + 20480);
        const int kq = F.tid >> 5, col = F.tid & 31, j = F.bid * 32 + col;
        float w[64];
#pragma unroll
        for (int kk = 0; kk < 64; ++kk) w[kk] = __builtin_nontemporal_load(w_ada + (size_t)(kq * 64 + kk) * 6144 + j);
        { float t[10];
#pragma unroll
          for (int q = 0; q < 10; ++q) { const int i = F.tid + q * 512, r = i >> 10, k = i & 1023; t[q] = (r < 4) ? c[r * 1024 + k] : c_ctx[k]; }
#pragma unroll
          for (int q = 0; q < 10; ++q) s[F.tid + q * 512] = t[q] * sigmoidf_(t[q]); }
        __syncthreads();
        float acc[5] = {0.f, 0.f, 0.f, 0.f, 0.f};
#pragma unroll
        for (int kk = 0; kk < 64; ++kk) { const int k = kq * 64 + kk;
#pragma unroll
            for (int r = 0; r < 5; ++r) acc[r] += s[r * 1024 + k] * w[kk]; }
#pragma unroll
        for (int r = 0; r < 5; ++r) red[(kq * 5 + r) * 32 + col] = acc[r];
        __syncthreads();
        if (F.tid < 160) { const int r = F.tid >> 5, cc = F.tid & 31; float t = b_ada[F.bid * 32 + cc];
#pragma unroll
            for (int q = 0; q < 16; ++q) t += red[(q * 5 + r) * 32 + cc];
            __hip_atomic_store(mod + r * 6144 + F.bid * 32 + cc, t, __ATOMIC_RELAXED, __HIP_MEMORY_SCOPE_AGENT); }
        asm volatile("s_waitcnt vmcnt(0)" ::: "memory");
        __syncthreads();
        if (F.tid == 0) __hip_atomic_fetch_add(F.ctl + CW_MOD + 64 * (F.bid & 7), 1u, __ATOMIC_RELAXED, __HIP_MEMORY_SCOPE_AGENT);
    }
    __syncthreads();
    transpose_items_bf16(F, a, F.bid * 8 + F.wave, F.G * 8, 0, TI_IN);
}
__device__ __forceinline__ void p0_late(const Frame& F, const Args& a) {
    const float* w_out = a.in[11]; const float* pool_w = a.in[14]; const float* pool_scale = a.in[15];
    bf16_t* WOUT = (bf16_t*)(F.ws + WS_WOUT);
    if (F.bid >= 128 && F.bid < 256) {
        const int un = F.bid - 128, gi = un >> 5, nb = un & 31;
        LAS float* pw = (LAS float*)F.lds;
        LAS float* wo = (LAS float*)(F.lds + 128 * 129 * 4);
        { float t[32]; const float sc = pool_scale[gi * 128 + (F.tid & 127)];
#pragma unroll
          for (int q = 0; q < 32; ++q) t[q] = pool_w[(size_t)gi * 16384 + F.tid + q * 512];
#pragma unroll
          for (int q = 0; q < 32; ++q) { const int i = F.tid + q * 512; pw[(i >> 7) * 129 + (i & 127)] = t[q] * sc; }
          float u[8];
#pragma unroll
          for (int q = 0; q < 8; ++q) { const int i = F.tid + q * 512; u[q] = w_out[(size_t)(512 + gi * 128 + (i >> 5)) * 1024 + nb * 32 + (i & 31)]; }
#pragma unroll
          for (int q = 0; q < 8; ++q) wo[F.tid + q * 512] = u[q]; }
        __syncthreads();
        const int n = F.tid & 31, cq = F.tid >> 5;
        float acc[8] = {0.f, 0.f, 0.f, 0.f, 0.f, 0.f, 0.f, 0.f};
        for (int j = 0; j < 128; ++j) { const float b = wo[j * 32 + n];
#pragma unroll
            for (int i = 0; i < 8; ++i) acc[i] += pw[(cq * 8 + i) * 129 + j] * b; }
        u32x4 o; o.x = cvt_pk_bf16(acc[0], acc[1]); o.y = cvt_pk_bf16(acc[2], acc[3]); o.z = cvt_pk_bf16(acc[4], acc[5]); o.w = cvt_pk_bf16(acc[6], acc[7]);
        { const unsigned long long ad = (unsigned long long)(WOUT + (size_t)(nb * 32 + n) * 1024 + 512 + gi * 128 + cq * 8);
          asm volatile("global_store_dwordx4 %0, %1, off sc1\n\ts_nop 2" :: "v"(ad), "v"(o) : "memory"); }
        __syncthreads();
    }
    if (F.bid >= 32 && F.bid < 40) {
        const float* w_router = a.in[16]; bf16_t* WRH = (bf16_t*)(F.ws + WS_WRH); bf16_t* WRL = (bf16_t*)(F.ws + WS_WRL);
        for (int i = (F.bid - 32) * 512 + F.tid; i < 32768; i += 8 * 512) { const int k = i >> 5, e = i & 31; const float w = w_router[i];
            const unsigned short hi = f2bf(w);
            __hip_atomic_store(WRH + e * 1024 + k, hi, __ATOMIC_RELAXED, __HIP_MEMORY_SCOPE_AGENT); __hip_atomic_store(WRL + e * 1024 + k, f2bf(w - bf2f(hi)), __ATOMIC_RELAXED, __HIP_MEMORY_SCOPE_AGENT); }
    }
    __syncthreads();
    transpose_items_bf16<true>(F, a, F.bid * 8 + F.wave, F.G * 8, TI_IN, TI_IN + TI_OUT);
    asm volatile("s_waitcnt vmcnt(0)" ::: "memory");
    __syncthreads();
    if (F.tid == 0 && F.G == 256 && (F.bid < 40 || F.bid >= 128)) (void)xb_add(F.ctl + CW_LATE + 64 * (F.bid & 7), 1u);
}

__device__ __forceinline__ void p1_normmod(const Frame& F, const Args& a, unsigned need) {
    const float* x = a.in[0]; const float* ctx = a.in[2]; const float* g = a.in[6];
    const float* mod = (const float*)(F.ws + WS_MOD); bf16_t* HX = (bf16_t*)(F.ws + WS_HX);
    const int gw = F.bid * 8 + F.wave;
    auto rowp = [&](int m) { return (m < M) ? x + (size_t)m * D : ctx + (size_t)(m - M) * D; };
    const int NGW = F.G * 8;
    int m0 = gw * 8;
    f32x4 v[4];
    { const float* xr = rowp(m0);
#pragma unroll
      for (int j = 0; j < 4; ++j) v[j] = __builtin_nontemporal_load((const f32x4*)(xr + F.lane * 4 + 256 * j)); }
    if (F.tid < 64) { unsigned sp = 0;
        for (;;) { const unsigned v = (F.lane < 8) ? __hip_atomic_load(F.ctl + CW_MOD + 64 * (F.lane & 7), __ATOMIC_RELAXED, __HIP_MEMORY_SCOPE_AGENT) : 0u;
            unsigned tot = 0;
#pragma unroll
            for (int j = 0; j < 8; ++j) tot += (unsigned)__builtin_amdgcn_readlane((int)v, j);
            if (tot >= need) break;
            __builtin_amdgcn_s_sleep(2); if (++sp > (1u << 22)) break; }
        __builtin_amdgcn_fence(__ATOMIC_ACQUIRE, "agent"); asm volatile("s_waitcnt vmcnt(0)" ::: "memory"); }
    __syncthreads();
    f32x4 ga[4], hb[4];
    auto ld_par = [&](int mr) { const float* sh = mod + mr * 6144, *sc = sh + 1024;
#pragma unroll
        for (int j = 0; j < 4; ++j) { const int col = F.lane * 4 + 256 * j; ga[j] = *(const f32x4*)(g + col) * (1.0f + *(const f32x4*)(sc + col)); hb[j] = *(const f32x4*)(sh + col); } };
    auto do_row = [&](int m) {
        float s = 0.f;
#pragma unroll
        for (int j = 0; j < 4; ++j) s += (v[j].x * v[j].x + v[j].y * v[j].y) + (v[j].z * v[j].z + v[j].w * v[j].w);
        const float rstd = rsqrtf(wave_sum(s) * (1.f / D) + EPS);
#pragma unroll
        for (int j = 0; j < 4; ++j) { const int col = F.lane * 4 + 256 * j;
            const f32x4 o = v[j] * rstd * ga[j] + hb[j];
            u32x2 w; w.x = cvt_pk_bf16(o.x, o.y); w.y = cvt_pk_bf16(o.z, o.w);
            *(u32x2*)(HX + (size_t)m * D + col) = w; } };
    const bool hasctx = gw < MC;
#pragma unroll 1
    for (; m0 < M; m0 += NGW * 8) {
        const bool lastg = m0 + NGW * 8 >= M;
        ld_par(m0 >> 12);
#pragma unroll 1
        for (int k = 0; k < 8; ++k) {
            const int m = m0 + k, mn = (k < 7) ? m + 1 : (lastg ? (hasctx ? M + gw : m) : m0 + NGW * 8);
            f32x4 vn[4];
            { const float* xr = rowp(mn);
#pragma unroll
              for (int j = 0; j < 4; ++j) vn[j] = __builtin_nontemporal_load((const f32x4*)(xr + F.lane * 4 + 256 * j)); }
            __builtin_amdgcn_sched_barrier(0);
            do_row(m);
            __builtin_amdgcn_sched_barrier(0);
#pragma unroll
            for (int j = 0; j < 4; ++j) v[j] = vn[j];
        }
    }
    for (int c = gw; c < MC; c += NGW) {
        if (c != gw) { const float* xr = rowp(M + c);
#pragma unroll
            for (int j = 0; j < 4; ++j) v[j] = __builtin_nontemporal_load((const f32x4*)(xr + F.lane * 4 + 256 * j)); }
        ld_par(4); do_row(M + c); }
}

constexpr int G_LF = 0, G_QR = 17408, G_V = 34816, G_Q2 = 52224, G_K2 = 69632, G_ATT = 87040, G_ST = 96256, G_RED = LDS_TAB;
static_assert(G_ST + 128 * 272 <= RING_BYTES, "GLA LDS map");
typedef short s16x4 __attribute__((ext_vector_type(4)));
__device__ __forceinline__ f32x16 mfma32(bf16x8 a, bf16x8 b, f32x16 c) { return __builtin_amdgcn_mfma_f32_32x32x16_bf16(a, b, c, 0, 0, 0); }
__device__ __forceinline__ constexpr int crow0(int reg) { return (reg & 3) + 8 * (reg >> 2); }
__device__ __forceinline__ int opq(int x) { asm volatile("" : "+v"(x)); return x; }
__device__ __forceinline__ unsigned opqu(unsigned x) { asm volatile("" : "+v"(x)); return x; }
__device__ __forceinline__ bf16x8 tr_frag(const LAS unsigned char* img, int trb, int ks, int c) {
    const LAS s16x4* p = (const LAS s16x4*)(img + trb + ks * 16 * 272 + c * 64);
    const s16x4 lo = __builtin_amdgcn_ds_read_tr16_b64_v4i16((LAS s16x4*)p), hi = __builtin_amdgcn_ds_read_tr16_b64_v4i16((LAS s16x4*)(p + 4 * 272 / 8));
    return __builtin_shufflevector(lo, hi, 0, 1, 2, 3, 4, 5, 6, 7);
}
template <int MODE> __device__ __forceinline__ bf16x8 cfrag(int d) {
    u32x4 w;
#pragma unroll
    for (int i = 0; i < 4; ++i) {
        const bool lo = MODE == 0 ? (2 * i <= d) : MODE == 1 ? (2 * i >= d) : MODE == 2 ? (2 * i == d) : true;
        const bool hi = MODE == 0 ? (2 * i + 1 <= d) : MODE == 1 ? (2 * i + 1 >= d) : MODE == 2 ? (2 * i + 1 == d) : true;
        w[i] = (lo ? 0x3F80u : 0u) | (hi ? 0x3F800000u : 0u);
    }
    return __builtin_bit_cast(bf16x8, w);
}
struct RawRegs { u32x4 lf[2], v[2], q[2]; };
template <int DIR, bool WITH_Q>
__device__ __forceinline__ void gla_load_raw(const Frame& F, const bf16_t* P, int row0, int head, RawRegs& R) {
    const bf16_t* rp = P + (size_t)(row0 + (F.tid >> 3)) * NIN + head * 128 + (F.tid & 7) * 16;
    R.lf[0] = *(const u32x4*)(rp + 512 + DIR * 512); R.lf[1] = *(const u32x4*)(rp + 512 + DIR * 512 + 8);
    R.v[0] = *(const u32x4*)(rp + 1536); R.v[1] = *(const u32x4*)(rp + 1536 + 8);
    if (WITH_Q) { R.q[0] = *(const u32x4*)rp; R.q[1] = *(const u32x4*)(rp + 8); }
}
template <bool WITH_Q>
__device__ __forceinline__ void gla_store_raw(const Frame& F, const RawRegs& R) {
    const int o = (F.tid >> 3) * 272 + (F.tid & 7) * 32;
    *(LAS u32x4*)(F.lds + G_LF + o) = R.lf[0]; *(LAS u32x4*)(F.lds + G_LF + o + 16) = R.lf[1];
    *(LAS u32x4*)(F.lds + G_V + o) = R.v[0]; *(LAS u32x4*)(F.lds + G_V + o + 16) = R.v[1];
    if (WITH_Q) { *(LAS u32x4*)(F.lds + G_QR + o) = R.q[0]; *(LAS u32x4*)(F.lds + G_QR + o + 16) = R.q[1]; }
}
template <int DIR, bool WITH_Q>
__device__ __forceinline__ void gla_stage1(const Frame& F, int trb, float (&eh)[16], float* tsum) {
    const int cb = F.wave >> 1, tb = F.wave & 1, l31 = F.lane & 31, lh = F.lane >> 5;
    f32x16 b, T;
#pragma unroll
    for (int r = 0; r < 16; ++r) { b[r] = 0.f; T[r] = 0.f; }
    const u32x4 ones4 = {0x3F803F80u, 0x3F803F80u, 0x3F803F80u, 0x3F803F80u};
#pragma unroll
    for (int ks = 0; ks < 4; ++ks) {
        const int dd = 32 * tb + l31 - 16 * ks - 8 * lh;
        const bf16x8 alf = tr_frag(F.lds + G_LF, trb, ks, cb);
        T = mfma32(alf, __builtin_bit_cast(bf16x8, ones4), T);
        if (DIR ? (tb == 0 || ks >= 2) : (tb == 1 || ks < 2)) b = mfma32(alf, cfrag<DIR>(dd), b);
    }
    const int wb = opq((32 * tb + l31) * 272 + (32 * cb + 4 * lh) * 2);
    typedef float f32x2 __attribute__((ext_vector_type(2)));
    u32x2 lfw[4], qw[4];
#pragma unroll
    for (int g = 0; g < 4; ++g) { lfw[g] = *(const LAS u32x2*)(F.lds + G_LF + wb + g * 16); if (WITH_Q) qw[g] = *(const LAS u32x2*)(F.lds + G_QR + wb + g * 16); }
#pragma unroll
    for (int g = 0; g < 4; ++g) {
        f32x2 k2[2], q2[2];
#pragma unroll
        for (int h = 0; h < 2; ++h) {
            const int r = 4 * g + 2 * h;
            const unsigned lw = h ? lfw[g].y : lfw[g].x;
            const f32x2 lf = {bflo(lw), bfhi(lw)}, Tv = {T[r], T[r + 1]}, bv = {b[r], b[r + 1]};
            const f32x2 mm = Tv * 0.5f, d = mm - bv;
            eh[r] = __builtin_amdgcn_exp2f(mm.x); eh[r + 1] = __builtin_amdgcn_exp2f(mm.y);
            if (tsum) { tsum[r] += Tv.x; tsum[r + 1] += Tv.y; }
            f32x2 ef, ek; ef.x = __builtin_amdgcn_exp2f(lf.x); ef.y = __builtin_amdgcn_exp2f(lf.y); ek.x = __builtin_amdgcn_exp2f(d.x); ek.y = __builtin_amdgcn_exp2f(d.y);
            k2[h] = (1.0f - ef) * ek;
            q2[h] = (f32x2){0.f, 0.f};
            if (WITH_Q) { const unsigned qq = h ? qw[g].y : qw[g].x; const f32x2 q = {bflo(qq), bfhi(qq)}, nd = bv - mm;
                f32x2 eq; eq.x = __builtin_amdgcn_exp2f(nd.x); eq.y = __builtin_amdgcn_exp2f(nd.y); q2[h] = q * eq; }
        }
        u32x2 w; w.x = cvt_pk_bf16(k2[0].x, k2[0].y); w.y = cvt_pk_bf16(k2[1].x, k2[1].y);
        *(LAS u32x2*)(F.lds + G_K2 + wb + g * 16) = w;
        if (WITH_Q) { w.x = cvt_pk_bf16(q2[0].x, q2[0].y); w.y = cvt_pk_bf16(q2[1].x, q2[1].y); *(LAS u32x2*)(F.lds + G_Q2 + wb + g * 16) = w; }
    }
}
__device__ __forceinline__ void gla_state_mma(const Frame& F, int trb, f32x16& s0, f32x16& s1) {
    const int kb = F.wave >> 1, vb = (F.wave & 1) * 2;
#pragma unroll
    for (int ks = 0; ks < 4; ++ks) {
        const bf16x8 a = tr_frag(F.lds + G_K2, trb, ks, kb);
        const bf16x8 b0 = tr_frag(F.lds + G_V, trb, ks, vb), b1 = tr_frag(F.lds + G_V, trb, ks, vb + 1);
        s0 = mfma32(a, b0, s0); s1 = mfma32(a, b1, s1);
    }
}

template <int DIR>
__device__ __forceinline__ void gla_passA_unit(const Frame& F, const bf16_t* P, int b, int h, int blk, bf16_t* dS, float* DD) {
    const int xb = DIR ? (16 - blk) : (blk - 1);
    const int rowb = (blk == 0) ? (M + b * CTXL) : (b * SEQ + xb * 256);
    const int l31 = F.lane & 31, lh = F.lane >> 5;
    const int trb = (8 * lh + ((F.lane & 15) >> 2)) * 272 + (16 * ((F.lane >> 4) & 1) + 4 * (F.lane & 3)) * 2;
    f32x16 s0, s1;
#pragma unroll
    for (int r = 0; r < 16; ++r) { s0[r] = 0.f; s1[r] = 0.f; }
    float tsum[16], eh[16];
#pragma unroll
    for (int i = 0; i < 16; ++i) tsum[i] = 0.f;
    RawRegs R;
    gla_load_raw<DIR, false>(F, P, rowb + (DIR ? 3 : 0) * 64, h, R);
#pragma unroll 1
    for (int ci = 0; ci < 4; ++ci) {
        LSYNC();
        gla_store_raw<false>(F, R);
        if (ci < 3) gla_load_raw<DIR, false>(F, P, rowb + (DIR ? (2 - ci) : (ci + 1)) * 64, h, R);
        LSYNC();
        gla_stage1<DIR, false>(F, trb, eh, tsum);
        LSYNC();
#pragma unroll
        for (int r = 0; r < 16; ++r) { s0[r] *= eh[r]; s1[r] *= eh[r]; }
        gla_state_mma(F, trb, s0, s1);
#pragma unroll
        for (int r = 0; r < 16; ++r) { s0[r] *= eh[r]; s1[r] *= eh[r]; }
    }
    const int kb = F.wave >> 1, vb = (F.wave & 1) * 2;
    const unsigned sb = opqu((unsigned)((32 * kb + 4 * lh) * 128 + 32 * vb + l31));
#pragma unroll
    for (int r = 0; r < 16; ++r) { dS[sb + crow0(r) * 128] = f2bf(s0[r]); dS[sb + 32 + crow0(r) * 128] = f2bf(s1[r]); }
    if ((F.wave & 1) == 0 && l31 == 0) {
#pragma unroll
        for (int r = 0; r < 16; ++r) DD[32 * kb + 4 * lh + crow0(r)] = __builtin_amdgcn_exp2f(tsum[r]);
    }
}

template <int W, class Get, class Emit> __device__ __forceinline__ void win_mean64(const Get& get, const Emit& emit) {
    float s = 0.f;
#pragma unroll
    for (int q = 0; q < W - W / 2; ++q) s += get(q);
#pragma unroll
    for (int r = 0; r < 64; ++r) {
        const int lo = (r - W / 2) < 0 ? 0 : (r - W / 2), hi = (r - W / 2 + W) > 64 ? 64 : (r - W / 2 + W);
        emit(r, s * (1.0f / (float)(hi - lo)));
        if (r + 1 < 64) { if (r + 1 - W / 2 + W <= 64) s += get(r - W / 2 + W); if (r + 1 - W / 2 > 0) s -= get(r - W / 2); }
    }
}
template <int W>
__device__ __forceinline__ void pool_unit(const Frame& F, const bf16_t* __restrict__ U, bf16_t* __restrict__ A2, int b, int slab) {
    LAS float* vm = (LAS float*)F.lds;
    const int ch = F.tid & 7, cc = F.tid >> 3;
    const bf16_t* Us = U + (size_t)(b * 64 + slab) * 4096 * 8;
    {
        unsigned short v[64];
        const unsigned pb = opqu((unsigned)(cc * 8 + ch));
#pragma unroll
        for (int r = 0; r < 64; ++r) v[r] = Us[pb + (unsigned)(r * 64 * 8)];
        const int vb = opq((cc * 8 + ch) * 4);
        win_mean64<W>([&](int q) { return bf2f(v[q]); }, [&](int r, float mean) { *(LAS float*)(F.lds + vb + r * 2080) = mean; });
    }
    __syncthreads();
    {
        const int rr = F.tid >> 3;
        unsigned short uu[64];
        const unsigned pb = opqu((unsigned)(rr * 64 * 8 + ch));
#pragma unroll
        for (int c = 0; c < 64; ++c) uu[c] = Us[pb + (unsigned)(c * 8)];
        const int vb = opq((rr * 520 + ch) * 4);
        const unsigned ab = opqu((unsigned)((b * SEQ + rr * 64) * D + 512 + slab * 8 + ch));
        win_mean64<W>([&](int q) { return *(const LAS float*)(F.lds + vb + q * 32); },
                      [&](int c, float mean) { A2[ab + (unsigned)(c * D)] = f2bf(mean - bf2f(uu[c])); });
    }
    __syncthreads();
}

__device__ __forceinline__ void p4_scan(const Frame& F) {
    bf16_t* ST = (bf16_t*)(F.ws + WS_ST); const float* DDp = (const float*)(F.ws + WS_DD);
    const int gt = F.bid * 512 + F.tid, NT = F.G * 512;
    for (int i = gt; i < 32 * 4096; i += NT) {
        const int seq = i >> 12, e4 = i & 4095, k = e4 >> 5;
        float S[4];
#pragma unroll
        for (int j = 0; j < 4; ++j) S[j] = 0.f;
        u32x2 d[NBLK]; float dec[NBLK];
#pragma unroll
        for (int blk = 0; blk < NBLK; ++blk) { d[blk] = *(const u32x2*)(ST + ((size_t)(seq * NBLK + blk) * 16384) + e4 * 4); dec[blk] = DDp[(seq * NBLK + blk) * 128 + k]; }
#pragma unroll
        for (int blk = 0; blk < NBLK; ++blk) {
            u32x2 o; o.x = cvt_pk_bf16(S[0], S[1]); o.y = cvt_pk_bf16(S[2], S[3]);
            *(u32x2*)(ST + ((size_t)(seq * NBLK + blk) * 16384) + e4 * 4) = o;
            S[0] = S[0] * dec[blk] + bflo(d[blk].x); S[1] = S[1] * dec[blk] + bfhi(d[blk].x); S[2] = S[2] * dec[blk] + bflo(d[blk].y); S[3] = S[3] * dec[blk] + bfhi(d[blk].y);
        }
    }
}

__device__ __forceinline__ float row16_sum(float x) {
    int v;
    v = __builtin_amdgcn_mov_dpp(__float_as_int(x), 0x128, 0xf, 0xf, false); x += __int_as_float(v);
    v = __builtin_amdgcn_mov_dpp(__float_as_int(x), 0x124, 0xf, 0xf, false); x += __int_as_float(v);
    v = __builtin_amdgcn_mov_dpp(__float_as_int(x), 0x122, 0xf, 0xf, false); x += __int_as_float(v);
    v = __builtin_amdgcn_mov_dpp(__float_as_int(x), 0x121, 0xf, 0xf, false); x += __int_as_float(v);
    return x;
}
template <int DIR>
__device__ __forceinline__ void gla_passC_dir(const Frame& F, const bf16_t* P, int b, int h, int xb, const bf16_t* ST, bf16_t* OF, bf16_t* A2, const float* gain) {
    const int blk = DIR ? (16 - xb) : (xb + 1);
    const int seq = b * 8 + h * 2 + DIR;
    const bf16_t* S0 = ST + (size_t)(seq * NBLK + blk) * 16384;
    const int kb = F.wave >> 1, vb = (F.wave & 1) * 2, l31 = F.lane & 31, lh = F.lane >> 5;
    const int trb = (8 * lh + ((F.lane & 15) >> 2)) * 272 + (16 * ((F.lane >> 4) & 1) + 4 * (F.lane & 3)) * 2;
    f32x16 s0, s1;
    const unsigned sb = opqu((unsigned)((32 * kb + 4 * lh) * 128 + 32 * vb + l31));
#pragma unroll
    for (int r = 0; r < 16; ++r) { s0[r] = bf2f(S0[sb + crow0(r) * 128]); s1[r] = bf2f(S0[sb + 32 + crow0(r) * 128]); }
    const int rowb = b * SEQ + xb * 256;
    const int omt = F.wave >> 2, ont = F.wave & 3;
    LAS float* red = (LAS float*)(F.lds + G_RED);
    RawRegs R;
    gla_load_raw<DIR, true>(F, P, rowb + (DIR ? 3 : 0) * 64, h, R);
    LSYNC();
    gla_store_raw<true>(F, R);
#pragma unroll 1
    for (int ci = 0; ci < 4; ++ci) {
        const int c = DIR ? (3 - ci) : ci;
        float eh[16];
        if (ci < 3) gla_load_raw<DIR, true>(F, P, rowb + (DIR ? (2 - ci) : (ci + 1)) * 64, h, R);
        f32x16 o;
        const unsigned trow = (unsigned)(rowb + c * 64 + 32 * omt + l31);
        const unsigned ob = opqu(trow * 512u + (unsigned)(h * 128 + 32 * ont + 4 * lh));
        u32x2 gg[4];
        if (DIR) {
            const unsigned pb = opqu(trow * (unsigned)NIN + (unsigned)(2048 + h * 128 + 32 * ont + 4 * lh));
#pragma unroll
            for (int g = 0; g < 4; ++g) { const u32x2 t4 = *(const u32x2*)(OF + ob + g * 8); o[4 * g] = bflo(t4.x); o[4 * g + 1] = bfhi(t4.x); o[4 * g + 2] = bflo(t4.y); o[4 * g + 3] = bfhi(t4.y); gg[g] = *(const u32x2*)(P + pb + g * 8); }
        } else {
#pragma unroll
            for (int r = 0; r < 16; ++r) o[r] = 0.f;
        }
        LSYNC();
        gla_stage1<DIR, true>(F, trb, eh, nullptr);
        LSYNC();
#pragma unroll
        for (int r = 0; r < 16; ++r) { s0[r] *= eh[r]; s1[r] *= eh[r]; }
        {
            const int stb = opq(G_ST + (32 * vb + l31) * 272 + (32 * kb + 4 * lh) * 2);
#pragma unroll
            for (int g = 0; g < 4; ++g) {
                u32x2 w; w.x = cvt_pk_bf16(s0[4 * g], s0[4 * g + 1]); w.y = cvt_pk_bf16(s0[4 * g + 2], s0[4 * g + 3]);
                *(LAS u32x2*)(F.lds + stb + g * 16) = w;
                w.x = cvt_pk_bf16(s1[4 * g], s1[4 * g + 1]); w.y = cvt_pk_bf16(s1[4 * g + 2], s1[4 * g + 3]);
                *(LAS u32x2*)(F.lds + stb + 32 * 272 + g * 16) = w;
            }
        }
        if (F.wave < 4) {
            const int asb = F.wave >> 1, atb = F.wave & 1;
            f32x16 at, at2;
#pragma unroll
            for (int r = 0; r < 16; ++r) { at[r] = 0.f; at2[r] = 0.f; }
            const int ka = opq(G_K2 + (32 * asb + l31) * 272 + 16 * lh), qa = opq(G_Q2 + (32 * atb + l31) * 272 + 16 * lh);
#pragma unroll
            for (int ks = 0; ks < 8; ks += 2) {
                const bf16x8 a = *(const LAS bf16x8*)(F.lds + ka + ks * 32), a2 = *(const LAS bf16x8*)(F.lds + ka + ks * 32 + 32);
                const bf16x8 bb = *(const LAS bf16x8*)(F.lds + qa + ks * 32), bb2 = *(const LAS bf16x8*)(F.lds + qa + ks * 32 + 32);
                at = mfma32(a, bb, at); at2 = mfma32(a2, bb2, at2);
            }
#pragma unroll
            for (int r = 0; r < 16; ++r) at[r] += at2[r];
            const int dts = opq((32 * atb + l31) - (32 * asb + 4 * lh));
            float am[16];
#pragma unroll
            for (int r = 0; r < 16; ++r) { const bool keep = DIR ? (crow0(r) >= dts) : (crow0(r) <= dts); am[r] = keep ? at[r] : 0.f; }
            const int ab = opq(G_ATT + (32 * atb + l31) * 144 + (32 * asb + 4 * lh) * 2);
#pragma unroll
            for (int g = 0; g < 4; ++g) { u32x2 w; w.x = cvt_pk_bf16(am[4 * g], am[4 * g + 1]); w.y = cvt_pk_bf16(am[4 * g + 2], am[4 * g + 3]); *(LAS u32x2*)(F.lds + ab + g * 16) = w; }
        }
        LSYNC();
        {
            const int qa = opq(G_Q2 + (32 * omt + l31) * 272 + 16 * lh), sa = opq(G_ST + (32 * ont + l31) * 272 + 16 * lh), aa = opq(G_ATT + (32 * omt + l31) * 144 + 16 * lh);
            f32x16 o2;
#pragma unroll
            for (int r = 0; r < 16; ++r) o2[r] = 0.f;
#pragma unroll
            for (int ks = 0; ks < 8; ++ks) {
                const bf16x8 a = *(const LAS bf16x8*)(F.lds + sa + ks * 32);
                const bf16x8 bb = *(const LAS bf16x8*)(F.lds + qa + ks * 32);
                if (ks & 1) o2 = mfma32(a, bb, o2); else o = mfma32(a, bb, o);
            }
#pragma unroll
            for (int ks = 0; ks < 4; ++ks) {
                const bf16x8 a = tr_frag(F.lds + G_V, trb, ks, ont);
                const bf16x8 bb = *(const LAS bf16x8*)(F.lds + aa + ks * 32);
                if (ks & 1) o2 = mfma32(a, bb, o2); else o = mfma32(a, bb, o);
            }
#pragma unroll
            for (int r = 0; r < 16; ++r) o[r] += o2[r];
        }
        gla_state_mma(F, trb, s0, s1);
#pragma unroll
        for (int r = 0; r < 16; ++r) { s0[r] *= eh[r]; s1[r] *= eh[r]; }
        if (DIR == 0) {
#pragma unroll
            for (int g = 0; g < 4; ++g) { u32x2 w; w.x = cvt_pk_bf16(o[4 * g], o[4 * g + 1]); w.y = cvt_pk_bf16(o[4 * g + 2], o[4 * g + 3]); *(u32x2*)(OF + ob + g * 8) = w; }
        } else {
            float sq = 0.f;
#pragma unroll
            for (int r = 0; r < 16; ++r) sq += o[r] * o[r];
            sq += __shfl_xor(sq, 32);
            if (lh == 0) red[(32 * omt + l31) * 4 + ont] = sq;
            LSYNC();
            const f32x4 q4 = *(const LAS f32x4*)(red + (32 * omt + l31) * 4);
            const float rstd = rsqrtf(((q4.x + q4.y) + (q4.z + q4.w)) * (1.0f / 128.0f) + EPS);
            const unsigned a2b = opqu(trow * (unsigned)D + (unsigned)(h * 128 + 32 * ont + 4 * lh));
#pragma unroll
            for (int g = 0; g < 4; ++g) {
                u32x2 w; w.x = cvt_pk_bf16(o[4 * g] * rstd * bflo(gg[g].x), o[4 * g + 1] * rstd * bfhi(gg[g].x));
                w.y = cvt_pk_bf16(o[4 * g + 2] * rstd * bflo(gg[g].y), o[4 * g + 3] * rstd * bfhi(gg[g].y));
                *(u32x2*)(A2 + a2b + g * 8) = w; }
        }
        if (ci < 3) { LSYNC();
            gla_store_raw<true>(F, R); }
    }
}
__device__ __forceinline__ void gla_passC_unit(const Frame& F, const Args& a, int b, int h, int xb) {
    const bf16_t* P = (const bf16_t*)(F.ws + WS_P); const bf16_t* ST = (const bf16_t*)(F.ws + WS_ST); bf16_t* A2 = (bf16_t*)(F.ws + WS_A2);
    bf16_t* OF = (bf16_t*)(F.ws + WS_YX);
    gla_passC_dir<0>(F, P, b, h, xb, ST, OF, A2, a.in[13]);
    gla_passC_dir<1>(F, P, b, h, xb, ST, OF, A2, a.in[13]);
}

__device__ __forceinline__ void p7_rows(const Frame& F, const Args& a, const XcdBarrier& bar, int pending) {
    const float* x = a.in[0]; const float* gpm = a.in[7]; const float* gpf = a.in[8]; const float* b_router = a.in[17];
    const float* mod = (const float*)(F.ws + WS_MOD); const bf16_t* YX = (const bf16_t*)(F.ws + WS_YXB);
    const bf16_t* WRH = (const bf16_t*)(F.ws + WS_WRH); const bf16_t* WRL = (const bf16_t*)(F.ws + WS_WRL);
    unsigned char* HX2F = F.ws + WS_HX2F; int* PE = (int*)(F.ws + WS_PE); int* PSLOT = (int*)(F.ws + WS_PSLOT); float* PW = (float*)(F.ws + WS_PW);
    int* RTOK = (int*)(F.ws + WS_RTOK); unsigned* cnt = F.ctl + CW_CNT;
    LAS float* part = (LAS float*)F.lds;
    LAS float* logit = (LAS float*)(F.lds + 65536);
    LAS int* lcnt = (LAS int*)(F.lds + LDS_TAB);
    const int l31 = F.lane & 31, lh = F.lane >> 5;
    for (int g = F.bid; g < M / 64; g += F.G) {
        const int base = (F.G == 256) ? ((8 * (g & 7) + ((g >> 3) & 7)) * 256 + (g >> 6) * 64) : g * 64;
        if (F.tid < 64) lcnt[F.tid] = 0;
        f32x4 cgt[4], e2[4], f2[4];
        { const float* mrow = mod + (base >> 12) * 6144;
#pragma unroll
          for (int j = 0; j < 4; ++j) { const int col = F.lane * 4 + 256 * j; cgt[j] = *(const f32x4*)(mrow + 2048 + col) * *(const f32x4*)(gpm + col);
              e2[j] = *(const f32x4*)(gpf + col) * (1.0f + *(const f32x4*)(mrow + 4096 + col)); f2[j] = *(const f32x4*)(mrow + 3072 + col); } }
        u32x2 yw[4]; f32x4 xx[4];
        { const int m0 = base + F.wave * 8;
#pragma unroll
          for (int j = 0; j < 4; ++j) { const int col = F.lane * 4 + 256 * j; xx[j] = __builtin_nontemporal_load((const f32x4*)(x + (size_t)m0 * D + col)); }
          if (pending == 1 && g == F.bid) xcd_wait(bar);
          if (pending == 2 && g == F.bid) {
              if (F.tid == 0) { unsigned* g6 = F.ctl + CW_G6 + 64 * (8 * (F.bid & 7) + ((F.bid >> 3) & 7)); unsigned sp = 0;
                  while (xb_ld(g6) < 4u) { __builtin_amdgcn_s_sleep(1); if (++sp > (1u << 22)) break; }
                  __builtin_amdgcn_fence(__ATOMIC_ACQUIRE, "agent"); asm volatile("s_waitcnt vmcnt(0)" ::: "memory"); }
              __syncthreads(); }
#pragma unroll
          for (int j = 0; j < 4; ++j) { const int col = F.lane * 4 + 256 * j; yw[j] = __builtin_nontemporal_load((const u32x2*)(YX + (size_t)m0 * D + col)); } }
#pragma unroll 1
        for (int r = 0; r < 8; ++r) {
            const int m = base + F.wave * 8 + r, mn = base + F.wave * 8 + (r < 7 ? r + 1 : r);
            u32x2 ywn[4]; f32x4 xn[4];
#pragma unroll
            for (int j = 0; j < 4; ++j) { const int col = F.lane * 4 + 256 * j; ywn[j] = __builtin_nontemporal_load((const u32x2*)(YX + (size_t)mn * D + col)); xn[j] = __builtin_nontemporal_load((const f32x4*)(x + (size_t)mn * D + col)); }
            __builtin_amdgcn_sched_barrier(0);
            f32x4 y[4]; float s = 0.f;
#pragma unroll
            for (int j = 0; j < 4; ++j) { y[j] = (f32x4){bflo(yw[j].x), bfhi(yw[j].x), bflo(yw[j].y), bfhi(yw[j].y)};
                s += (y[j].x * y[j].x + y[j].y * y[j].y) + (y[j].z * y[j].z + y[j].w * y[j].w); }
            const float rstd = rsqrtf(wave_sum(s) * (1.f / D) + EPS);
            float s2 = 0.f;
#pragma unroll
            for (int j = 0; j < 4; ++j) { const int col = F.lane * 4 + 256 * j;
                xx[j] = xx[j] + cgt[j] * (y[j] * rstd);
                { u32x2 w1; w1.x = cvt_pk_bf16(xx[j].x, xx[j].y); w1.y = cvt_pk_bf16(xx[j].z, xx[j].w); __builtin_nontemporal_store(w1, (u32x2*)(x1b_row(F.ws, m) + col)); }
                s2 += (xx[j].x * xx[j].x + xx[j].y * xx[j].y) + (xx[j].z * xx[j].z + xx[j].w * xx[j].w); }
            const float rstd2 = rsqrtf(wave_sum(s2) * (1.f / D) + EPS);
#pragma unroll
            for (int j = 0; j < 4; ++j) { const int col = F.lane * 4 + 256 * j;
                const f32x4 hh = xx[j] * rstd2 * e2[j] + f2[j];
                u32x2 w; w.x = cvt_pk_bf16(hh.x, hh.y); w.y = cvt_pk_bf16(hh.z, hh.w);
                const int lr = F.wave * 8 + r;
                *(LAS u32x2*)(F.lds + lr * 2048 + ((((F.lane >> 1) + 32 * j) ^ (lr & 15)) * 16) + (F.lane & 1) * 8) = w;
                *(unsigned*)(HX2F + (size_t)m * D + col) = pk4_fp8(hh.x, hh.y, hh.z, hh.w); }
            __builtin_amdgcn_sched_barrier(0);
#pragma unroll
            for (int j = 0; j < 4; ++j) { yw[j] = ywn[j]; xx[j] = xn[j]; }
        }
        bf16x8 bh[8], bl[8];
#pragma unroll
        for (int ks = 0; ks < 8; ++ks) { const int k0 = 128 * F.wave + 16 * ks + 8 * lh; bh[ks] = *(const bf16x8*)(WRH + l31 * 1024 + k0); bl[ks] = *(const bf16x8*)(WRL + l31 * 1024 + k0); }
        __syncthreads();
        {
            f32x16 acc0, acc1;
#pragma unroll
            for (int r = 0; r < 16; ++r) { acc0[r] = 0.f; acc1[r] = 0.f; }
#pragma unroll
            for (int ks = 0; ks < 8; ++ks) {
                const int ch = ((16 * F.wave + 2 * ks + lh) ^ (l31 & 15)) * 16;
                const bf16x8 a0 = *(const LAS bf16x8*)(F.lds + l31 * 2048 + ch), a1 = *(const LAS bf16x8*)(F.lds + (32 + l31) * 2048 + ch);
                acc0 = mfma32(a0, bh[ks], acc0); acc0 = mfma32(a0, bl[ks], acc0); acc1 = mfma32(a1, bh[ks], acc1); acc1 = mfma32(a1, bl[ks], acc1);
            }
            const int pb = opq((F.wave * 64 + 4 * lh) * 32 + l31);
            __syncthreads();
#pragma unroll
            for (int r = 0; r < 16; ++r) { part[pb + crow0(r) * 32] = acc0[r]; part[pb + (32 + crow0(r)) * 32] = acc1[r]; }
        }
        __syncthreads();
        { f32x4 t = *(const f32x4*)(b_router + ((F.tid * 4) & 31));
#pragma unroll
          for (int w = 0; w < 8; ++w) t += *(const LAS f32x4*)(part + w * 2048 + F.tid * 4);
          *(LAS f32x4*)(logit + F.tid * 4) = t; }
        __syncthreads();
#pragma unroll 1
        for (int r = 0; r < 8; ++r) {
            const int m = base + F.wave * 8 + r;
            float v = (F.lane < 32) ? logit[(F.wave * 8 + r) * 32 + l31] : -3.0e38f; float tv[4]; int ti[4];
#pragma unroll
            for (int k = 0; k < 4; ++k) {
                const float mx = wave_max(v);
                const unsigned long long bal = __ballot(v == mx);
                int idx = __ffsll((long long)bal) - 1; idx = idx < 0 ? 0 : (idx > 31 ? 31 : idx);
                tv[k] = mx; ti[k] = idx;
                if (F.lane == idx) v = -3.0e38f;
            }
            const float e1 = __expf(tv[1] - tv[0]), e2 = __expf(tv[2] - tv[0]), e3 = __expf(tv[3] - tv[0]);
            const float inv = 1.0f / (1.0f + e1 + e2 + e3);
            if (F.lane < 4) {
                const int e = F.lane == 0 ? ti[0] : F.lane == 1 ? ti[1] : F.lane == 2 ? ti[2] : ti[3];
                const float w = (F.lane == 0 ? 1.0f : F.lane == 1 ? e1 : F.lane == 2 ? e2 : e3) * inv;
                const int lrank = __hip_atomic_fetch_add(lcnt + e, 1, __ATOMIC_RELAXED, __HIP_MEMORY_SCOPE_WORKGROUP);
                PE[m * 4 + F.lane] = e; PSLOT[m * 4 + F.lane] = lrank; PW[m * 4 + F.lane] = w;
            }
        }
        __syncthreads();
        if (F.tid < 32) { const int c = lcnt[F.tid]; lcnt[32 + F.tid] = c ? (int)__hip_atomic_fetch_add(cnt + 64 * F.tid, (unsigned)c, __ATOMIC_RELAXED, __HIP_MEMORY_SCOPE_AGENT) : 0; }
        __syncthreads();
        if (F.tid < 256) { const int m = base + (F.tid >> 2), k = F.tid & 3; const int e = PE[m * 4 + k]; const int slot = lcnt[32 + e] + PSLOT[m * 4 + k];
            PSLOT[m * 4 + k] = slot; RTOK[e * ECAP + slot] = m * 1024; }
        __syncthreads();
    }
}

__device__ __forceinline__ void moe_tables(const Frame& F) {
    LAS int* tab = (LAS int*)(F.lds + LDS_TAB);
    __syncthreads();
    if (F.tid < 64) {
        const int c = (F.lane < 32) ? (int)__hip_atomic_load(F.ctl + CW_CNT + 64 * (F.lane & 31), __ATOMIC_RELAXED, __HIP_MEMORY_SCOPE_AGENT) : 0;
        const int padded = ((c + 255) >> 8) * 256;
        int incl = padded;
#pragma unroll
        for (int o = 1; o < 32; o <<= 1) { const int t = __shfl_up(incl, o); if (F.lane >= o) incl += t; }
        if (F.lane < 32) { tab[F.lane] = c; tab[32 + F.lane] = incl - padded; }
        if (F.lane == 31) tab[64] = incl >> 8;
    }
    __syncthreads();
}

__device__ __forceinline__ void p10_final(const Frame& F, const Args& a, const XcdBarrier& bar, bool pending) {
    const float* gpo = a.in[9]; const float* mod = (const float*)(F.ws + WS_MOD);
    const unsigned char* YB = F.ws + WS_YB; const int* PE = (const int*)(F.ws + WS_PE); const int* PSLOT = (const int*)(F.ws + WS_PSLOT); const float* PW = (const float*)(F.ws + WS_PW);
    const LAS int* tab = (const LAS int*)(F.lds + LDS_TAB);
    const int gw = F.bid * 8 + F.wave;
    struct Rec { int e[4], s[4]; float w[4]; };
    auto ld_rec = [&](int m, Rec& r) {
#pragma unroll
        for (int k = 0; k < 4; ++k) { r.e[k] = PE[m * 4 + k]; r.s[k] = PSLOT[m * 4 + k]; r.w[k] = PW[m * 4 + k]; } };
    auto ld_x = [&](int m, u32x2 (&xw)[4]) {
#pragma unroll
        for (int j = 0; j < 4; ++j) xw[j] = __builtin_nontemporal_load((const u32x2*)(x1b_row(F.ws, m) + F.lane * 4 + 256 * j)); };
    auto ld_y = [&](const Rec& r, int (&yv)[16]) {
#pragma unroll
        for (int k = 0; k < 4; ++k) { const unsigned char* yr = YB + (size_t)(tab[32 + r.e[k]] + r.s[k]) * D + F.lane * 4;
#pragma unroll
            for (int j = 0; j < 4; ++j) yv[k * 4 + j] = __builtin_nontemporal_load((const int*)(yr + 256 * j)); } };
    auto ld_row = [&](int m, const Rec& r, int (&yv)[16], u32x2 (&xw)[4]) { ld_y(r, yv); ld_x(m, xw); };
#pragma unroll 1
    for (int g8 = gw; g8 < M / 8; g8 += F.G * 8) {
    const int mbeg = g8 * 8, mend = mbeg + 7;
    int m = mbeg;
    Rec r0, r1; int yv[16]; u32x2 xw[4];
    f32x4 ggt[4];
    { const float* mrow = mod + (mbeg >> 12) * 6144;
#pragma unroll
      for (int j = 0; j < 4; ++j) { const int col = F.lane * 4 + 256 * j; ggt[j] = *(const f32x4*)(gpo + col) * *(const f32x4*)(mrow + 5120 + col); } }
    ld_rec(m, r0);
    ld_rec(m + 1, r1);
    ld_x(m, xw);
    if (pending && g8 == gw) xcd_wait(bar);
    ld_y(r0, yv);
#pragma unroll 1
    for (; m <= mend; ++m) {
        const int m1 = m + 1 <= mend ? m + 1 : m, m2 = m1 + 1 <= mend ? m1 + 1 : m1;
        Rec r2; ld_rec(m2, r2);
        int yn[16]; u32x2 xn[4];
        ld_row(m1, r1, yn, xn);
        __builtin_amdgcn_sched_barrier(0);
        f32x4 y[4];
#pragma unroll
        for (int j = 0; j < 4; ++j) y[j] = (f32x4){0.f, 0.f, 0.f, 0.f};
#pragma unroll
        for (int k = 0; k < 4; ++k) { const float w = r0.w[k];
#pragma unroll
            for (int j = 0; j < 4; ++j) { const int v = yv[k * 4 + j];
                const auto lo = __builtin_amdgcn_cvt_pk_f32_fp8(v, false), hi = __builtin_amdgcn_cvt_pk_f32_fp8(v, true);
                y[j].x += w * lo[0]; y[j].y += w * lo[1]; y[j].z += w * hi[0]; y[j].w += w * hi[1]; } }
        float s = 0.f;
#pragma unroll
        for (int j = 0; j < 4; ++j) s += (y[j].x * y[j].x + y[j].y * y[j].y) + (y[j].z * y[j].z + y[j].w * y[j].w);
        const float rstd = rsqrtf(wave_sum(s) * (1.f / D) + EPS);
#pragma unroll
        for (int j = 0; j < 4; ++j) { const int col = F.lane * 4 + 256 * j;
            float* op = a.out + (size_t)m * D + col; const f32x4 x1 = {bflo(xw[j].x), bfhi(xw[j].x), bflo(xw[j].y), bfhi(xw[j].y)};
            __builtin_nontemporal_store(x1 + ggt[j] * (y[j] * rstd), (f32x4*)op); }
        __builtin_amdgcn_sched_barrier(0);
        r0 = r1; r1 = r2;
#pragma unroll
        for (int i = 0; i < 16; ++i) yv[i] = yn[i];
#pragma unroll
        for (int j = 0; j < 4; ++j) xw[j] = xn[j];
    }
    }
}

constexpr int NPHASE = 11;
__global__ void __launch_bounds__(512, 2) mk_fwd(Args args) {
    extern __shared__ __attribute__((aligned(16))) unsigned char lds_raw[];
    Frame F;
    F.lds = (LAS unsigned char*)lds_raw; F.ws = args.ws; F.ctl = (unsigned*)(args.ws + WS_CTL);
    F.tid = threadIdx.x; F.lane = F.tid & 63; F.wave = __builtin_amdgcn_readfirstlane(F.tid >> 6); F.G = gridDim.x; F.bid = blockIdx.x;
    volatile LAS unsigned* MISC = (volatile LAS unsigned*)(F.lds + LDS_MISC);
    if (F.tid < 32) MISC[F.tid] = 0u;
    __syncthreads();
    XcdBarrier bar = xcd_barrier_post(F.ctl + CW_BAR + args.li * XCD_BAR_WORDS, MISC + 8);
    if (F.tid == 0) __hip_atomic_store(F.ctl + CW_XCC + F.bid, bar.x + 1u, __ATOMIC_RELAXED, __HIP_MEMORY_SCOPE_AGENT);
    const int lo = args.ph_lo, hi = args.ph_hi;
#ifndef PHMASK
#define PHMASK 0x7ff
#endif
#define IN(k) (((PHMASK >> (k)) & 1) && lo <= (k) && (k) < hi)
#define SEAM(k) do { if (IN(k) && IN((k) + 1)) xcd_barrier(bar); } while (0)

    if (IN(0)) { p0_prologue(F, args); }
    if (IN(1)) for (int rep = 0; rep <= ((REPMASK >> 1) & 1); ++rep) { if (rep) xcd_barrier(bar); p1_normmod(F, args, 192u); }
    if (IN(1) && IN(2)) xcd_arrive(bar);
    if (IN(2)) for (int rep = 0; rep <= ((REPMASK >> 2) & 1); ++rep) { if (rep) xcd_barrier(bar);
        pg8::StaticOrder S; S.init(F.ws + WS_HX, F.ws + WS_WIN, M, NIN, D, F.G, F.bid);
        EpiInProj E{(bf16_t*)(F.ws + WS_P), args.in[12], (bf16_t*)(F.ws + WS_U), args.in[13]};
        const int nctx = 24;
        const bool tfirst = (F.bid >= nctx) && (((F.bid >> 3) & 1) != 0);
        const int nbefore = tfirst ? 11 : 2;
        if (F.bid >= nctx) { transpose_items_fp8(F, args, (F.bid - nctx) * 8 + F.wave, (F.G - nctx) * 8, 0, 1); if (IN(1) && rep == 0) xcd_try_acquire(bar);
            transpose_items_fp8(F, args, (F.bid - nctx) * 8 + F.wave, (F.G - nctx) * 8, 1, nbefore); __syncthreads(); }
        if (IN(1) && rep == 0) xcd_wait(bar);
        {
            pg8::P2Order O; O.S = S; O.ctx = (F.bid < nctx);
            O.cu.pm = 64 + F.bid / 6; O.cu.pn = 2 + F.bid % 6; O.cu.A = (const char*)(F.ws + WS_HX) + (size_t)O.cu.pm * 256 * D * 2; O.cu.B = (const char*)(F.ws + WS_WIN) + (size_t)O.cu.pn * 256 * D * 2;
            pg8::gemm_phase<EpiInProj, pg8::P2Order, false, true, true>(F.lds, D, O, E);
        }
        const bool lastrep = rep == ((REPMASK >> 2) & 1);
        if (F.bid >= nctx) {
            if (IN(3) && lastrep) xcd_arrive(bar);
            transpose_items_fp8(F, args, (F.bid - nctx) * 8 + F.wave, (F.G - nctx) * 8, nbefore, nbefore + 1); if (IN(3) && lastrep) xcd_try_acquire(bar);
            transpose_items_fp8(F, args, (F.bid - nctx) * 8 + F.wave, (F.G - nctx) * 8, nbefore + 1, 1 << 20); __syncthreads();
        }
        if (F.bid < nctx) {
            asm volatile("s_waitcnt vmcnt(0)" ::: "memory");
            __syncthreads();
            if (F.tid == 0) { __builtin_amdgcn_fence(__ATOMIC_RELEASE, "agent"); asm volatile("s_waitcnt vmcnt(0)" ::: "memory");
                __hip_atomic_fetch_add(F.ctl + CW_CTX + 64 * (F.bid / 6), 1u, __ATOMIC_RELAXED, __HIP_MEMORY_SCOPE_AGENT); }
            if (IN(3) && lastrep) xcd_arrive(bar);
            const bf16_t* P = (const bf16_t*)(F.ws + WS_P); bf16_t* ST = (bf16_t*)(F.ws + WS_ST); float* DDp = (float*)(F.ws + WS_DD);
            for (int u = F.bid; u < 32; u += nctx) {
                const int b = u >> 3, h = (u >> 1) & 3;
                if (F.tid == 0) { unsigned sp = 0;
                    while (__hip_atomic_load(F.ctl + CW_CTX + 64 * b, __ATOMIC_RELAXED, __HIP_MEMORY_SCOPE_AGENT) < 6u * (unsigned)(rep + 1)) { __builtin_amdgcn_s_sleep(2); if (++sp > (1u << 22)) break; }
                    __builtin_amdgcn_fence(__ATOMIC_ACQUIRE, "agent"); asm volatile("s_waitcnt vmcnt(0)" ::: "memory"); }
                __syncthreads();
                if (u & 1) gla_passA_unit<1>(F, P, b, h, 0, ST + (size_t)(u * NBLK) * 16384, DDp + (u * NBLK) * 128);
                else gla_passA_unit<0>(F, P, b, h, 0, ST + (size_t)(u * NBLK) * 16384, DDp + (u * NBLK) * 128);
                __syncthreads();
            }
        }
    }
    if (IN(2) && IN(3)) xcd_wait(bar);
    if (IN(3)) for (int rep = 0; rep <= ((REPMASK >> 3) & 1); ++rep) { if (rep) xcd_barrier(bar);
        const bf16_t* P = (const bf16_t*)(F.ws + WS_P); bf16_t* A2 = (bf16_t*)(F.ws + WS_A2);
        const bf16_t* Up = (const bf16_t*)(F.ws + WS_U);
        bf16_t* ST = (bf16_t*)(F.ws + WS_ST); float* DDp = (float*)(F.ws + WS_DD);
        for (int uu = F.bid; uu < 32 * 16; uu += F.G) { const int seq = uu >> 4, blk = 1 + (uu & 15), b = seq >> 3, h = (seq >> 1) & 3, dir = seq & 1, u = seq * NBLK + blk;
            if (dir == 0) gla_passA_unit<0>(F, P, b, h, blk, ST + (size_t)u * 16384, DDp + u * 128);
            else gla_passA_unit<1>(F, P, b, h, blk, ST + (size_t)u * 16384, DDp + u * 128); }
    }
    if (IN(3) && IN(4)) xcd_arrive(bar);
    if (IN(3)) {
        bf16_t* A2 = (bf16_t*)(F.ws + WS_A2); const bf16_t* Up = (const bf16_t*)(F.ws + WS_U);
        for (int w = F.bid; w < 256; w += F.G) {
            const int grp = (w & 7) * 4 + ((w >> 3) >> 3), mem = (w >> 3) & 7, b = grp >> 3, slab = (grp & 7) * 8 + mem, gi = slab >> 4;
            if (gi == 0) pool_unit<2>(F, Up, A2, b, slab); else if (gi == 1) pool_unit<4>(F, Up, A2, b, slab); else if (gi == 2) pool_unit<8>(F, Up, A2, b, slab); else pool_unit<16>(F, Up, A2, b, slab); }
    }
    if (IN(3) && IN(4)) xcd_wait(bar);
    if (IN(4)) { p4_scan(F); }
    if (IN(4) && IN(5)) xcd_arrive(bar);
    if (IN(4)) p0_late(F, args);
    if (IN(4) && IN(5)) xcd_wait(bar);
    unsigned xc[4] = {0u, 0u, 0u, 0u};
    if (IN(4) && IN(5) && IN(6)) {
#pragma unroll
        for (int k = 0; k < 4; ++k) xc[k] = xb_ld(F.ctl + CW_XCC + (F.bid & 63) + 64 * k); }
    if (IN(5)) for (int rep = 0; rep <= ((REPMASK >> 5) & 1); ++rep) { if (rep) xcd_barrier(bar); for (int u = F.bid; u < 256; u += F.G) {
            const int x = u & 7, slot = u >> 3;
            gla_passC_unit(F, args, x >> 1, slot >> 3, (x & 1) * 8 + (slot & 7)); } }
    const bool grp5 = (F.G == 256) && IN(4) && IN(5) && IN(6) && ((REPMASK >> 5) & 3) == 0;
    if (grp5) {
        asm volatile("s_waitcnt vmcnt(0)" ::: "memory");
        __syncthreads();
        if (F.tid == 0) {
            const bool same = (xc[0] == bar.x + 1u) && (xc[1] == bar.x + 1u) && (xc[2] == bar.x + 1u) && (xc[3] == bar.x + 1u);
            MISC[20] = same ? 1u : 0u;
            if (!same) { __builtin_amdgcn_fence(__ATOMIC_RELEASE, "agent"); asm volatile("s_waitcnt vmcnt(0)" ::: "memory"); }
            unsigned* g5 = F.ctl + CW_G5 + 64 * (8 * (F.bid & 7) + ((F.bid >> 3) & 7));
            (void)xb_add(g5, 1u);
            unsigned sp = 0;
            for (;;) { unsigned late = 0;
#pragma unroll
                for (int k = 0; k < 8; ++k) late += xb_ld(F.ctl + CW_LATE + 64 * k);
                if (xb_ld(g5) >= 4u && late >= 168u) break;
                __builtin_amdgcn_s_sleep(1); if (++sp > (1u << 22)) break; }
            __builtin_amdgcn_fence(__ATOMIC_ACQUIRE, "agent"); asm volatile("s_waitcnt vmcnt(0)" ::: "memory");
        }
        __syncthreads();
    } else SEAM(5);
    if (IN(6)) for (int rep = 0; rep <= ((REPMASK >> 6) & 1); ++rep) { if (rep) xcd_barrier(bar);
        pg8::StaticOrder S; S.init(F.ws + WS_A2, F.ws + WS_WOUT, M, D, D, F.G, F.bid);
        EpiBf16Out E{(bf16_t*)(F.ws + WS_YXB), D};
        pg8::gemm_phase<EpiBf16Out, pg8::StaticOrder, false, false, true>(F.lds, D, S, E);
    }
    const bool grp6 = grp5 && IN(7) && ((REPMASK >> 6) & 3) == 0;
    if (grp6) {
        asm volatile("s_waitcnt vmcnt(0)" ::: "memory");
        __syncthreads();
        if (F.tid == 0) {
            if (MISC[20] == 0u) { __builtin_amdgcn_fence(__ATOMIC_RELEASE, "agent"); asm volatile("s_waitcnt vmcnt(0)" ::: "memory"); }
            (void)xb_add(F.ctl + CW_G6 + 64 * (8 * (F.bid & 7) + ((F.bid >> 3) & 7)), 1u);
        }
    } else if (IN(6) && IN(7)) xcd_arrive(bar);
    if (IN(7)) { p7_rows(F, args, bar, grp6 ? 2 : ((IN(6) && IN(7)) ? 1 : 0)); }
    SEAM(7);
    if (IN(8)) for (int rep = 0; rep <= ((REPMASK >> 8) & 1); ++rep) { if (rep) xcd_barrier(bar);
        moe_tables(F);
        MoeOrder<8, true> S; S.ldsb = F.lds; S.tab = (const LAS int*)(F.lds + LDS_TAB); S.Abase = (const char*)(F.ws + WS_HX2F); S.Wbase = (const char*)(F.ws + WS_WGU); S.rtok = (const int*)(F.ws + WS_RTOK);
        S.cls = 0; S.rank = (F.bid & 7) * (F.G >> 3) + (F.bid >> 3); S.nrank = F.G; S.mtc = F.ctl + CW_MT;
        EpiGateUp E{F.ws + WS_H, args.in[19], args.in[21]};
        pg8::gemm_phase<EpiGateUp, MoeOrder<8, true>, true, true, true, true>(F.lds, 512, S, E);
    }
    if (IN(9)) for (int rep = 0; rep <= ((REPMASK >> 9) & 1); ++rep) { if (rep) xcd_barrier(bar);
        if (!IN(8) || rep) moe_tables(F);
        MoeOrder<4, false> S; S.ldsb = F.lds; S.tab = (const LAS int*)(F.lds + LDS_TAB); S.Abase = (const char*)(F.ws + WS_H); S.Wbase = (const char*)(F.ws + WS_WDN); S.rtok = nullptr;
        S.cls = 0; S.rank = F.G - 1 - ((F.bid & 7) * (F.G >> 3) + (F.bid >> 3)); S.nrank = F.G; S.mtc = F.ctl + CW_MT;
        EpiDown E{F.ws + WS_YB, args.in[23]};
        pg8::gemm_phase<EpiDown, MoeOrder<4, false>, false, true, true, true>(F.lds, 512, S, E);
    }
    if (IN(9) && IN(10)) xcd_arrive(bar);
    if (IN(10)) { if (!IN(9)) moe_tables(F);
        p10_final(F, args, bar, IN(9) && IN(10)); }
#undef IN
#undef SEAM
}

extern "C" void kernel_launch(void* const* d_in, const int* in_sizes, int n_in, void* d_out, int out_size, void* d_ws, size_t ws_size, hipStream_t stream) {
    static int grid = 0;
    if (grid == 0) {
        if (n_in != 24 || out_size != M * D || ws_size < WS_END) { fprintf(stderr, "kernel_launch: unexpected shapes (n_in %d out %d ws %zu)\n", n_in, out_size, ws_size); grid = -1; return; }
        int dev = 0, cus = 0, per_cu = 0;
        if (hipGetDevice(&dev) != hipSuccess || hipDeviceGetAttribute(&cus, hipDeviceAttributeMultiprocessorCount, dev) != hipSuccess) { grid = -1; return; }
        if (hipFuncSetAttribute((const void*)mk_fwd, hipFuncAttributeMaxDynamicSharedMemorySize, LDS_BYTES) != hipSuccess) { fprintf(stderr, "kernel_launch: hipFuncSetAttribute failed\n"); grid = -1; return; }
        if (hipOccupancyMaxActiveBlocksPerMultiprocessor(&per_cu, (const void*)mk_fwd, 512, LDS_BYTES) != hipSuccess || per_cu < 1) { fprintf(stderr, "kernel_launch: occupancy query says %d\n", per_cu); }
        (void)hipGetLastError();
        grid = cus;
        if (grid % 8 != 0 || M % grid != 0 || (M / grid) % 64 != 0) { fprintf(stderr, "kernel_launch: unsupported CU count %d\n", cus); grid = -1; return; }
    }
    if (grid < 0) return;
    if (hipMemsetAsync((char*)d_ws + WS_CTL, 0, CTL_ZERO_BYTES, stream) != hipSuccess) return;
    Args a{};
    for (int i = 0; i < 24; ++i) a.in[i] = (const float*)d_in[i];
    a.out = (float*)d_out; a.ws = (unsigned char*)d_ws; a.pad = 0;
    constexpr int NL = MK_N_LAUNCHES;
    for (int li = 0; li < NL; ++li) {
        a.ph_lo = (NL == 1) ? 0 : li; a.ph_hi = (NL == 1) ? NPHASE : li + 1; a.li = (NL == 1) ? 0 : 0;
        hipLaunchKernelGGL(mk_fwd, dim3(grid), dim3(512), LDS_BYTES, stream, a);
    }
}
```
